# Optimizing an MI355X kernel written in HIP

```python
import jax, jax.numpy as jnp
from jax import lax
import numpy as np

D_MODEL = 2048
BATCH = 2
SEQ = 8192
DEPTH = 1

FOX_HEADS = 8
FOX_HEAD_DIM = 128
FOX_W = FOX_HEADS * FOX_HEAD_DIM
Q_BLOCK = 128
HG_HEADS = 8
HG_HEAD_DIM = 128
HG_W = HG_HEADS * HG_HEAD_DIM
HG_CHUNK = 64
MIX_W = FOX_W + HG_W
IN_SPLITS = [FOX_W, FOX_W, FOX_W, FOX_HEADS, HG_W, HG_W, HG_W, HG_W]
IN_COLS = sum(IN_SPLITS)
N_EXPERTS = 32
TOP_K = 4
D_FF = D_MODEL
SWIGLU_ALPHA = 1.702
SWIGLU_LIMIT = 7.0
MOE_BLOCK = 256
N_MOD = 6
NORM_EPS = 1e-6

kernel_name = "fox_hgrn2_hybrid_moe_adaln"


def rms_norm(x, g):
    xf = x.astype(jnp.float32)
    y = xf * lax.rsqrt(jnp.mean(xf * xf, axis=-1, keepdims=True) + NORM_EPS)
    return (y * g.astype(jnp.float32)).astype(x.dtype)


def fox_attention(q, k, v, logf):
    B, S, H, Dh = q.shape
    scale = Dh ** -0.5
    cum = jnp.cumsum(logf, axis=1).transpose(0, 2, 1)
    outs = []
    for qb in range(S // Q_BLOCK):
        q0, q1 = qb * Q_BLOCK, (qb + 1) * Q_BLOCK
        s = jnp.einsum('bqhd,bkhd->bhqk', q[:, q0:q1], k[:, :q1]).astype(jnp.float32) * scale
        s = s + cum[:, :, q0:q1, None] - cum[:, :, None, :q1]
        causal = jnp.arange(q1)[None, :] <= jnp.arange(q0, q1)[:, None]
        s = jnp.where(causal, s, -jnp.inf)
        p = jax.nn.softmax(s, axis=-1).astype(v.dtype)
        outs.append(jnp.einsum('bhqk,bkhd->bqhd', p, v[:, :q1]))
    return jnp.concatenate(outs, axis=1)


def hgrn2_recurrence(q, f_logit, i, lb):
    B, S, H, Dk = q.shape
    nc = S // HG_CHUNK
    lbh = lb.astype(jnp.float32).reshape(H, Dk)
    f = lbh + (1.0 - lbh) * jax.nn.sigmoid(f_logit.astype(jnp.float32))
    logf = jnp.log(f)
    kk = 1.0 - f
    qq = jax.nn.silu(q.astype(jnp.float32))
    vv = i.astype(jnp.float32)

    def chunked(t):
        return t.reshape(B, nc, HG_CHUNK, H, t.shape[-1]).transpose(0, 3, 1, 2, 4)

    qq, kk, vv, logf = chunked(qq), chunked(kk), chunked(vv), chunked(logf)
    b = jnp.cumsum(logf, axis=3)
    b_last = b[:, :, :, -1:, :]
    q_dec = qq * jnp.exp(b)
    k_inv = kk * jnp.exp(-b)
    k_tail = kk * jnp.exp(b_last - b)
    causal = jnp.tril(jnp.ones((HG_CHUNK, HG_CHUNK), dtype=bool))
    attn = jnp.where(causal, jnp.einsum('bhncd,bhnsd->bhncs', q_dec, k_inv), 0.0)
    o_intra = jnp.einsum('bhncs,bhnsv->bhncv', attn, vv)
    upd = jnp.einsum('bhnsd,bhnsv->bhndv', k_tail, vv)
    decay = jnp.exp(b_last[:, :, :, 0, :])

    def step(state, inp):
        dec, u = inp
        return dec[..., None] * state + u, state

    s0 = jnp.zeros((B, H, Dk, vv.shape[-1]), jnp.float32)
    _, s_prev = lax.scan(step, s0, (jnp.moveaxis(decay, 2, 0), jnp.moveaxis(upd, 2, 0)))
    s_prev = jnp.moveaxis(s_prev, 0, 2)
    o = o_intra + jnp.einsum('bhncd,bhndv->bhncv', q_dec, s_prev)
    return o.transpose(0, 2, 3, 1, 4).reshape(B, S, H, vv.shape[-1])


def hybrid_mixer(h, w_in, b_fgate, g_fox_out, lb, g_hg_out, w_out):
    B, S, _ = h.shape
    proj = jnp.einsum('bsd,dn->bsn', h, w_in)
    cuts = [int(v) for v in np.cumsum(IN_SPLITS)[:-1]]
    fq, fk, fv, fgl, hq, hf, hi, hg = jnp.split(proj, cuts, axis=-1)
    heads_a = lambda t: t.reshape(B, S, FOX_HEADS, FOX_HEAD_DIM)
    logf = jax.nn.log_sigmoid((fgl + b_fgate).astype(jnp.float32))
    fox = fox_attention(heads_a(fq), heads_a(fk), heads_a(fv), logf).reshape(B, S, FOX_W)
    fox = rms_norm(fox, g_fox_out)
    heads_b = lambda t: t.reshape(B, S, HG_HEADS, HG_HEAD_DIM)
    o = hgrn2_recurrence(heads_b(hq), heads_b(hf), heads_b(hi), lb)
    o = rms_norm(o, g_hg_out.reshape(HG_HEADS, HG_HEAD_DIM))
    o = (o * jax.nn.silu(heads_b(hg).astype(jnp.float32))).reshape(B, S, HG_W).astype(h.dtype)
    mixed = jnp.concatenate([fox, o], axis=-1)
    return jnp.einsum('bsm,md->bsd', mixed, w_out)


def moe_ffn(h, w_router, b_router, w_gu, b_gu, w_down, b_down):
    B, S, D = h.shape
    T = B * S
    TK = T * TOP_K
    xt = h.reshape(T, D)
    logits = (xt @ w_router + b_router).astype(jnp.float32)
    top_val, top_idx = lax.top_k(logits, TOP_K)
    gates = jax.nn.softmax(top_val, axis=-1)
    e_flat = top_idx.reshape(TK).astype(jnp.int32)
    tok = jnp.arange(TK, dtype=jnp.int32) // TOP_K
    counts = jnp.bincount(e_flat, length=N_EXPERTS).astype(jnp.int32)
    group_start = jnp.cumsum(counts) - counts
    padded = (counts + MOE_BLOCK - 1) // MOE_BLOCK * MOE_BLOCK
    padded_end = jnp.cumsum(padded)
    padded_start = padded_end - padded
    order = jnp.argsort(e_flat, stable=True)
    e_sorted = e_flat[order]
    rank = jnp.arange(TK, dtype=jnp.int32) - group_start[e_sorted]
    pos = jnp.zeros((TK,), jnp.int32).at[order].set((padded_start[e_sorted] + rank).astype(jnp.int32))
    n_blocks = -(-TK // MOE_BLOCK) + N_EXPERTS
    n_rows = n_blocks * MOE_BLOCK
    src = jnp.full((n_rows,), T, jnp.int32).at[pos].set(tok)
    x_pad = jnp.concatenate([xt, jnp.zeros((1, D), xt.dtype)], axis=0)
    buf = x_pad[src].reshape(n_blocks, MOE_BLOCK, D)
    block_e = jnp.minimum(
        jnp.searchsorted(padded_end, jnp.arange(n_blocks, dtype=jnp.int32) * MOE_BLOCK, side='right'),
        N_EXPERTS - 1)

    def expert_block(args):
        xb, e = args
        gu = xb @ w_gu[e] + b_gu[e]
        glu, lin = jnp.split(gu, 2, axis=-1)
        glu = jnp.minimum(glu, SWIGLU_LIMIT)
        lin = jnp.clip(lin, -SWIGLU_LIMIT, SWIGLU_LIMIT)
        act = glu * jax.nn.sigmoid(SWIGLU_ALPHA * glu) * (lin + 1.0)
        return act @ w_down[e] + b_down[e]

    y_buf = lax.map(expert_block, (buf, block_e)).reshape(n_rows, D)
    y = y_buf[pos].reshape(T, TOP_K, D)
    out = jnp.einsum('tk,tkd->td', gates.astype(y.dtype), y)
    return out.reshape(B, S, D)


def setup_inputs(seed: int = 0) -> dict:
    key = jax.random.key(seed)
    ks = jax.random.split(key, 20)
    f32 = jnp.float32
    nrm = lambda k, shape, s: jax.random.normal(k, shape, f32) * s
    D = D_MODEL
    return {
        'x': nrm(ks[0], (BATCH, SEQ, D), 1.0),
        'c': nrm(ks[1], (BATCH, D), 1.0),
        'w_ada': nrm(ks[2], (DEPTH, D, N_MOD * D), 0.5 * D ** -0.5),
        'b_ada': nrm(ks[3], (DEPTH, N_MOD * D), 0.02),
        'g_norm1': 1.0 + nrm(ks[4], (DEPTH, D), 0.02),
        'g_norm2': 1.0 + nrm(ks[5], (DEPTH, D), 0.02),
        'w_in': nrm(ks[6], (DEPTH, D, IN_COLS), D ** -0.5),
        'b_fgate': 2.0 + nrm(ks[7], (DEPTH, FOX_HEADS), 0.1),
        'g_fox_out': 1.0 + nrm(ks[8], (DEPTH, FOX_W), 0.02),
        'lb_logits': nrm(ks[9], (DEPTH + 1, HG_W), 0.1),
        'g_hg_out': 1.0 + nrm(ks[10], (DEPTH, HG_W), 0.02),
        'w_out': nrm(ks[11], (DEPTH, MIX_W, D), MIX_W ** -0.5),
        'w_router': nrm(ks[12], (DEPTH, D, N_EXPERTS), D ** -0.5),
        'b_router': nrm(ks[13], (DEPTH, N_EXPERTS), 0.01),
        'w_gu': nrm(ks[14], (DEPTH, N_EXPERTS, D, 2 * D_FF), D ** -0.5),
        'b_gu': nrm(ks[15], (DEPTH, N_EXPERTS, 2 * D_FF), 0.01),
        'w_down': nrm(ks[16], (DEPTH, N_EXPERTS, D_FF, D), D_FF ** -0.5),
        'b_down': nrm(ks[17], (DEPTH, N_EXPERTS, D), 0.01),
        'g_final': 1.0 + nrm(ks[18], (D,), 0.02),
    }


def reference(x, c, w_ada, b_ada, g_norm1, g_norm2, w_in, b_fgate, g_fox_out, lb_logits, g_hg_out,
              w_out, w_router, b_router, w_gu, b_gu, w_down, b_down, g_final):
    gamma = jnp.cumsum(jax.nn.softmax(lb_logits.astype(jnp.float32), axis=0), axis=0)
    cond = jax.nn.silu(c)
    for l in range(DEPTH):
        mod = (cond @ w_ada[l] + b_ada[l])[:, None, :]
        sh1, sc1, gt1, sh2, sc2, gt2 = jnp.split(mod, N_MOD, axis=-1)
        h = rms_norm(x, g_norm1[l]) * (1.0 + sc1) + sh1
        x = x + gt1 * hybrid_mixer(h, w_in[l], b_fgate[l], g_fox_out[l], gamma[l], g_hg_out[l], w_out[l])
        h = rms_norm(x, g_norm2[l]) * (1.0 + sc2) + sh2
        x = x + gt2 * moe_ffn(h, w_router[l], b_router[l], w_gu[l], b_gu[l], w_down[l], b_down[l])
    return rms_norm(x, g_final)
```

```cpp
#include <hip/hip_runtime.h>
#include <cstdio>
#include <cstdint>

#define LAS __attribute__((address_space(3)))
typedef unsigned short bf16_t;
typedef short bf16x8 __attribute__((ext_vector_type(8)));
typedef short s16x4 __attribute__((ext_vector_type(4)));
typedef float f32x4 __attribute__((ext_vector_type(4)));
typedef float f32x2 __attribute__((ext_vector_type(2)));
typedef unsigned u32x4 __attribute__((ext_vector_type(4)));
typedef unsigned u32x2 __attribute__((ext_vector_type(2)));
typedef int i32x4 __attribute__((ext_vector_type(4)));
typedef int i32x8 __attribute__((ext_vector_type(8)));

constexpr int T_ = 16384, D_ = 2048, S_ = 8192;
constexpr int NPROJ = 7168;
constexpr int C_FQ = 0, C_FK = 1024, C_FV = 2048, C_HQ = 3072, C_HF = 4096, C_HI = 5120, C_HG = 6144;
constexpr int NE = 32;
constexpr int MAXTILES = 288, MAXROWS = MAXTILES * 256;
constexpr int LDS_BYTES = 155648;
constexpr int NPHASE = 12;
#ifndef WGM_IN
#define WGM_IN 2
#endif
#ifndef WGM_OUT
#define WGM_OUT 2
#endif
#ifndef WGM_GU
#define WGM_GU 2
#endif
#ifndef WGM_DN
#define WGM_DN 2
#endif
#ifndef CONV_NCG
#define IN_MODE 2
#define FP8_OUT 0
#define CONV_NCG 4
#endif
#ifndef CONV_NA
#define CONV_NA 1
#endif
constexpr float EPS = 1e-6f;
constexpr float LOG2E = 1.4426950408889634f;

constexpr size_t al256(size_t x) { return (x + 255) & ~(size_t)255; }
constexpr size_t WS_CTL   = 0;
constexpr size_t WS_MODP  = 65536;
constexpr size_t WS_MOD   = WS_MODP + al256(8 * 2 * 12288 * 4);
constexpr size_t WS_WIN   = WS_MOD + al256(2 * 12288 * 4);
constexpr size_t WS_WOUT  = WS_WIN + (size_t)NPROJ * 2048 * 2;
constexpr size_t WS_WGU   = WS_WOUT + (size_t)2048 * 2048 * 2;
constexpr size_t WS_WDN   = WS_WGU + (size_t)32 * 4096 * 2048 * 2;
constexpr size_t WS_H1    = WS_WDN + (size_t)32 * 2048 * 2048 * 2;
constexpr size_t WS_PROJ  = WS_H1 + (size_t)T_ * 2048 * 2;
constexpr size_t WS_LOGF  = WS_PROJ + (size_t)T_ * NPROJ * 2;
constexpr size_t WS_CUM   = WS_LOGF + (size_t)T_ * 8 * 4;
constexpr size_t WS_HGU   = WS_CUM + (size_t)T_ * 8 * 4;
constexpr size_t WS_HGSP  = WS_HGU + (size_t)16 * 128 * 128 * 128 * 4;
constexpr size_t WS_HGDEC = WS_HGSP + (size_t)16 * 128 * 128 * 128 * 2;
constexpr size_t WS_MIXED = WS_HGDEC + (size_t)16 * 128 * 128 * 4;
constexpr size_t WS_SSQ   = WS_MIXED + (size_t)T_ * 2048 * 2;
constexpr size_t WS_X1    = WS_SSQ + (size_t)T_ * 8 * 4;
constexpr size_t WS_H2    = WS_X1 + (size_t)T_ * 2048 * 4;
constexpr size_t WS_TOPI  = WS_H2 + (size_t)T_ * 2048 * 2;
constexpr size_t WS_TOPG  = WS_TOPI + (size_t)T_ * 16;
constexpr size_t WS_POS   = WS_TOPG + (size_t)T_ * 16;
constexpr size_t WS_CNT   = WS_POS + (size_t)T_ * 16;
constexpr size_t WS_SRC   = WS_CNT + 256 * 32 * 4;
constexpr size_t WS_TILEE = WS_SRC + (size_t)MAXROWS * 4;
constexpr size_t WS_ACT   = WS_TILEE + 4096;
constexpr size_t WS_YBUF  = WS_ACT + (size_t)MAXROWS * 2048 * 2;
constexpr size_t WS_KN    = WS_YBUF + (size_t)MAXROWS * 2048 * 2;
constexpr size_t WS_MIX8  = WS_KN + 16 * 128 * 4;
constexpr size_t WS_RS    = WS_MIX8 + (size_t)T_ * 2048;
constexpr size_t WS_END   = WS_RS + (size_t)T_ * 4;
constexpr size_t WS_CMAX  = 16384;

struct Params {
    const float* x; const float* c; const float* w_ada; const float* b_ada; const float* g1; const float* g2;
    const float* w_in; const float* b_fgate; const float* g_fox; const float* lb_logits; const float* g_hg;
    const float* w_out; const float* w_router; const float* b_router; const float* w_gu; const float* b_gu;
    const float* w_down; const float* b_down; const float* g_final;
    float* out; unsigned char* ws; int lo, hi;
};

__device__ __forceinline__ unsigned cvt_pk_bf16(float lo, float hi) { unsigned r; asm volatile("v_cvt_pk_bf16_f32 %0, %1, %2" : "=v"(r) : "v"(lo), "v"(hi)); return r; }
__device__ __forceinline__ unsigned pack4_fp8(float a, float b, float c, float d) { int w = 0; w = __builtin_amdgcn_cvt_pk_fp8_f32(a, b, w, false); w = __builtin_amdgcn_cvt_pk_fp8_f32(c, d, w, true); return (unsigned)w; }
__device__ __forceinline__ unsigned pack4_i8(float a, float b, float c, float d) {
    const int ia = __float2int_rn(a), ib = __float2int_rn(b), ic = __float2int_rn(c), id = __float2int_rn(d);
    return (unsigned)(ia & 255) | ((unsigned)(ib & 255) << 8) | ((unsigned)(ic & 255) << 16) | ((unsigned)id << 24);
}
__device__ __forceinline__ i32x8 cat8(bf16x8 a, bf16x8 b) { const i32x4 x = __builtin_bit_cast(i32x4, a), y = __builtin_bit_cast(i32x4, b); return __builtin_shufflevector(x, y, 0, 1, 2, 3, 4, 5, 6, 7); }
__device__ __forceinline__ float bf2f(bf16_t b) { return __uint_as_float(((unsigned)b) << 16); }
__device__ __forceinline__ float bflo(unsigned w) { return __uint_as_float(w << 16); }
__device__ __forceinline__ float bfhi(unsigned w) { return __uint_as_float(w & 0xffff0000u); }
__device__ __forceinline__ float wave_sum(float v) {
#pragma unroll
    for (int o = 32; o >= 1; o >>= 1) v += __shfl_xor(v, o);
    return v;
}

#define XB_TMO      128
#define XB_XCNT(j)  (256  + 64 * (j))
#define XB_XSUB(j)  (1280 + 64 * (j))
#define XB_XGEN(j)  (2304 + 64 * (j))
#define XB_TOP      3328
#define XB_TOPGEN   3392
#define XCD_BAR_WORDS 3456
#define XB_SPIN_CAP (1u << 18)

__device__ __forceinline__ unsigned xb_ld(unsigned* p)              { return __hip_atomic_load(p, __ATOMIC_RELAXED, __HIP_MEMORY_SCOPE_AGENT); }
__device__ __forceinline__ unsigned xb_add(unsigned* p, unsigned v) { return __hip_atomic_fetch_add(p, v, __ATOMIC_RELAXED, __HIP_MEMORY_SCOPE_AGENT); }
__device__ __forceinline__ unsigned xb_xcc_id() { return (unsigned)__builtin_amdgcn_s_getreg((3 << 11) | 20) & 0xFu; }
#define XB_SPIN(cond, bar) do { unsigned _sp = 0; while (cond) { __builtin_amdgcn_s_sleep(1); \
    if ((++_sp & 255u) == 0u) { if (xb_ld(&(bar)[XB_TMO])) break; if (_sp > XB_SPIN_CAP) { atomicAdd(&(bar)[XB_TMO], 1u); break; } } } } while (0)

struct XcdBarrier { unsigned* bar; unsigned x; volatile LAS unsigned* st; };

__device__ __forceinline__ XcdBarrier xcd_barrier_post(unsigned* bar, volatile LAS unsigned* st) {
    XcdBarrier b; b.bar = bar; b.x = xb_xcc_id(); b.st = st;
    if (threadIdx.x == 0) (void)xb_add(&bar[XB_XCNT(b.x)], 1u);
    return b;
}
__device__ __forceinline__ void xcd_barrier_complete(unsigned* bar, unsigned x, unsigned& nloc, unsigned& nx) {
    const unsigned G = gridDim.x * gridDim.y * gridDim.z;
    unsigned sum, cnt, mine, sp = 0u;
    for (;;) {
        sum = 0u; cnt = 0u; mine = 0u;
#pragma unroll
        for (unsigned j = 0; j < 16; ++j) { const unsigned c = xb_ld(&bar[XB_XCNT(j)]); sum += c; cnt += (c > 0u) ? 1u : 0u; mine = (j == x) ? c : mine; }
        if (sum == G) break;
        __builtin_amdgcn_s_sleep(1);
        if ((++sp & 255u) == 0u) { if (xb_ld(&bar[XB_TMO])) break; if (sp > XB_SPIN_CAP) { atomicAdd(&bar[XB_TMO], 1u); break; } }
    }
    nloc = mine > 0u ? mine : 1u; nx = cnt > 0u ? cnt : 1u;
}
__device__ __forceinline__ void xcd_barrier(const XcdBarrier& b) {
    asm volatile("s_waitcnt vmcnt(0)" ::: "memory");
    __syncthreads();
    if (threadIdx.x == 0) {
        unsigned* bar = b.bar;
        __builtin_amdgcn_s_waitcnt(0);
        unsigned nloc = b.st[0], nx = b.st[1];
        if (nloc == 0u) { xcd_barrier_complete(bar, b.x, nloc, nx); b.st[0] = nloc; b.st[1] = nx; }
        const unsigned old = xb_add(&bar[XB_XSUB(b.x)], 1u);
        const unsigned gen = old / nloc;
        if (old + 1u == (gen + 1u) * nloc) {
            __builtin_amdgcn_fence(__ATOMIC_RELEASE, "agent");
            asm volatile("s_waitcnt vmcnt(0)" ::: "memory");
            const unsigned og = xb_add(&bar[XB_TOP], 1u);
            const unsigned tg = og / nx;
            if (og + 1u == (tg + 1u) * nx) xb_add(&bar[XB_TOPGEN], 1u);
            else XB_SPIN(xb_ld(&bar[XB_TOPGEN]) == tg, bar);
            __builtin_amdgcn_fence(__ATOMIC_ACQUIRE, "agent");
            xb_add(&bar[XB_XGEN(b.x)], 1u);
            asm volatile("s_waitcnt vmcnt(0)" ::: "memory");
        } else {
            XB_SPIN(xb_ld(&bar[XB_XGEN(b.x)]) == gen, bar);
            __builtin_amdgcn_fence(__ATOMIC_ACQUIRE, "agent");
            asm volatile("s_waitcnt vmcnt(0)" ::: "memory");
        }
    }
    __syncthreads();
}

namespace pg8 {
constexpr int BM = 256, BK = 64, HALF = 128, HTB = HALF * BK * 2, STAGE_BYTES = 8 * HTB, NXCD = 8;
__device__ __forceinline__ int lds_byte(int r, int c) { const int st = (r >> 4) * 2 + (c >> 5), rr = r & 15, cc = c & 31, ob = rr * 64 + cc * 2; return st * 1024 + (ob ^ (((ob >> 9) & 1) << 5)); }
__device__ __forceinline__ void stage_rc(int b, int& R, int& C) { const int st = b / 1024, sb = b % 1024, swz = sb ^ (((sb >> 9) & 1) << 5); R = (st >> 1) * 16 + swz / 64; C = (st & 1) * 32 + (swz % 64) / 2; }
__device__ __forceinline__ int perm32(int rho) { const int n = rho >> 4, i = rho & 15; return 8 * (i >> 2) + 4 * n + (i & 3); }
struct Unit { int pm, pn; };
struct StaticOrder {
    int nM, nN, nwg, G, c, WGM;
    __device__ void init(int M, int N, int G_, int c_, int wgm) { nM = M / BM; nN = N / BM; nwg = nM * nN; G = G_; c = c_; WGM = wgm; }
    __device__ bool next(int i, Unit& u) const {
        const long L = (long)i * G + c; if (L >= nwg) return false;
        int wgid = (int)L; { const int q = nwg / NXCD, r = nwg % NXCD, xcd = wgid % NXCD, off = wgid / NXCD; wgid = (xcd < r ? xcd * (q + 1) : r * (q + 1) + (xcd - r) * q) + off; }
        const int nig = WGM * nN, gid = wgid / nig, fm = gid * WGM, gsz = (nM - fm) < WGM ? (nM - fm) : WGM;
        u.pm = fm + ((wgid % nig) % gsz); u.pn = (wgid % nig) / gsz; return true;
    }
};

struct SplitOrder {
    int nM, nN, nwg, G, c, na, nb, n_nc, rank_nc, WGM; bool conv;
    __device__ void init(int M, int N, int G_, int c_, int ncg, int na_, int wgm) {
        nM = M / BM; nN = N / BM; nwg = nM * nN; G = G_; c = c_; WGM = wgm;
        if ((G & 63) != 0) ncg = 0;
        const int g = c >> 3, oct = g >> 3, gi = g & 7;
        conv = gi < ncg;
        n_nc = G - (G >> 3) * ncg;
        rank_nc = 8 * (oct * (8 - ncg) + (gi > ncg ? gi - ncg : 0)) + (c & 7);
        na = ncg ? na_ : 0x3fffffff;
        const int rem = nwg - na * G;
        nb = ncg ? na + (rem > 0 ? (rem + n_nc - 1) / n_nc : 0) : 0x3fffffff;
    }
    __device__ int conv_rank(int ncg) const { const int g = c >> 3; return 8 * ((g >> 3) * ncg + ((g & 7) < ncg ? (g & 7) : ncg)) + (c & 7); }
    __device__ bool next(int i, Unit& u) const {
        long L;
        if (i < na) L = (long)i * G + c;
        else { if (conv || i >= nb) return false; L = (long)na * G + (long)(i - na) * n_nc + rank_nc; }
        if (L >= nwg) return false;
        int wgid = (int)L; { const int q = nwg / NXCD, r = nwg % NXCD, xcd = wgid % NXCD, off = wgid / NXCD; wgid = (xcd < r ? xcd * (q + 1) : r * (q + 1) + (xcd - r) * q) + off; }
        const int nig = WGM * nN, gid = wgid / nig, fm = gid * WGM, gsz = (nM - fm) < WGM ? (nM - fm) : WGM;
        u.pm = fm + ((wgid % nig) % gsz); u.pn = (wgid % nig) / gsz; return true;
    }
};
struct SrcPlain {
    static constexpr bool SIDE = false;
    const bf16_t* A; const bf16_t* Bt; int K;
    __device__ __forceinline__ void load_map(LAS int*, int) const {}
    __device__ __forceinline__ const char* a_base(const Unit& u) const { return (const char*)A + (size_t)u.pm * BM * K * 2; }
    __device__ __forceinline__ const char* b_base(const Unit& u, const LAS int*) const { return (const char*)Bt + (size_t)u.pn * BM * K * 2; }
    __device__ __forceinline__ void a_voff(const Unit&, const int (&R)[2], const int (&C)[2], unsigned (&v)[2][2]) const {
#pragma unroll
        for (int h = 0; h < 2; ++h)
#pragma unroll
            for (int i = 0; i < 2; ++i) v[h][i] = (unsigned)((h * HALF + R[i]) * K + C[i]) * 2u;
    }
    __device__ __forceinline__ void side_issue(const Unit&, LAS int*, int, int) const {}
    __device__ __forceinline__ void a_voff_side(const Unit& u, const LAS int*, const int (&R)[2], const int (&C)[2], unsigned (&v)[2][2]) const { a_voff(u, R, C, v); }
};
struct SrcMoE {
    static constexpr bool SIDE = true;
    const bf16_t* A; const bf16_t* Bt; const int* src; const int* tile_e; int K; size_t estride;
    __device__ __forceinline__ void load_map(LAS int* lte, int nM) const { for (int i = threadIdx.x; i < nM; i += 512) lte[i] = tile_e[i]; }
    __device__ __forceinline__ const char* a_base(const Unit& u) const { return src ? (const char*)A : (const char*)A + (size_t)u.pm * BM * K * 2; }
    __device__ __forceinline__ const char* b_base(const Unit& u, const LAS int* lte) const { const int e = lte[u.pm]; return (const char*)Bt + ((size_t)e * estride + (size_t)u.pn * BM * K) * 2; }
    __device__ __forceinline__ void a_voff(const Unit& u, const int (&R)[2], const int (&C)[2], unsigned (&v)[2][2]) const {
#pragma unroll
        for (int h = 0; h < 2; ++h)
#pragma unroll
            for (int i = 0; i < 2; ++i) {
                const int r = src ? src[u.pm * BM + h * HALF + R[i]] : (h * HALF + R[i]);
                v[h][i] = (unsigned)(r * K + C[i]) * 2u; }
    }
    __device__ __forceinline__ void side_issue(const Unit& u, LAS int* tbl, int wid, int lane) const {
        if (src && wid < 4) __builtin_amdgcn_global_load_lds((const unsigned*)(src + u.pm * BM + wid * 64 + lane), (LAS unsigned*)(tbl + wid * 64), 4, 0, 0);
    }
    __device__ __forceinline__ void a_voff_side(const Unit& u, const LAS int* tbl, const int (&R)[2], const int (&C)[2], unsigned (&v)[2][2]) const {
#pragma unroll
        for (int h = 0; h < 2; ++h)
#pragma unroll
            for (int i = 0; i < 2; ++i) {
                const int r = src ? tbl[h * HALF + R[i]] : (h * HALF + R[i]);
                v[h][i] = (unsigned)(r * K + C[i]) * 2u; }
    }
};

template <int MODE, class Epi, class Sched, class Src>
__device__ __forceinline__ void gemm_phase(LAS unsigned char* lds, const int K, const Sched& S, const Src& X, const Epi& E) {
    const int tid = threadIdx.x, wid = __builtin_amdgcn_readfirstlane(tid >> 6), lane = tid & 63, wr = wid >> 2, wc = wid & 3, fr = lane & 15, fq = lane >> 4;
    const int nt = K / BK;
    int Rr[2], Cc[2]; unsigned voffB[2];
#pragma unroll
    for (int i = 0; i < 2; ++i) { int R, C; stage_rc(tid * 16 + i * 8192, R, C); Rr[i] = R; Cc[i] = C; const int Rb = Epi::PERM ? ((R & ~31) + perm32(R & 31)) : R; voffB[i] = (unsigned)(Rb * K + C) * 2u; }
    const size_t kstep = (size_t)(BK * 2);
    const size_t hstep = (size_t)HALF * K * 2;
    const unsigned ldsw = (unsigned)wid * 1024u;
    const int aoff = lds_byte(wr * 64 + fr, fq * 8), boff = lds_byte(wc * 32 + fr, fq * 8);
#define PG8_SA(b, h) (((b) * 2 + (h)) * HTB)
#define PG8_SB(b, h) ((4 + (b) * 2 + (h)) * HTB)
#define PG8_STAGE(bufoff, gbase, voff) do { _Pragma("unroll") for (int _i = 0; _i < 2; ++_i) \
        __builtin_amdgcn_global_load_lds((const unsigned*)((const char*)(gbase) + (voff)[_i]), (LAS unsigned*)(lds + (bufoff) + ldsw + _i * 8192), 16, 0, 0); } while (0)
#define PG8_LDA(dst, b, h) do { _Pragma("unroll") for (int m = 0; m < 4; ++m) _Pragma("unroll") for (int k = 0; k < 2; ++k) dst[m][k] = *(const LAS bf16x8*)(lds + PG8_SA(b, h) + aoff + m * 2048 + k * 1024); } while (0)
#define PG8_LDB(dst, b, h) do { _Pragma("unroll") for (int n = 0; n < 2; ++n) _Pragma("unroll") for (int k = 0; k < 2; ++k) dst[n][k] = *(const LAS bf16x8*)(lds + PG8_SB(b, h) + boff + n * 2048 + k * 1024); } while (0)
#define PG8_MMA(ai, bj, At, Bt) do { __builtin_amdgcn_s_setprio(1); if constexpr (MODE == 2) { \
        _Pragma("unroll") for (int m = 0; m < 4; ++m) _Pragma("unroll") for (int n = 0; n < 2; ++n) _Pragma("unroll") for (int k = 0; k < 2; ++k) \
        acc[ai][bj][m][n] = __builtin_bit_cast(f32x4, __builtin_amdgcn_mfma_i32_16x16x64_i8(__builtin_bit_cast(i32x4, Bt[n][k]), __builtin_bit_cast(i32x4, At[m][k]), __builtin_bit_cast(i32x4, acc[ai][bj][m][n]), 0, 0, 0)); \
        } else if constexpr (MODE == 1) { _Pragma("unroll") for (int m = 0; m < 4; ++m) _Pragma("unroll") for (int n = 0; n < 2; ++n) \
        asm volatile("v_mfma_f32_16x16x128_f8f6f4 %0, %1, %2, %0" : "+v"(acc[ai][bj][m][n]) : "v"(cat8(Bt[n][0], Bt[n][1])), "v"(cat8(At[m][0], At[m][1]))); } else { \
        _Pragma("unroll") for (int m = 0; m < 4; ++m) _Pragma("unroll") for (int n = 0; n < 2; ++n) _Pragma("unroll") for (int k = 0; k < 2; ++k) \
        acc[ai][bj][m][n] = __builtin_amdgcn_mfma_f32_16x16x32_bf16(Bt[n][k], At[m][k], acc[ai][bj][m][n], 0, 0, 0); } __builtin_amdgcn_s_setprio(0); } while (0)
#define PG8_WAIT_V(n) asm volatile("s_waitcnt vmcnt(" #n ")" ::: "memory")
#define PG8_WAIT_L(n) asm volatile("s_waitcnt lgkmcnt(" #n ")" ::: "memory")
#define PG8_BAR __builtin_amdgcn_s_barrier()
#define PG8_SCHED __builtin_amdgcn_sched_barrier(0)
    Unit cur, nxt; int ui = 0;
    if (!S.next(0, cur)) return;
    f32x4 acc[2][2][4][2];
#pragma unroll
    for (int a = 0; a < 2; ++a)
#pragma unroll
        for (int b = 0; b < 2; ++b)
#pragma unroll
            for (int m = 0; m < 4; ++m)
#pragma unroll
                for (int n = 0; n < 2; ++n) acc[a][b][m][n] = (f32x4){0.f, 0.f, 0.f, 0.f};
    bf16x8 At[4][2], B0[2][2], B1[2][2];
    unsigned vA[2][2], nvA[2][2];
    LAS unsigned char* side = lds + STAGE_BYTES;
    LAS int* lte = (LAS int*)(side + 5120);
#define PG8_TSRC(sl) ((LAS int*)(side + (sl) * 1024))
#define PG8_TBIAS(sl) ((LAS float*)(side + 2048 + (sl) * 1024))
    if constexpr (Src::SIDE) { X.load_map(lte, S.nM); __syncthreads(); }
    X.a_voff(cur, Rr, Cc, vA);
    E.side_issue(cur, PG8_TBIAS(0), lte, wid, lane);
    const char* cA = X.a_base(cur); const char* cB = X.b_base(cur, lte);
    PG8_STAGE(PG8_SB(0, 0), cB, voffB); PG8_STAGE(PG8_SB(0, 1), cB + hstep, voffB); PG8_STAGE(PG8_SA(0, 0), cA, vA[0]); PG8_STAGE(PG8_SA(0, 1), cA, vA[1]);
    if (wr == 1) PG8_BAR;
    PG8_WAIT_V(2); PG8_BAR;
    PG8_STAGE(PG8_SB(1, 0), cB + kstep, voffB); PG8_STAGE(PG8_SA(1, 0), cA + kstep, vA[0]); PG8_STAGE(PG8_SB(1, 1), cB + hstep + kstep, voffB);
    PG8_WAIT_V(6); PG8_BAR;
    for (;;) {
        const bool has_next = S.next(ui + 1, nxt);
        const char* nA = cA; const char* nB = cB;
#pragma unroll
        for (int h = 0; h < 2; ++h)
#pragma unroll
            for (int i = 0; i < 2; ++i) nvA[h][i] = vA[h][i];
        const int tsl = (ui + 1) & 1, bsl = (ui + 1) % 3;
        if (has_next) { nA = X.a_base(nxt); nB = X.b_base(nxt, lte); X.side_issue(nxt, PG8_TSRC(tsl), wid, lane); E.side_issue(nxt, PG8_TBIAS(bsl), lte, wid, lane); }
        for (int t = 0; t < nt; t += 2) {
            const bool last = (t == nt - 2);
            const char* a1 = cA + (size_t)(t + 1) * kstep;
            const char* a2 = last ? nA : cA + (size_t)(t + 2) * kstep; const char* b2 = last ? nB : cB + (size_t)(t + 2) * kstep;
            const char* a3 = a2 + kstep; const char* b3 = b2 + kstep;
            unsigned w0[2], w1[2];
            if (last && has_next) X.a_voff_side(nxt, PG8_TSRC(tsl), Rr, Cc, nvA);
            w0[0] = last ? nvA[0][0] : vA[0][0]; w0[1] = last ? nvA[0][1] : vA[0][1];
            w1[0] = last ? nvA[1][0] : vA[1][0]; w1[1] = last ? nvA[1][1] : vA[1][1];
            PG8_LDB(B0, 0, 0); PG8_LDB(B1, 0, 1); PG8_SCHED; PG8_LDA(At, 0, 0); PG8_STAGE(PG8_SA(1, 1), a1, vA[1]);
            PG8_WAIT_V(8); PG8_WAIT_L(0); PG8_BAR; PG8_MMA(0, 0, At, B0); PG8_MMA(0, 1, At, B1); PG8_BAR; PG8_SCHED;
            PG8_LDA(At, 0, 1); PG8_STAGE(PG8_SB(0, 0), b2, voffB); PG8_STAGE(PG8_SB(0, 1), b2 + hstep, voffB); PG8_STAGE(PG8_SA(0, 0), a2, w0);
            PG8_WAIT_V(8); PG8_WAIT_L(0); PG8_BAR; PG8_MMA(1, 0, At, B0); PG8_MMA(1, 1, At, B1); PG8_BAR; PG8_SCHED;
            PG8_LDB(B0, 1, 0); PG8_LDB(B1, 1, 1); PG8_SCHED; PG8_LDA(At, 1, 0); PG8_STAGE(PG8_SA(0, 1), a2, w1);
            PG8_WAIT_V(8); PG8_WAIT_L(0); PG8_BAR; PG8_MMA(0, 0, At, B0); PG8_MMA(0, 1, At, B1); PG8_BAR; PG8_SCHED;
            PG8_LDA(At, 1, 1); PG8_STAGE(PG8_SB(1, 0), b3, voffB); PG8_STAGE(PG8_SB(1, 1), b3 + hstep, voffB); PG8_STAGE(PG8_SA(1, 0), a3, w0);
            PG8_WAIT_V(8); PG8_WAIT_L(0); PG8_BAR; PG8_MMA(1, 0, At, B0); PG8_MMA(1, 1, At, B1); PG8_BAR; PG8_SCHED;
        }
        if (wr == 0) PG8_BAR;
        if constexpr (MODE == 1) asm volatile("s_nop 15\n\ts_nop 15\n\ts_nop 15" ::: "memory");
        E(acc, cur, wr, wc, fr, fq, PG8_TBIAS(ui % 3), lte);
        if (!has_next) break;
#pragma unroll
        for (int a = 0; a < 2; ++a)
#pragma unroll
            for (int b = 0; b < 2; ++b)
#pragma unroll
                for (int m = 0; m < 4; ++m)
#pragma unroll
                    for (int n = 0; n < 2; ++n) acc[a][b][m][n] = (f32x4){0.f, 0.f, 0.f, 0.f};
        cur = nxt; cA = nA; cB = nB; ++ui;
#pragma unroll
        for (int h = 0; h < 2; ++h)
#pragma unroll
            for (int i = 0; i < 2; ++i) vA[h][i] = nvA[h][i];
        if (wr == 1) PG8_BAR;
    }
    PG8_WAIT_V(0);
    PG8_BAR;
#undef PG8_TSRC
#undef PG8_TBIAS
#undef PG8_SA
#undef PG8_SB
#undef PG8_STAGE
#undef PG8_LDA
#undef PG8_LDB
#undef PG8_MMA
#undef PG8_WAIT_V
#undef PG8_WAIT_L
#undef PG8_BAR
#undef PG8_SCHED
}

struct EpiProj {
    static constexpr bool PERM = true;
    bf16_t* O; int ldc; float sc;
    __device__ __forceinline__ void side_issue(const Unit&, LAS float*, const LAS int*, int, int) const {}
    __device__ __forceinline__ void operator()(const f32x4 (&acc)[2][2][4][2], const Unit& u, int wr, int wc, int fr, int fq, const LAS float*, const LAS int*) const {
        const int row0 = u.pm * BM + wr * 64 + fr, col0 = u.pn * BM + wc * 32 + 8 * fq;
#pragma unroll
        for (int ai = 0; ai < 2; ++ai)
#pragma unroll
            for (int m = 0; m < 4; ++m) { bf16_t* rowp = O + (size_t)(row0 + ai * HALF + m * 16) * ldc + col0;
#pragma unroll
                for (int bj = 0; bj < 2; ++bj) { const f32x4 v0 = acc[ai][bj][m][0] * sc, v1 = acc[ai][bj][m][1] * sc;
                    u32x4 w; w.x = cvt_pk_bf16(v0[0], v0[1]); w.y = cvt_pk_bf16(v0[2], v0[3]); w.z = cvt_pk_bf16(v1[0], v1[1]); w.w = cvt_pk_bf16(v1[2], v1[3]);
                    *(u32x4*)(rowp + bj * HALF) = w; } }
    }
};
struct EpiProjI8 {
    static constexpr bool PERM = true;
    bf16_t* O; int ldc; const float* rs; const float* cmax;
    __device__ __forceinline__ void side_issue(const Unit&, LAS float*, const LAS int*, int, int) const {}
    __device__ __forceinline__ void operator()(const f32x4 (&acc)[2][2][4][2], const Unit& u, int wr, int wc, int fr, int fq, const LAS float*, const LAS int*) const {
        const int row0 = u.pm * BM + wr * 64 + fr, col0 = u.pn * BM + wc * 32 + 8 * fq;
        f32x4 cs[2][2];
#pragma unroll
        for (int bj = 0; bj < 2; ++bj)
#pragma unroll
            for (int n = 0; n < 2; ++n) cs[bj][n] = *(const f32x4*)(cmax + col0 + bj * HALF + n * 4) * (1.0f / 127.0f);
#pragma unroll
        for (int ai = 0; ai < 2; ++ai)
#pragma unroll
            for (int m = 0; m < 4; ++m) { const int row = row0 + ai * HALF + m * 16; bf16_t* rowp = O + (size_t)row * ldc + col0; const float r = rs[row];
#pragma unroll
                for (int bj = 0; bj < 2; ++bj) { const i32x4 a0 = __builtin_bit_cast(i32x4, acc[ai][bj][m][0]), a1 = __builtin_bit_cast(i32x4, acc[ai][bj][m][1]);
                    const f32x4 c0 = cs[bj][0] * r, c1 = cs[bj][1] * r;
                    u32x4 w; w.x = cvt_pk_bf16((float)a0[0] * c0[0], (float)a0[1] * c0[1]); w.y = cvt_pk_bf16((float)a0[2] * c0[2], (float)a0[3] * c0[3]);
                    w.z = cvt_pk_bf16((float)a1[0] * c1[0], (float)a1[1] * c1[1]); w.w = cvt_pk_bf16((float)a1[2] * c1[2], (float)a1[3] * c1[3]);
                    *(u32x4*)(rowp + bj * HALF) = w; } }
    }
};
struct EpiResid {
    static constexpr bool PERM = false;
    const float* x; float* x1; const float* gate; float sc;
    __device__ __forceinline__ void side_issue(const Unit&, LAS float*, const LAS int*, int, int) const {}
    __device__ __forceinline__ void operator()(const f32x4 (&acc)[2][2][4][2], const Unit& u, int wr, int wc, int fr, int fq, const LAS float*, const LAS int*) const {
        const int row0 = u.pm * BM + wr * 64 + fr, col0 = u.pn * BM + wc * 32 + 4 * fq;
        const float* gp = gate + ((u.pm * BM) >> 13) * 12288 + col0;
        f32x4 gv[2][2];
#pragma unroll
        for (int bj = 0; bj < 2; ++bj)
#pragma unroll
            for (int n = 0; n < 2; ++n) gv[bj][n] = *(const f32x4*)(gp + bj * HALF + n * 16) * sc;
#pragma unroll
        for (int ai = 0; ai < 2; ++ai) {
            f32x4 xs[4][2][2];
#pragma unroll
            for (int m = 0; m < 4; ++m) { const size_t off = (size_t)(row0 + ai * HALF + m * 16) * 2048 + col0;
#pragma unroll
                for (int bj = 0; bj < 2; ++bj)
#pragma unroll
                    for (int n = 0; n < 2; ++n) xs[m][bj][n] = *(const f32x4*)(x + off + bj * HALF + n * 16); }
#pragma unroll
            for (int m = 0; m < 4; ++m) { const size_t off = (size_t)(row0 + ai * HALF + m * 16) * 2048 + col0;
#pragma unroll
                for (int bj = 0; bj < 2; ++bj)
#pragma unroll
                    for (int n = 0; n < 2; ++n) *(f32x4*)(x1 + off + bj * HALF + n * 16) = xs[m][bj][n] + gv[bj][n] * acc[ai][bj][m][n]; }
            asm volatile("" ::: "memory"); }
    }
};
struct EpiGlu {
    static constexpr bool PERM = true;
    unsigned char* O; const float* b_gu;
    __device__ __forceinline__ void side_issue(const Unit& u, LAS float* bt, const LAS int* lte, int wid, int lane) const {
        if (wid >= 4) { const int w4 = wid - 4, e = lte[u.pm];
            __builtin_amdgcn_global_load_lds((const unsigned*)(b_gu + (size_t)e * 4096 + (w4 >> 1) * 2048 + u.pn * HALF + (w4 & 1) * 64 + lane), (LAS unsigned*)(bt + w4 * 64), 4, 0, 0); }
    }
    __device__ __forceinline__ void operator()(const f32x4 (&acc)[2][2][4][2], const Unit& u, int wr, int wc, int fr, int fq, const LAS float* bt, const LAS int*) const {
        const int row0 = u.pm * BM + wr * 64 + fr, col0 = u.pn * HALF + wc * 32 + 8 * fq;
        f32x2 bg4[2][2], bl1[2][2];
#pragma unroll
        for (int n = 0; n < 2; ++n) { const f32x4 g = *(const LAS f32x4*)(bt + wc * 32 + 8 * fq + 4 * n), l = *(const LAS f32x4*)(bt + HALF + wc * 32 + 8 * fq + 4 * n);
            bg4[n][0] = (f32x2){4.0f * g[0], 4.0f * g[1]}; bg4[n][1] = (f32x2){4.0f * g[2], 4.0f * g[3]}; bl1[n][0] = (f32x2){l[0] + 1.0f, l[1] + 1.0f}; bl1[n][1] = (f32x2){l[2] + 1.0f, l[3] + 1.0f}; }
#pragma unroll
        for (int ai = 0; ai < 2; ++ai)
#pragma unroll
            for (int m = 0; m < 4; ++m) { unsigned char* rowp = O + (size_t)(row0 + ai * HALF + m * 16) * 2048 + col0;
                f32x2 r[4];
#pragma unroll
                for (int n = 0; n < 2; ++n)
#pragma unroll
                    for (int hp = 0; hp < 2; ++hp) {
                        const f32x2 ga = (f32x2){acc[ai][0][m][n][2 * hp], acc[ai][0][m][n][2 * hp + 1]}, la = (f32x2){acc[ai][1][m][n][2 * hp], acc[ai][1][m][n][2 * hp + 1]};
                        f32x2 g4 = ga * (4.0f / 64.0f) + bg4[n][hp]; g4[0] = fminf(g4[0], 28.0f); g4[1] = fminf(g4[1], 28.0f);
                        f32x2 l1 = la * (1.0f / 64.0f) + bl1[n][hp]; l1[0] = __builtin_amdgcn_fmed3f(l1[0], -6.0f, 8.0f); l1[1] = __builtin_amdgcn_fmed3f(l1[1], -6.0f, 8.0f);
                        const f32x2 z = g4 * (-1.702f * LOG2E * 0.25f);
                        f32x2 d = (f32x2){__builtin_amdgcn_exp2f(z[0]), __builtin_amdgcn_exp2f(z[1])} + 1.0f;
                        const f32x2 sg = (f32x2){__builtin_amdgcn_rcpf(d[0]), __builtin_amdgcn_rcpf(d[1])};
                        r[n * 2 + hp] = (g4 * sg) * l1; }
                u32x2 w; w.x = pack4_fp8(r[0][0], r[0][1], r[1][0], r[1][1]); w.y = pack4_fp8(r[2][0], r[2][1], r[3][0], r[3][1]);
                *(u32x2*)rowp = w; }
    }
};
struct EpiDown {
    static constexpr bool PERM = true;
    unsigned char* O; const float* b_down;
    __device__ __forceinline__ void side_issue(const Unit& u, LAS float* bt, const LAS int* lte, int wid, int lane) const {
        if (wid >= 4) { const int w4 = wid - 4, e = lte[u.pm];
            __builtin_amdgcn_global_load_lds((const unsigned*)(b_down + (size_t)e * 2048 + u.pn * BM + w4 * 64 + lane), (LAS unsigned*)(bt + w4 * 64), 4, 0, 0); }
    }
    __device__ __forceinline__ void operator()(const f32x4 (&acc)[2][2][4][2], const Unit& u, int wr, int wc, int fr, int fq, const LAS float* bt, const LAS int*) const {
        const int row0 = u.pm * BM + wr * 64 + fr, col0 = u.pn * BM + wc * 32 + 8 * fq;
        f32x4 bv[2][2];
#pragma unroll
        for (int bj = 0; bj < 2; ++bj)
#pragma unroll
            for (int n = 0; n < 2; ++n) bv[bj][n] = *(const LAS f32x4*)(bt + bj * HALF + wc * 32 + 8 * fq + 4 * n) * 16.0f;
#pragma unroll
        for (int ai = 0; ai < 2; ++ai)
#pragma unroll
            for (int m = 0; m < 4; ++m) { unsigned char* rowp = O + (size_t)(row0 + ai * HALF + m * 16) * 2048 + col0;
#pragma unroll
                for (int bj = 0; bj < 2; ++bj) { const f32x4 v0 = acc[ai][bj][m][0] * (16.0f / 256.0f) + bv[bj][0], v1 = acc[ai][bj][m][1] * (16.0f / 256.0f) + bv[bj][1];
                    u32x2 w; w.x = pack4_fp8(v0[0], v0[1], v0[2], v0[3]); w.y = pack4_fp8(v1[0], v1[1], v1[2], v1[3]);
                    *(u32x2*)(rowp + bj * HALF) = w; } }
    }
};
}

struct Frame {
    LAS unsigned char* lds; int tid, lane, wave, G, bid;
    unsigned char* ws;
};
#define WSP(T, off) ((T*)(F.ws + (off)))

struct TileInfo { const float* src; unsigned char* dst; int ld, colA, colB, f8, n0, pad_; };
__device__ __forceinline__ TileInfo conv_decode(const Params& p, const Frame& F, int i) {
    TileInfo t;
    if (i < 896) { const int kt = i / 28, nt = i % 28, r0 = nt * 256; t.colA = r0 < 3072 ? r0 : r0 + 8; t.colB = t.colA + 128; t.ld = 7176;
        t.src = p.w_in + (size_t)kt * 64 * 7176; t.f8 = IN_MODE; t.n0 = r0; t.pad_ = 0; t.dst = F.ws + WS_WIN + (IN_MODE ? (size_t)r0 * 2048 + kt * 64 : ((size_t)r0 * 2048 + kt * 64) * 2); }
    else { const int j = i - 896, kt = j / 8, nt = j % 8; t.colA = nt * 256; t.colB = t.colA + 128; t.ld = 2048;
        t.src = p.w_out + (size_t)kt * 64 * 2048; t.f8 = FP8_OUT != 0; t.n0 = 0; t.pad_ = 0; t.dst = F.ws + WS_WOUT + (FP8_OUT ? (size_t)nt * 256 * 2048 + kt * 64 : ((size_t)nt * 256 * 2048 + kt * 64) * 2); }
    return t;
}
constexpr int CONV_TILES = 1152;
constexpr int CONV8_TILES = 16384 + 8192;
struct Tile8 { const float* src; unsigned char* dst; int ld; };
__device__ __forceinline__ Tile8 conv8_decode(const Params& p, const Frame& F, int i) {
    Tile8 t;
    if (i < 16384) { const int e = i / 512, r = i % 512, kt = r / 32, nt = r % 32, pn = nt >> 1, half = nt & 1; t.ld = 4096;
        t.src = p.w_gu + (size_t)e * 2048 * 4096 + (size_t)kt * 128 * 4096 + half * 2048 + pn * 128; t.dst = F.ws + WS_WGU + ((size_t)e * 4096 + nt * 128) * 2048 + kt * 128; }
    else { const int j = i - 16384, e = j / 256, r = j % 256, kt = r / 16, nt = r % 16; t.ld = 2048;
        t.src = p.w_down + (size_t)e * 2048 * 2048 + (size_t)kt * 128 * 2048 + nt * 128; t.dst = F.ws + WS_WDN + ((size_t)e * 2048 + nt * 128) * 2048 + kt * 128; }
    return t;
}
__device__ __forceinline__ void conv8_load(const Tile8& t, int g, int kq, f32x4 (&L)[2][4]) {
#pragma unroll
    for (int i = 0; i < 2; ++i)
#pragma unroll
        for (int r = 0; r < 4; ++r) L[i][r] = __builtin_nontemporal_load((const f32x4*)(t.src + (size_t)(4 * (kq + 16 * i) + r) * t.ld + 4 * g));
}
__device__ __forceinline__ void conv_load(const TileInfo& t, int g, int kq, f32x4 (&L)[4][2]) {
    const int col = g < 32 ? t.colA + 4 * g : t.colB + 4 * (g - 32);
#pragma unroll
    for (int i = 0; i < 4; ++i) { const int k0 = t.f8 ? 4 * (kq + 8 * (i >> 1)) + 2 * (i & 1) : 2 * (kq + 8 * i);
        L[i][0] = *(const f32x4*)(t.src + (size_t)k0 * t.ld + col);
        L[i][1] = *(const f32x4*)(t.src + (size_t)(k0 + 1) * t.ld + col); }
}
template <int KIND>
__device__ __forceinline__ void wtile_pass(const Params& p, const Frame& F, int lo, int hi) {
    const int tid = F.tid;
    LAS unsigned* tt = (LAS unsigned*)F.lds;
    const int g = tid & 63, kq = tid >> 6;
    f32x4 cur[4][2], nxt[4][2];
    int i = lo + F.bid;
    TileInfo ti;
    if (i < hi) { ti = conv_decode(p, F, i); conv_load(ti, g, kq, cur); }
    while (i < hi) {
        const int inext = i + F.G;
        TileInfo tn = ti;
        if (inext < hi) { tn = conv_decode(p, F, inext); conv_load(tn, g, kq, nxt); }
        if constexpr (KIND == 1) {
            f32x4 m = __builtin_elementwise_max(__builtin_elementwise_abs(cur[0][0]), __builtin_elementwise_abs(cur[0][1]));
#pragma unroll
            for (int q = 1; q < 4; ++q) m = __builtin_elementwise_max(m, __builtin_elementwise_max(__builtin_elementwise_abs(cur[q][0]), __builtin_elementwise_abs(cur[q][1])));
            *(LAS f32x4*)((LAS float*)tt + kq * 256 + 4 * g) = m;
            __syncthreads();
            if (tid < 256) { float v = ((LAS float*)tt)[tid];
#pragma unroll
                for (int w = 1; w < 8; ++w) v = fmaxf(v, ((LAS float*)tt)[w * 256 + tid]);
                __hip_atomic_fetch_max((unsigned*)(F.ws + WS_CMAX) + ti.n0 + tid, __float_as_uint(v), __ATOMIC_RELAXED, __HIP_MEMORY_SCOPE_AGENT); }
        } else if (ti.f8 == 2) {
            const f32x4 cm = *(const f32x4*)((const float*)(F.ws + WS_CMAX) + ti.n0 + 4 * g);
            f32x4 inv;
#pragma unroll
            for (int j = 0; j < 4; ++j) inv[j] = cm[j] > 0.f ? 127.0f / cm[j] : 0.f;
#pragma unroll
            for (int q = 0; q < 2; ++q)
#pragma unroll
                for (int j = 0; j < 4; ++j) tt[(4 * g + j) * 17 + kq + 8 * q] = pack4_i8(inv[j] * cur[2 * q][0][j], inv[j] * cur[2 * q][1][j], inv[j] * cur[2 * q + 1][0][j], inv[j] * cur[2 * q + 1][1][j]);
            __syncthreads();
#pragma unroll
            for (int r = 0; r < 2; ++r) { const int q = tid + 512 * r, n = q >> 2, ch = q & 3;
                u32x4 v; v.x = tt[n * 17 + ch * 4 + 0]; v.y = tt[n * 17 + ch * 4 + 1]; v.z = tt[n * 17 + ch * 4 + 2]; v.w = tt[n * 17 + ch * 4 + 3];
                *(u32x4*)(ti.dst + (size_t)n * 2048 + ch * 16) = v; }
        } else if (ti.f8) {
#pragma unroll
            for (int q = 0; q < 2; ++q)
#pragma unroll
                for (int j = 0; j < 4; ++j) tt[(4 * g + j) * 17 + kq + 8 * q] = pack4_fp8(64.0f * cur[2 * q][0][j], 64.0f * cur[2 * q][1][j], 64.0f * cur[2 * q + 1][0][j], 64.0f * cur[2 * q + 1][1][j]);
            __syncthreads();
#pragma unroll
            for (int r = 0; r < 2; ++r) { const int q = tid + 512 * r, n = q >> 2, ch = q & 3;
                u32x4 v; v.x = tt[n * 17 + ch * 4 + 0]; v.y = tt[n * 17 + ch * 4 + 1]; v.z = tt[n * 17 + ch * 4 + 2]; v.w = tt[n * 17 + ch * 4 + 3];
                *(u32x4*)(ti.dst + (size_t)n * 2048 + ch * 16) = v; }
        } else {
#pragma unroll
            for (int q = 0; q < 4; ++q)
#pragma unroll
                for (int j = 0; j < 4; ++j) tt[(4 * g + j) * 33 + kq + 8 * q] = cvt_pk_bf16(cur[q][0][j], cur[q][1][j]);
            __syncthreads();
#pragma unroll
            for (int r = 0; r < 4; ++r) { const int q = tid + 512 * r, n = q >> 3, ch = q & 7;
                u32x4 v; v.x = tt[n * 33 + ch * 4 + 0]; v.y = tt[n * 33 + ch * 4 + 1]; v.z = tt[n * 33 + ch * 4 + 2]; v.w = tt[n * 33 + ch * 4 + 3];
                *(u32x4*)(ti.dst + (size_t)n * 4096 + ch * 16) = v; }
        }
        __syncthreads();
#pragma unroll
        for (int q = 0; q < 4; ++q) { cur[q][0] = nxt[q][0]; cur[q][1] = nxt[q][1]; }
        ti = tn; i = inext;
    }
}


__device__ __forceinline__ void phase0(const Params& p, const Frame& F) {
    const int tid = F.tid;
    LAS float* cs = (LAS float*)F.lds;
    LAS float* red = cs + 4096;
    for (int i = tid; i < 4096; i += 512) { const float v = p.c[i]; cs[i] = v / (1.0f + expf(-v)); }
    __syncthreads();
    float* modp = WSP(float, WS_MODP);
    for (int u = F.bid; u < 384; u += F.G) {
        const int cc = u % 48, dc = u / 48, w = F.wave, lane = F.lane;
        const int d0 = dc * 256 + w * 32;
        const float* wp = p.w_ada + (size_t)d0 * 12288 + cc * 256 + lane * 4;
        f32x4 a0 = {0.f, 0.f, 0.f, 0.f}, a1 = {0.f, 0.f, 0.f, 0.f};
#pragma unroll 8
        for (int i = 0; i < 32; ++i) { const f32x4 v = *(const f32x4*)(wp + (size_t)i * 12288); const float c0 = cs[d0 + i], c1 = cs[2048 + d0 + i]; a0 += v * c0; a1 += v * c1; }
        *(LAS f32x4*)(red + (w * 2 + 0) * 256 + lane * 4) = a0;
        *(LAS f32x4*)(red + (w * 2 + 1) * 256 + lane * 4) = a1;
        __syncthreads();
        { const int b = tid >> 8, col = tid & 255; float s = 0.f;
#pragma unroll
          for (int w8 = 0; w8 < 8; ++w8) s += red[(w8 * 2 + b) * 256 + col];
          modp[(dc * 2 + b) * 12288 + cc * 256 + col] = s; }
        __syncthreads();
    }
#if IN_MODE == 2
    wtile_pass<1>(p, F, 0, 896);
    wtile_pass<0>(p, F, 896, CONV_TILES);
#else
    wtile_pass<0>(p, F, 0, CONV_TILES);
#endif
}

__device__ __forceinline__ void conv8_range(const Params& p, const Frame& F, int first, int stride) {
    const int tid = F.tid;
    LAS unsigned* tt = (LAS unsigned*)F.lds;
    const int g8 = tid & 31, kq8 = tid >> 5;
    f32x4 r0[2][4], r1[2][4], r2[2][4], r3[2][4], r4[2][4]; Tile8 t0, t1, t2, t3, t4;
#define C8_PROCESS(R, T) do { \
        _Pragma("unroll") for (int q = 0; q < 2; ++q) _Pragma("unroll") for (int j = 0; j < 4; ++j) \
            tt[(4 * g8 + j) * 33 + kq8 + 16 * q] = pack4_fp8(64.0f * R[q][0][j], 64.0f * R[q][1][j], 64.0f * R[q][2][j], 64.0f * R[q][3][j]); \
        __syncthreads(); \
        _Pragma("unroll") for (int r = 0; r < 2; ++r) { const int q = tid + 512 * r, n = q >> 3, ch = q & 7; \
            u32x4 v; v.x = tt[n * 33 + ch * 4 + 0]; v.y = tt[n * 33 + ch * 4 + 1]; v.z = tt[n * 33 + ch * 4 + 2]; v.w = tt[n * 33 + ch * 4 + 3]; \
            __builtin_nontemporal_store(v, (u32x4*)(T.dst + (size_t)n * 2048 + ch * 16)); } \
        __syncthreads(); } while (0)
#define C8_FETCH(R, T, idx) do { if ((idx) < CONV8_TILES) { T = conv8_decode(p, F, (idx)); conv8_load(T, g8, kq8, R); } } while (0)
    int i = first;
    C8_FETCH(r0, t0, i); C8_FETCH(r1, t1, i + stride); C8_FETCH(r2, t2, i + 2 * stride); C8_FETCH(r3, t3, i + 3 * stride);
    for (;;) {
        if (i >= CONV8_TILES) break;
        C8_FETCH(r4, t4, i + 4 * stride); C8_PROCESS(r0, t0); i += stride;
        if (i >= CONV8_TILES) break;
        C8_FETCH(r0, t0, i + 4 * stride); C8_PROCESS(r1, t1); i += stride;
        if (i >= CONV8_TILES) break;
        C8_FETCH(r1, t1, i + 4 * stride); C8_PROCESS(r2, t2); i += stride;
        if (i >= CONV8_TILES) break;
        C8_FETCH(r2, t2, i + 4 * stride); C8_PROCESS(r3, t3); i += stride;
        if (i >= CONV8_TILES) break;
        C8_FETCH(r3, t3, i + 4 * stride); C8_PROCESS(r4, t4); i += stride;
    }
#undef C8_FETCH
#undef C8_PROCESS
}

__device__ __forceinline__ void phase1(const Params& p, const Frame& F) {
    const int tid = F.tid, lane = F.lane;
    LAS float* wfT = (LAS float*)F.lds;
    LAS float* a1 = wfT + 8 * 2048;
    LAS float* s1 = a1 + 4096;
    const float* modp = WSP(float, WS_MODP);
    for (int q = tid; q < 4096; q += 512) { const int d = q >> 1, hf = q & 1; const f32x4 v = *(const f32x4*)(p.w_in + (size_t)d * 7176 + 3072 + hf * 4);
#pragma unroll
        for (int j = 0; j < 4; ++j) wfT[(hf * 4 + j) * 2048 + d] = v[j]; }
    for (int q = tid; q < 8192; q += 512) { const int b = q >> 12, r = q & 4095; float s = p.b_ada[r];
#pragma unroll
        for (int dc = 0; dc < 8; ++dc) s += modp[(dc * 2 + b) * 12288 + r];
        if (r < 2048) s1[b * 2048 + r] = s; else a1[b * 2048 + (r - 2048)] = p.g1[r - 2048] * (1.0f + s); }
    float* mod = WSP(float, WS_MOD);
    for (int q = F.bid * 512 + tid; q < 24576; q += F.G * 512) { const int b = q / 12288, r = q % 12288; float s = p.b_ada[r];
#pragma unroll
        for (int dc = 0; dc < 8; ++dc) s += modp[(dc * 2 + b) * 12288 + r];
        mod[q] = s; }
    __syncthreads();
    bf16_t* H1 = WSP(bf16_t, WS_H1); float* LOGF = WSP(float, WS_LOGF);
    for (int t = F.bid * 8 + F.wave; t < T_; t += F.G * 8) {
        asm volatile("" ::: "memory");
        const int b = t >> 13;
        const float* xr = p.x + (size_t)t * 2048;
        f32x4 v[8]; float ss = 0.f;
#pragma unroll
        for (int i = 0; i < 8; ++i) { v[i] = *(const f32x4*)(xr + (i * 64 + lane) * 4); ss += v[i][0] * v[i][0] + v[i][1] * v[i][1] + v[i][2] * v[i][2] + v[i][3] * v[i][3]; }
        ss = wave_sum(ss);
        const float rstd = rsqrtf(ss * (1.0f / 2048.0f) + EPS);
        float acc[8];
#pragma unroll
        for (int j = 0; j < 8; ++j) acc[j] = 0.f;
#if IN_MODE == 2
        float amax = 0.f;
#pragma unroll
        for (int i = 0; i < 8; ++i) { const int d = (i * 64 + lane) * 4;
            const f32x4 a = *(const LAS f32x4*)(a1 + b * 2048 + d), s = *(const LAS f32x4*)(s1 + b * 2048 + d);
            const f32x4 h = v[i] * rstd * a + s;
            amax = fmaxf(fmaxf(amax, fmaxf(fabsf(h[0]), fabsf(h[1]))), fmaxf(fabsf(h[2]), fabsf(h[3]))); }
#pragma unroll
        for (int o = 32; o > 0; o >>= 1) amax = fmaxf(amax, __shfl_xor(amax, o));
        const float qinv = amax > 0.f ? 127.0f / amax : 0.f;
        if (lane == 0) WSP(float, WS_RS)[t] = amax * (1.0f / 127.0f);
        asm volatile("" ::: "memory");
#pragma unroll
        for (int i = 0; i < 8; ++i) { const int d = (i * 64 + lane) * 4;
            const f32x4 a = *(const LAS f32x4*)(a1 + b * 2048 + d), s = *(const LAS f32x4*)(s1 + b * 2048 + d);
            const f32x4 h = v[i] * rstd * a + s;
            *(unsigned*)((unsigned char*)H1 + (size_t)t * 2048 + d) = pack4_i8(qinv * h[0], qinv * h[1], qinv * h[2], qinv * h[3]);
#pragma unroll
            for (int j = 0; j < 8; ++j) { const f32x4 wv = *(const LAS f32x4*)(wfT + j * 2048 + d); acc[j] += h[0] * wv[0] + h[1] * wv[1] + h[2] * wv[2] + h[3] * wv[3]; } }
#else
#pragma unroll
        for (int i = 0; i < 8; ++i) { const int d = (i * 64 + lane) * 4;
            const f32x4 a = *(const LAS f32x4*)(a1 + b * 2048 + d), s = *(const LAS f32x4*)(s1 + b * 2048 + d);
            const f32x4 h = v[i] * rstd * a + s;
#if IN_MODE == 1
            *(unsigned*)((unsigned char*)H1 + (size_t)t * 2048 + d) = pack4_fp8(4.0f * h[0], 4.0f * h[1], 4.0f * h[2], 4.0f * h[3]);
#else
            u32x2 w; w.x = cvt_pk_bf16(h[0], h[1]); w.y = cvt_pk_bf16(h[2], h[3]);
            *(u32x2*)(H1 + (size_t)t * 2048 + d) = w;
#endif
#pragma unroll
            for (int j = 0; j < 8; ++j) { const f32x4 wv = *(const LAS f32x4*)(wfT + j * 2048 + d); acc[j] += h[0] * wv[0] + h[1] * wv[1] + h[2] * wv[2] + h[3] * wv[3]; } }
#endif
        float z = 0.f;
#pragma unroll
        for (int j = 0; j < 8; ++j) { const float r = wave_sum(acc[j]); if (lane == j) z = r; }
        if (lane < 8) { z += p.b_fgate[lane]; LOGF[(size_t)t * 8 + lane] = fminf(z, 0.f) - log1pf(expf(-fabsf(z))); }
    }
}

__device__ __forceinline__ void cum_scan(const Frame& F) {
    const int tid = F.tid;
    LAS float* sc = (LAS float*)F.lds;
    const float* LOGF = WSP(float, WS_LOGF); float* CUM = WSP(float, WS_CUM);
    for (int seq = F.bid; seq < 16; seq += F.G) { const int b = seq >> 3, h = seq & 7;
        float v[16]; float run = 0.f; const size_t base = (size_t)b * S_ + tid * 16;
#pragma unroll
        for (int i = 0; i < 16; ++i) { run += LOGF[(base + i) * 8 + h]; v[i] = run; }
        sc[tid] = run; __syncthreads();
        for (int off = 1; off < 512; off <<= 1) { const float tv = tid >= off ? sc[tid - off] : 0.f; __syncthreads(); sc[tid] += tv; __syncthreads(); }
        const float excl = tid ? sc[tid - 1] : 0.f;
#pragma unroll
        for (int i = 0; i < 16; ++i) CUM[(size_t)seq * S_ + tid * 16 + i] = excl + v[i];
        __syncthreads();
    }
}

constexpr int AT_KS = 288;
__device__ __forceinline__ void attn_unit(const Frame& F, int bh, int qb) {
    const int tid = F.tid, lane = F.lane, w = F.wave, fr = lane & 15, fq = lane >> 4;
    const int b = bh >> 3, h = bh & 7;
    const bf16_t* proj = WSP(bf16_t, WS_PROJ) + (size_t)b * S_ * NPROJ + h * 128;
    const bf16_t* Qp = proj + C_FQ; const bf16_t* Kp = proj + C_FK; const bf16_t* Vp = proj + C_FV;
    const float* cum = WSP(float, WS_CUM) + (size_t)bh * S_;
    LAS unsigned char* Kt = F.lds;
    LAS unsigned char* Vt = F.lds + 2 * 64 * AT_KS;
    LAS float* cs = (LAS float*)(F.lds + 4 * 64 * AT_KS);
    const int r0 = qb * 128 + w * 16;
    const int qpos = r0 + fr;
    bf16x8 qf[4];
#pragma unroll
    for (int ks = 0; ks < 4; ++ks) qf[ks] = *(const bf16x8*)(Qp + (size_t)qpos * NPROJ + ks * 32 + fq * 8);
    const float cq = cum[qpos] * LOG2E;
    const int ntiles = 2 * qb + 2;
    const float SC2 = 0.08838834764831845f * LOG2E;
    LAS float* wmax = cs + 128;
    LAS int* shi = (LAS int*)(cs + 136);
    float qn = 0.f, sdiag = 0.f;
    {
#pragma unroll
      for (int ks = 0; ks < 4; ++ks) { const u32x4 v = __builtin_bit_cast(u32x4, qf[ks]); const u32x4 kk = *(const u32x4*)(Kp + (size_t)qpos * NPROJ + ks * 32 + fq * 8);
          const float q0 = bflo(v.x), q1 = bfhi(v.x), q2 = bflo(v.y), q3 = bfhi(v.y), q4 = bflo(v.z), q5 = bfhi(v.z), q6 = bflo(v.w), q7 = bfhi(v.w);
          qn += q0 * q0 + q1 * q1 + q2 * q2 + q3 * q3 + q4 * q4 + q5 * q5 + q6 * q6 + q7 * q7;
          sdiag += q0 * bflo(kk.x) + q1 * bfhi(kk.x) + q2 * bflo(kk.y) + q3 * bfhi(kk.y) + q4 * bflo(kk.z) + q5 * bfhi(kk.z) + q6 * bflo(kk.w) + q7 * bfhi(kk.w); }
      qn += __shfl_xor(qn, 16); qn += __shfl_xor(qn, 32); sdiag += __shfl_xor(sdiag, 16); sdiag += __shfl_xor(sdiag, 32);
      if (tid < 2) shi[tid] = 0; }
    __syncthreads();
    float ce = 0.f;
    if (tid < ntiles) { const float kv = WSP(float, WS_KN)[bh * 128 + tid]; ce = cum[(tid + 1) * 64 - 1] * LOG2E; atomicMax((int*)(shi + 0), __float_as_int(kv)); }
    __syncthreads();
    { float rt = SC2 * sqrtf(qn) * sqrtf(__int_as_float(shi[0])) * 1.001f + cq - SC2 * sdiag;
#pragma unroll
      for (int o = 8; o >= 1; o >>= 1) rt = fmaxf(rt, __shfl_xor(rt, o));
      if (lane == 0) wmax[w] = rt; }
    __syncthreads();
    { float rmax = wmax[0];
#pragma unroll
      for (int i = 1; i < 8; ++i) rmax = fmaxf(rmax, wmax[i]);
      const float bound = rmax - ce + 0.02f;
      if (tid < 2 * qb && bound < -40.0f) atomicMax((int*)(shi + 1), tid + 1); }
    __syncthreads();
    const int j_lo = shi[1];
    float m = -1e30f, l = 0.f;
    f32x4 oT[8];
#pragma unroll
    for (int n = 0; n < 8; ++n) oT[n] = (f32x4){0.f, 0.f, 0.f, 0.f};
    const int skey = tid >> 3, sc16 = (tid & 7) * 16;
    u32x4 kA0, kA1, vA0, vA1, kB0, kB1, vB0, vB1; float cA = 0.f, cB = 0.f;
#define AT_LOAD(S_, j) do { const size_t ro = (size_t)((j) * 64 + skey) * NPROJ + sc16; \
        k##S_##0 = *(const u32x4*)(Kp + ro); k##S_##1 = *(const u32x4*)(Kp + ro + 8); v##S_##0 = *(const u32x4*)(Vp + ro); v##S_##1 = *(const u32x4*)(Vp + ro + 8); \
        if (tid < 64) c##S_ = cum[(j) * 64 + tid]; } while (0)
#define AT_WRITE(S_, buf) do { LAS unsigned char* kd = Kt + (buf) * 64 * AT_KS + skey * AT_KS + sc16 * 2; LAS unsigned char* vd = Vt + (buf) * 64 * AT_KS + skey * AT_KS + sc16 * 2; \
        *(LAS u32x4*)kd = k##S_##0; *(LAS u32x4*)(kd + 16) = k##S_##1; *(LAS u32x4*)vd = v##S_##0; *(LAS u32x4*)(vd + 16) = v##S_##1; if (tid < 64) cs[(buf) * 64 + tid] = c##S_ * LOG2E; } while (0)
#define AT_COMPUTE(j, buf) do { \
        const LAS unsigned char* kb = Kt + (buf) * 64 * AT_KS; \
        f32x4 st[4]; \
        _Pragma("unroll") for (int kt = 0; kt < 4; ++kt) { st[kt] = (f32x4){0.f, 0.f, 0.f, 0.f}; \
            _Pragma("unroll") for (int ks = 0; ks < 4; ++ks) { const bf16x8 a = *(const LAS bf16x8*)(kb + (kt * 16 + fr) * AT_KS + (ks * 32 + fq * 8) * 2); \
                st[kt] = __builtin_amdgcn_mfma_f32_16x16x32_bf16(a, qf[ks], st[kt], 0, 0, 0); } } \
        const int kbase = (j) * 64; \
        const bool diag = (kbase + 63 > r0); \
        float mx = -1e30f; \
        if (diag) {     \
            _Pragma("unroll") for (int kt = 0; kt < 4; ++kt) { const f32x4 ck = *(const LAS f32x4*)(cs + (buf) * 64 + kt * 16 + fq * 4); \
                _Pragma("unroll") for (int i = 0; i < 4; ++i) { float s2 = st[kt][i] * SC2 + (cq - ck[i]); \
                    if (kbase + kt * 16 + fq * 4 + i > qpos) s2 = -__builtin_inff(); \
                    st[kt][i] = s2; mx = fmaxf(mx, s2); } } \
        } else { \
            _Pragma("unroll") for (int kt = 0; kt < 4; ++kt) { const f32x4 ck = *(const LAS f32x4*)(cs + (buf) * 64 + kt * 16 + fq * 4); \
                _Pragma("unroll") for (int i = 0; i < 4; ++i) { const float s2 = st[kt][i] * SC2 + (cq - ck[i]); st[kt][i] = s2; mx = fmaxf(mx, s2); } } \
        } \
        mx = fmaxf(mx, __shfl_xor(mx, 16)); mx = fmaxf(mx, __shfl_xor(mx, 32)); \
        const float mn = fmaxf(m, mx); \
        const float alpha = __builtin_amdgcn_exp2f(m - mn); \
        m = mn; \
        float ps = 0.f; \
        _Pragma("unroll") for (int kt = 0; kt < 4; ++kt) \
            _Pragma("unroll") for (int i = 0; i < 4; ++i) { const float pv = __builtin_amdgcn_exp2f(st[kt][i] - mn); st[kt][i] = pv; ps += pv; } \
        ps += __shfl_xor(ps, 16); ps += __shfl_xor(ps, 32); \
        l = l * alpha + ps; \
        _Pragma("unroll") for (int n = 0; n < 8; ++n) oT[n] *= alpha; \
        bf16x8 pf[2]; \
        _Pragma("unroll") for (int kk = 0; kk < 2; ++kk) { u32x4 pw; pw.x = cvt_pk_bf16(st[2 * kk][0], st[2 * kk][1]); pw.y = cvt_pk_bf16(st[2 * kk][2], st[2 * kk][3]); \
            pw.z = cvt_pk_bf16(st[2 * kk + 1][0], st[2 * kk + 1][1]); pw.w = cvt_pk_bf16(st[2 * kk + 1][2], st[2 * kk + 1][3]); pf[kk] = __builtin_bit_cast(bf16x8, pw); } \
        const unsigned vaddr = (unsigned)(uintptr_t)(Vt + (buf) * 64 * AT_KS) + (unsigned)((fq * 4 + (fr >> 2)) * AT_KS + (fr & 3) * 8); \
        s16x4 va[8][4]; \
          \
        _Pragma("unroll") for (int g2 = 0; g2 < 5; ++g2) { \
            if (g2 < 4) asm volatile("ds_read_b64_tr_b16 %0, %8 offset:%9\n\tds_read_b64_tr_b16 %1, %8 offset:%10\n\tds_read_b64_tr_b16 %2, %8 offset:%11\n\tds_read_b64_tr_b16 %3, %8 offset:%12\n\t" \
                         "ds_read_b64_tr_b16 %4, %8 offset:%13\n\tds_read_b64_tr_b16 %5, %8 offset:%14\n\tds_read_b64_tr_b16 %6, %8 offset:%15\n\tds_read_b64_tr_b16 %7, %8 offset:%16" \
                         : "=&v"(va[2 * (g2 & 3) + 0][0]), "=&v"(va[2 * (g2 & 3) + 0][1]), "=&v"(va[2 * (g2 & 3) + 0][2]), "=&v"(va[2 * (g2 & 3) + 0][3]), \
                           "=&v"(va[2 * (g2 & 3) + 1][0]), "=&v"(va[2 * (g2 & 3) + 1][1]), "=&v"(va[2 * (g2 & 3) + 1][2]), "=&v"(va[2 * (g2 & 3) + 1][3]) \
                         : "v"(vaddr), \
                           "i"((2 * (g2 & 3) + 0) * 32), "i"(16 * AT_KS + (2 * (g2 & 3) + 0) * 32), "i"(32 * AT_KS + (2 * (g2 & 3) + 0) * 32), "i"(48 * AT_KS + (2 * (g2 & 3) + 0) * 32), \
                           "i"((2 * (g2 & 3) + 1) * 32), "i"(16 * AT_KS + (2 * (g2 & 3) + 1) * 32), "i"(32 * AT_KS + (2 * (g2 & 3) + 1) * 32), "i"(48 * AT_KS + (2 * (g2 & 3) + 1) * 32) : "memory"); \
            if (g2 >= 1) { \
                if (g2 < 4) asm volatile("s_waitcnt lgkmcnt(8)" ::: "memory"); else asm volatile("s_waitcnt lgkmcnt(0)" ::: "memory"); \
                __builtin_amdgcn_sched_barrier(0);     \
                _Pragma("unroll") for (int nn = 0; nn < 2; ++nn) { const int n = 2 * (g2 - 1) + nn; \
                    const bf16x8 v0 = (bf16x8){va[n][0][0], va[n][0][1], va[n][0][2], va[n][0][3], va[n][1][0], va[n][1][1], va[n][1][2], va[n][1][3]}; \
                    const bf16x8 v1 = (bf16x8){va[n][2][0], va[n][2][1], va[n][2][2], va[n][2][3], va[n][3][0], va[n][3][1], va[n][3][2], va[n][3][3]}; \
                    oT[n] = __builtin_amdgcn_mfma_f32_16x16x32_bf16(v0, pf[0], oT[n], 0, 0, 0); \
                    oT[n] = __builtin_amdgcn_mfma_f32_16x16x32_bf16(v1, pf[1], oT[n], 0, 0, 0); } } } \
    } while (0)
    AT_LOAD(A, j_lo); AT_WRITE(A, 0);
    if (j_lo + 1 < ntiles) AT_LOAD(B, j_lo + 1);
    __syncthreads();
    for (int j = j_lo; j < ntiles; j += 2) {
        {
            if (j + 2 < ntiles) AT_LOAD(A, j + 2);
            AT_COMPUTE(j, 0);
            if (j + 1 < ntiles) AT_WRITE(B, 1);
            __syncthreads();
        }
        if (j + 1 < ntiles) {
            if (j + 3 < ntiles) AT_LOAD(B, j + 3);
            AT_COMPUTE(j + 1, 1);
            if (j + 2 < ntiles) AT_WRITE(A, 0);
            __syncthreads();
        }
    }
#undef AT_LOAD
#undef AT_WRITE
#undef AT_COMPUTE
    const float rl = 1.0f / l;
    float ssq = 0.f;
    bf16_t* orow = WSP(bf16_t, WS_MIXED) + ((size_t)b * S_ + qpos) * 2048 + h * 128 + fq * 4;
#pragma unroll
    for (int n = 0; n < 8; ++n) { const f32x4 o = oT[n] * rl; ssq += o[0] * o[0] + o[1] * o[1] + o[2] * o[2] + o[3] * o[3];
        u32x2 wv; wv.x = cvt_pk_bf16(o[0], o[1]); wv.y = cvt_pk_bf16(o[2], o[3]); *(u32x2*)(orow + n * 16) = wv; }
    ssq += __shfl_xor(ssq, 16); ssq += __shfl_xor(ssq, 32);
    if (fq == 0) WSP(float, WS_SSQ)[((size_t)b * S_ + qpos) * 8 + h] = ssq;
    __syncthreads();
}


__device__ __forceinline__ void knorm_pass(const Frame& F) {
    const int lane = F.lane, r = lane >> 4, c = lane & 15;
    float* KN = WSP(float, WS_KN);
    for (int u = F.bid * 8 + F.wave; u < 2048; u += F.G * 8) { const int bh = u >> 7, j = u & 127, b = bh >> 3, h = bh & 7;
        const bf16_t* kp = WSP(bf16_t, WS_PROJ) + ((size_t)b * S_ + j * 64 + r) * NPROJ + C_FK + h * 128 + c * 8;
        float mx = 0.f;
#pragma unroll
        for (int it = 0; it < 16; ++it) { const u32x4 v = *(const u32x4*)(kp + (size_t)it * 4 * NPROJ);
            float s = bflo(v.x) * bflo(v.x) + bfhi(v.x) * bfhi(v.x) + bflo(v.y) * bflo(v.y) + bfhi(v.y) * bfhi(v.y) + bflo(v.z) * bflo(v.z) + bfhi(v.z) * bfhi(v.z) + bflo(v.w) * bflo(v.w) + bfhi(v.w) * bfhi(v.w);
#pragma unroll
            for (int o = 8; o >= 1; o >>= 1) s += __shfl_xor(s, o);
            mx = fmaxf(mx, s); }
        mx = fmaxf(mx, __shfl_xor(mx, 16)); mx = fmaxf(mx, __shfl_xor(mx, 32));
        if (lane == 0) KN[u] = mx; }
}

__device__ __forceinline__ void hg_load_col(const Frame& F, int bh, int n, int colbase, unsigned short (&r)[16]) {
    const int tid = F.tid, dk = tid & 127, rq = tid >> 7, b = bh >> 3, h = bh & 7;
    const bf16_t* ptr = WSP(bf16_t, WS_PROJ) + ((size_t)b * S_ + n * 64 + rq * 16) * NPROJ + colbase + h * 128 + dk;
#pragma unroll
    for (int i = 0; i < 16; ++i) r[i] = ptr[(size_t)i * NPROJ];
}
__device__ __forceinline__ void hg_gates(const Params& p, const Frame& F, LAS float* qsum, int h, const unsigned short (&hf)[16], float (&fv)[16], float (&bc)[16], float& blast) {
    const int tid = F.tid, dk = tid & 127, rq = tid >> 7;
    const float l0 = p.lb_logits[h * 128 + dk], l1 = p.lb_logits[1024 + h * 128 + dk];
    const float lb = __builtin_amdgcn_rcpf(1.0f + __expf(l1 - l0));
    float run = 0.f;
#pragma unroll
    for (int i = 0; i < 16; ++i) { const float z = bf2f(hf[i]); const float f = lb + (1.0f - lb) * __builtin_amdgcn_rcpf(1.0f + __builtin_amdgcn_exp2f(z * -LOG2E)); fv[i] = f; run += __builtin_amdgcn_logf(f); bc[i] = run; }
    qsum[rq * 128 + dk] = run;
    __syncthreads();
    float off = 0.f, tot = 0.f;
#pragma unroll
    for (int q = 0; q < 4; ++q) { const float v = qsum[q * 128 + dk]; tot += v; if (q < rq) off += v; }
#pragma unroll
    for (int i = 0; i < 16; ++i) bc[i] += off;
    blast = tot;
}

__device__ __forceinline__ void hgu_unit(const Params& p, const Frame& F, int bh, int n, const unsigned short (&hf)[16], const unsigned short (&hi)[16]) {
    const int tid = F.tid, lane = F.lane, w = F.wave, fr = lane & 15, fq = lane >> 4;
    const int h = bh & 7, dk = tid & 127, rq = tid >> 7;
    LAS bf16_t* kT = (LAS bf16_t*)F.lds;
    LAS bf16_t* vT = kT + 128 * 72;
    LAS float* qsum = (LAS float*)(vT + 128 * 72);
    float fv[16], bc[16], blast;
    hg_gates(p, F, qsum, h, hf, fv, bc, blast);
#pragma unroll
    for (int i = 0; i < 16; i += 2) { const float k0 = (1.0f - fv[i]) * __builtin_amdgcn_exp2f(blast - bc[i]), k1 = (1.0f - fv[i + 1]) * __builtin_amdgcn_exp2f(blast - bc[i + 1]);
        *(LAS unsigned*)(kT + dk * 72 + rq * 16 + i) = cvt_pk_bf16(k0, k1); }
    if (rq == 0) WSP(float, WS_HGDEC)[((size_t)bh * 128 + n) * 128 + dk] = __builtin_amdgcn_exp2f(blast);
#pragma unroll
    for (int i = 0; i < 16; i += 2) *(LAS unsigned*)(vT + dk * 72 + rq * 16 + i) = (unsigned)hi[i] | ((unsigned)hi[i + 1] << 16);
    __syncthreads();
    f32x4 acc[8];
#pragma unroll
    for (int nt = 0; nt < 8; ++nt) acc[nt] = (f32x4){0.f, 0.f, 0.f, 0.f};
#pragma unroll
    for (int ks = 0; ks < 2; ++ks) { const bf16x8 a = *(const LAS bf16x8*)(kT + (w * 16 + fr) * 72 + ks * 32 + fq * 8);
#pragma unroll
        for (int nt = 0; nt < 8; ++nt) { const bf16x8 bv = *(const LAS bf16x8*)(vT + (nt * 16 + fr) * 72 + ks * 32 + fq * 8);
            acc[nt] = __builtin_amdgcn_mfma_f32_16x16x32_bf16(a, bv, acc[nt], 0, 0, 0); } }
    bf16_t* U = WSP(bf16_t, WS_HGU) + ((size_t)bh * 128 + n) * 16384;
#pragma unroll
    for (int nt = 0; nt < 8; ++nt) { u32x2 wv; wv.x = cvt_pk_bf16(acc[nt][0], acc[nt][1]); wv.y = cvt_pk_bf16(acc[nt][2], acc[nt][3]); *(u32x2*)(U + (size_t)(nt * 16 + fr) * 128 + w * 16 + fq * 4) = wv; }
    __syncthreads();
}

__device__ __forceinline__ void hg_scan(const Frame& F) {
    const bf16_t* U = WSP(bf16_t, WS_HGU); const float* DEC = WSP(float, WS_HGDEC); bf16_t* SP = WSP(bf16_t, WS_HGSP);
    for (int idx = F.bid * 512 + F.tid; idx < 16 * 8192; idx += F.G * 512) {
        const int bh = idx >> 13, rem = idx & 8191, dv = rem >> 6, dk2 = (rem & 63) * 2;
        const size_t e0 = (size_t)bh * 128 * 16384 + (size_t)dv * 128 + dk2;
        const size_t d0 = (size_t)bh * 128 * 128 + dk2;
        f32x2 s = {0.f, 0.f};
        for (int n0 = 0; n0 < 128; n0 += 8) {
            unsigned u[8]; f32x2 d[8];
#pragma unroll
            for (int k = 0; k < 8; ++k) { u[k] = *(const unsigned*)(U + e0 + (size_t)(n0 + k) * 16384); d[k] = *(const f32x2*)(DEC + d0 + (size_t)(n0 + k) * 128); }
#pragma unroll
            for (int k = 0; k < 8; ++k) { *(unsigned*)(SP + e0 + (size_t)(n0 + k) * 16384) = cvt_pk_bf16(s[0], s[1]); s = d[k] * s + (f32x2){bflo(u[k]), bfhi(u[k])}; }
        }
    }
}

__device__ __forceinline__ void hgo_unit(const Params& p, const Frame& F, int bh, int n, const unsigned short (&hf)[16], const unsigned short (&hq)[16], const unsigned short (&hi)[16], const u32x4 (&spr)[4]) {
    const int tid = F.tid, lane = F.lane, w = F.wave, fr = lane & 15, fq = lane >> 4;
    const int b = bh >> 3, h = bh & 7, dk = tid & 127, rq = tid >> 7;
    LAS bf16_t* qd = (LAS bf16_t*)F.lds;
    LAS bf16_t* ki = qd + 64 * 136;
    LAS bf16_t* vT = ki + 64 * 136;
    LAS bf16_t* at = vT + 128 * 72;
    LAS bf16_t* sp = at + 64 * 72;
    LAS float* qsum = (LAS float*)(sp + 128 * 136);
    LAS float* rs = qsum + 512;
    const size_t trow = (size_t)b * S_ + n * 64;
    bf16_t* fxp = WSP(bf16_t, WS_MIXED) + (trow + (tid >> 3)) * 2048 + h * 128 + (tid & 7) * 16;
    const u32x4 fx0 = *(const u32x4*)fxp, fx1 = *(const u32x4*)(fxp + 8);
    const f32x4 sq0 = *(const f32x4*)(WSP(float, WS_SSQ) + (trow + (tid >> 3)) * 8), sq1 = *(const f32x4*)(WSP(float, WS_SSQ) + (trow + (tid >> 3)) * 8 + 4);
    u32x2 gwv[4];
    { const bf16_t* hg = WSP(bf16_t, WS_PROJ) + (trow + (w & 3) * 16 + fr) * NPROJ + C_HG + h * 128;
#pragma unroll
      for (int q = 0; q < 4; ++q) gwv[q] = *(const u32x2*)(hg + ((w >> 2) * 4 + q) * 16 + fq * 4); }
    float fv[16], bc[16], blast;
    hg_gates(p, F, qsum, h, hf, fv, bc, blast);
#pragma unroll
    for (int i = 0; i < 16; ++i) { const float q = bf2f(hq[i]); const float qq = q * __builtin_amdgcn_rcpf(1.0f + __builtin_amdgcn_exp2f(q * -LOG2E));
        const float qdv = qq * __builtin_amdgcn_exp2f(bc[i]), kiv = (1.0f - fv[i]) * __builtin_amdgcn_exp2f(-bc[i]);
        qd[(rq * 16 + i) * 136 + dk] = (bf16_t)(cvt_pk_bf16(qdv, 0.f) & 0xffffu);
        ki[(rq * 16 + i) * 136 + dk] = (bf16_t)(cvt_pk_bf16(kiv, 0.f) & 0xffffu); }
#pragma unroll
    for (int i = 0; i < 16; i += 2) *(LAS unsigned*)(vT + dk * 72 + rq * 16 + i) = (unsigned)hi[i] | ((unsigned)hi[i + 1] << 16);
#pragma unroll
    for (int r = 0; r < 4; ++r) { const int q = tid + 512 * r, dv = q >> 4, ch = q & 15; *(LAS u32x4*)(sp + dv * 136 + ch * 8) = spr[r]; }
    __syncthreads();
    { const int ct = w & 3;
#pragma unroll
      for (int q = 0; q < 2; ++q) { const int st = (w >> 2) * 2 + q;
          f32x4 a = {0.f, 0.f, 0.f, 0.f};
          if (st <= ct) {
#pragma unroll
              for (int ks = 0; ks < 4; ++ks) { const bf16x8 ka = *(const LAS bf16x8*)(ki + (st * 16 + fr) * 136 + ks * 32 + fq * 8); const bf16x8 qb = *(const LAS bf16x8*)(qd + (ct * 16 + fr) * 136 + ks * 32 + fq * 8);
                  a = __builtin_amdgcn_mfma_f32_16x16x32_bf16(ka, qb, a, 0, 0, 0); } }
          const int c = ct * 16 + fr;
#pragma unroll
          for (int i = 0; i < 4; ++i) if (st * 16 + fq * 4 + i > c) a[i] = 0.f;
          u32x2 wv; wv.x = cvt_pk_bf16(a[0], a[1]); wv.y = cvt_pk_bf16(a[2], a[3]);
          *(LAS u32x2*)(at + c * 72 + st * 16 + fq * 4) = wv; } }
    __syncthreads();
    const int ct = w & 3, dh = w >> 2;
    f32x4 acc[4];
#pragma unroll
    for (int q = 0; q < 4; ++q) acc[q] = (f32x4){0.f, 0.f, 0.f, 0.f};
#pragma unroll
    for (int ks = 0; ks < 2; ++ks) { const bf16x8 bb = *(const LAS bf16x8*)(at + (ct * 16 + fr) * 72 + ks * 32 + fq * 8);
#pragma unroll
        for (int q = 0; q < 4; ++q) { const bf16x8 aa = *(const LAS bf16x8*)(vT + ((dh * 4 + q) * 16 + fr) * 72 + ks * 32 + fq * 8);
            acc[q] = __builtin_amdgcn_mfma_f32_16x16x32_bf16(aa, bb, acc[q], 0, 0, 0); } }
#pragma unroll
    for (int ks = 0; ks < 4; ++ks) { const bf16x8 bb = *(const LAS bf16x8*)(qd + (ct * 16 + fr) * 136 + ks * 32 + fq * 8);
#pragma unroll
        for (int q = 0; q < 4; ++q) { const bf16x8 aa = *(const LAS bf16x8*)(sp + ((dh * 4 + q) * 16 + fr) * 136 + ks * 32 + fq * 8);
            acc[q] = __builtin_amdgcn_mfma_f32_16x16x32_bf16(aa, bb, acc[q], 0, 0, 0); } }
    float ss = 0.f;
#pragma unroll
    for (int q = 0; q < 4; ++q) ss += acc[q][0] * acc[q][0] + acc[q][1] * acc[q][1] + acc[q][2] * acc[q][2] + acc[q][3] * acc[q][3];
    ss += __shfl_xor(ss, 16); ss += __shfl_xor(ss, 32);
    const int c = ct * 16 + fr;
    if (fq == 0) rs[c * 2 + dh] = ss;
    __syncthreads();
    const float rstd = rsqrtf((rs[c * 2] + rs[c * 2 + 1]) * (1.0f / 128.0f) + EPS);
    bf16_t* orow = WSP(bf16_t, WS_MIXED) + (trow + c) * 2048 + 1024 + h * 128;
#pragma unroll
    for (int q = 0; q < 4; ++q) { const int dv = (dh * 4 + q) * 16 + fq * 4;
        const u32x2 gw = gwv[q]; const f32x4 gn = *(const f32x4*)(p.g_hg + h * 128 + dv);
        const float g0 = bflo(gw.x), g1 = bfhi(gw.x), g2 = bflo(gw.y), g3 = bfhi(gw.y);
        const float o0 = acc[q][0] * rstd * gn[0] * (g0 * __builtin_amdgcn_rcpf(1.0f + __expf(-g0))), o1 = acc[q][1] * rstd * gn[1] * (g1 * __builtin_amdgcn_rcpf(1.0f + __expf(-g1)));
        const float o2 = acc[q][2] * rstd * gn[2] * (g2 * __builtin_amdgcn_rcpf(1.0f + __expf(-g2))), o3 = acc[q][3] * rstd * gn[3] * (g3 * __builtin_amdgcn_rcpf(1.0f + __expf(-g3)));
#if FP8_OUT
        *(unsigned*)(F.ws + WS_MIX8 + (trow + c) * 2048 + 1024 + h * 128 + dv) = pack4_fp8(4.0f * o0, 4.0f * o1, 4.0f * o2, 4.0f * o3);
#else
        u32x2 wv; wv.x = cvt_pk_bf16(o0, o1); wv.y = cvt_pk_bf16(o2, o3); *(u32x2*)(orow + dv) = wv;
#endif
    }
    { const float rstdf = rsqrtf(((sq0[0] + sq0[1]) + (sq0[2] + sq0[3]) + (sq1[0] + sq1[1]) + (sq1[2] + sq1[3])) * (1.0f / 1024.0f) + EPS);
      const float* gf = p.g_fox + h * 128 + (tid & 7) * 16;
#if FP8_OUT
      const float rs4 = 4.0f * rstdf;
      const f32x4 ga = *(const f32x4*)gf * rs4, gb = *(const f32x4*)(gf + 4) * rs4, gc = *(const f32x4*)(gf + 8) * rs4, gd = *(const f32x4*)(gf + 12) * rs4;
      u32x4 ov;
      ov.x = pack4_fp8(bflo(fx0.x) * ga[0], bfhi(fx0.x) * ga[1], bflo(fx0.y) * ga[2], bfhi(fx0.y) * ga[3]); ov.y = pack4_fp8(bflo(fx0.z) * gb[0], bfhi(fx0.z) * gb[1], bflo(fx0.w) * gb[2], bfhi(fx0.w) * gb[3]);
      ov.z = pack4_fp8(bflo(fx1.x) * gc[0], bfhi(fx1.x) * gc[1], bflo(fx1.y) * gc[2], bfhi(fx1.y) * gc[3]); ov.w = pack4_fp8(bflo(fx1.z) * gd[0], bfhi(fx1.z) * gd[1], bflo(fx1.w) * gd[2], bfhi(fx1.w) * gd[3]);
      *(u32x4*)(F.ws + WS_MIX8 + (trow + (tid >> 3)) * 2048 + h * 128 + (tid & 7) * 16) = ov; }
#else
      const f32x4 ga = *(const f32x4*)gf * rstdf, gb = *(const f32x4*)(gf + 4) * rstdf, gc = *(const f32x4*)(gf + 8) * rstdf, gd = *(const f32x4*)(gf + 12) * rstdf;
      u32x4 o0v, o1v;
      o0v.x = cvt_pk_bf16(bflo(fx0.x) * ga[0], bfhi(fx0.x) * ga[1]); o0v.y = cvt_pk_bf16(bflo(fx0.y) * ga[2], bfhi(fx0.y) * ga[3]); o0v.z = cvt_pk_bf16(bflo(fx0.z) * gb[0], bfhi(fx0.z) * gb[1]); o0v.w = cvt_pk_bf16(bflo(fx0.w) * gb[2], bfhi(fx0.w) * gb[3]);
      o1v.x = cvt_pk_bf16(bflo(fx1.x) * gc[0], bfhi(fx1.x) * gc[1]); o1v.y = cvt_pk_bf16(bflo(fx1.y) * gc[2], bfhi(fx1.y) * gc[3]); o1v.z = cvt_pk_bf16(bflo(fx1.z) * gd[0], bfhi(fx1.z) * gd[1]); o1v.w = cvt_pk_bf16(bflo(fx1.w) * gd[2], bfhi(fx1.w) * gd[3]);
      *(u32x4*)fxp = o0v; *(u32x4*)(fxp + 8) = o1v; }
#endif
    __syncthreads();
}

constexpr int HS_STRIDE = 2052;
__device__ __forceinline__ void phase7(const Params& p, const Frame& F) {
    const int tid = F.tid, lane = F.lane, w = F.wave;
    LAS float* hs = (LAS float*)F.lds;
    LAS float* part = hs + 16 * HS_STRIDE;
    LAS float* lg = part + 8 * 16 * 32;
    LAS int* hist = (LAS int*)(lg + 512);
    const float* mod = WSP(float, WS_MOD); const float* X1 = WSP(float, WS_X1);
    unsigned char* H2 = F.ws + WS_H2; int* TOPI = WSP(int, WS_TOPI); float* TOPG = WSP(float, WS_TOPG); int* CNT = WSP(int, WS_CNT);
    float wreg[16][4][2];
    { const int i16 = lane & 15, kq = lane >> 4;
#pragma unroll
      for (int kb = 0; kb < 16; ++kb)
#pragma unroll
          for (int sx = 0; sx < 4; ++sx) { const float* wp = p.w_router + (size_t)(256 * w + 16 * kb + 4 * kq + sx) * 32 + i16; wreg[kb][sx][0] = wp[0]; wreg[kb][sx][1] = wp[16]; } }
    for (int chunk = F.bid; chunk < 256; chunk += F.G) {
        if (tid < 32) hist[tid] = 0;
        __syncthreads();
        for (int gi = 0; gi < 4; ++gi) {
            const int t0 = chunk * 64 + gi * 16;
#pragma unroll
            for (int r = 0; r < 2; ++r) { const int tk = 2 * w + r, t = t0 + tk, b = t >> 13;
                const float* xr = X1 + (size_t)t * 2048;
                f32x4 v[8]; float ss = 0.f;
#pragma unroll
                for (int i = 0; i < 8; ++i) { v[i] = *(const f32x4*)(xr + (i * 64 + lane) * 4); ss += v[i][0] * v[i][0] + v[i][1] * v[i][1] + v[i][2] * v[i][2] + v[i][3] * v[i][3]; }
                ss = wave_sum(ss);
                const float rstd = rsqrtf(ss * (1.0f / 2048.0f) + EPS);
#pragma unroll
                for (int i = 0; i < 8; ++i) { const int d = (i * 64 + lane) * 4;
                    const f32x4 sh = *(const f32x4*)(mod + b * 12288 + 6144 + d), sc = *(const f32x4*)(mod + b * 12288 + 8192 + d), g = *(const f32x4*)(p.g2 + d);
                    const f32x4 hv = v[i] * rstd * g * (sc + 1.0f) + sh;
                    *(unsigned*)(H2 + (size_t)t * 2048 + d) = pack4_fp8(hv[0], hv[1], hv[2], hv[3]);
                    *(LAS f32x4*)(hs + tk * HS_STRIDE + d) = hv; } }
            __syncthreads();
            { const int i16 = lane & 15, kq = lane >> 4;
              f32x4 c0 = {0.f, 0.f, 0.f, 0.f}, c1 = {0.f, 0.f, 0.f, 0.f};
#pragma unroll
              for (int kb = 0; kb < 16; ++kb) { const int kbase = 256 * w + 16 * kb + 4 * kq;
                  const f32x4 a4 = *(const LAS f32x4*)(hs + i16 * HS_STRIDE + kbase);
#pragma unroll
                  for (int sx = 0; sx < 4; ++sx) {
                      c0 = __builtin_amdgcn_mfma_f32_16x16x4f32(a4[sx], wreg[kb][sx][0], c0, 0, 0, 0); c1 = __builtin_amdgcn_mfma_f32_16x16x4f32(a4[sx], wreg[kb][sx][1], c1, 0, 0, 0); } }
#pragma unroll
              for (int r = 0; r < 4; ++r) { part[(w * 16 + 4 * kq + r) * 32 + i16] = c0[r]; part[(w * 16 + 4 * kq + r) * 32 + 16 + i16] = c1[r]; } }
            __syncthreads();
            {
                const int tk = tid >> 5, e = tid & 31; float cur = p.b_router[e];
#pragma unroll
                for (int w8 = 0; w8 < 8; ++w8) cur += part[(w8 * 16 + tk) * 32 + e];
                float vals[4]; int ids[4];
#pragma unroll
                for (int k = 0; k < 4; ++k) { float bv = cur; int bi = e;
#pragma unroll
                    for (int o = 16; o >= 1; o >>= 1) { const float ov = __shfl_xor(bv, o); const int oi = __shfl_xor(bi, o); if (ov > bv || (ov == bv && oi < bi)) { bv = ov; bi = oi; } }
                    vals[k] = bv; ids[k] = bi; if (e == bi) cur = -__builtin_inff(); }
                if (e == 0) { const int t = t0 + tk; float ex[4], se = 0.f;
#pragma unroll
                    for (int k = 0; k < 4; ++k) { ex[k] = __expf(vals[k] - vals[0]); se += ex[k]; }
                    const float inv = 1.0f / se;
#pragma unroll
                    for (int k = 0; k < 4; ++k) { TOPI[(size_t)t * 4 + k] = ids[k]; TOPG[(size_t)t * 4 + k] = ex[k] * inv; atomicAdd((int*)(hist + ids[k]), 1); } } }
            __syncthreads();
        }
        if (tid < 32) CNT[chunk * 32 + tid] = hist[tid];
        __syncthreads();
    }
}

__device__ __forceinline__ void phase8(const Frame& F) {
    const int tid = F.tid, lane = F.lane, w = F.wave;
    LAS int* cn = (LAS int*)F.lds;
    LAS int* part = cn + 8192;
    LAS int* tot = part + 512;
    LAS int* base = tot + 32;
    LAS int* pst = base + 32;
    LAS int* wcnt = pst + 40;
    const int* CNT = WSP(int, WS_CNT); const int* TOPI = WSP(int, WS_TOPI);
    int* POS = WSP(int, WS_POS); int* SRC = WSP(int, WS_SRC); int* TILEE = WSP(int, WS_TILEE);
    const int chunk0 = F.bid;
    int e_pre = 0;
    if (tid < 256 && chunk0 < 256) e_pre = TOPI[(size_t)chunk0 * 256 + tid];
    for (int q = tid; q < 8192; q += 512) cn[q] = CNT[q];
    __syncthreads();
    { const int e = tid & 31, g = tid >> 5; int sacc = 0;
#pragma unroll
      for (int c = 0; c < 16; ++c) sacc += cn[(g * 16 + c) * 32 + e];
      part[g * 32 + e] = sacc; }
    __syncthreads();
    if (tid < 32) { int run = 0;
#pragma unroll
        for (int g = 0; g < 16; ++g) run += part[g * 32 + tid];
        tot[tid] = run; }
    __syncthreads();
    if (tid < 32) {
        const int pad = (tot[tid] + 255) / 256 * 256; int incl = pad;
#pragma unroll
        for (int o = 1; o < 32; o <<= 1) { const int v = __shfl_up(incl, o); if (tid >= o) incl += v; }
        pst[tid] = incl - pad; if (tid == 31) pst[32] = incl; }
    __syncthreads();
    for (int chunk = chunk0; chunk < 256; chunk += F.G) {
        if (tid < 32) { const int g = chunk >> 4; int run = 0;
            for (int gg = 0; gg < g; ++gg) run += part[gg * 32 + tid];
            for (int c = g * 16; c < chunk; ++c) run += cn[c * 32 + tid];
            base[tid] = run; }
        int e = e_pre; if (chunk != chunk0 && tid < 256) e = TOPI[(size_t)chunk * 256 + tid];
        int rk = 0;
        if (tid < 256) {
#pragma unroll 8
            for (int k = 0; k < 32; ++k) { const unsigned long long mk = __ballot(e == k);
                if (e == k) rk = __popcll(mk & ((1ull << lane) - 1ull));
                if (lane == k) wcnt[w * 32 + k] = __popcll(mk); } }
        __syncthreads();
        if (tid < 256) { int before = 0;
            for (int ww = 0; ww < w; ++ww) before += wcnt[ww * 32 + e];
            const int pos = pst[e] + base[e] + before + rk; POS[(size_t)chunk * 256 + tid] = pos; SRC[pos] = chunk * 64 + (tid >> 2); }
        if (chunk < 32) { const int ee = chunk; for (int r = pst[ee] + tot[ee] + tid; r < pst[ee + 1]; r += 512) SRC[r] = 0; }
        if (chunk == 0) { const int ntl = pst[32] >> 8; for (int i = tid; i < ntl; i += 512) { int ee = 0;
#pragma unroll
                for (int k = 0; k < 32; ++k) if (pst[k] <= i * 256) ee = k;
                TILEE[i] = ee; }
            if (tid == 0) TILEE[MAXTILES] = ntl; }
        __syncthreads();
    }
}

__device__ __forceinline__ void phase11(const Params& p, const Frame& F) {
    const int lane = F.lane;
    const float* mod = WSP(float, WS_MOD); const float* X1 = WSP(float, WS_X1); const unsigned char* Y = F.ws + WS_YBUF;
    const int* POS = WSP(int, WS_POS); const float* TOPG = WSP(float, WS_TOPG);
    for (int t = F.bid * 8 + F.wave; t < T_; t += F.G * 8) {
        const int b = t >> 13;
        int ps[4]; float gk[4];
#pragma unroll
        for (int k = 0; k < 4; ++k) { ps[k] = POS[(size_t)t * 4 + k]; gk[k] = TOPG[(size_t)t * 4 + k] * (1.0f / 16.0f); }
        f32x4 v[8]; float ss = 0.f;
#pragma unroll
        for (int i = 0; i < 8; ++i) { const int d = (i * 64 + lane) * 4;
            f32x4 a = {0.f, 0.f, 0.f, 0.f};
#pragma unroll
            for (int k = 0; k < 4; ++k) { const int yw = *(const int*)(Y + (size_t)ps[k] * 2048 + d);
                const f32x2 ylo = __builtin_amdgcn_cvt_pk_f32_fp8(yw, false), yhi = __builtin_amdgcn_cvt_pk_f32_fp8(yw, true);
                a[0] += gk[k] * ylo[0]; a[1] += gk[k] * ylo[1]; a[2] += gk[k] * yhi[0]; a[3] += gk[k] * yhi[1]; }
            const f32x4 gt = *(const f32x4*)(mod + b * 12288 + 10240 + d);
            v[i] = *(const f32x4*)(X1 + (size_t)t * 2048 + d) + gt * a;
            ss += v[i][0] * v[i][0] + v[i][1] * v[i][1] + v[i][2] * v[i][2] + v[i][3] * v[i][3]; }
        ss = wave_sum(ss);
        const float rstd = rsqrtf(ss * (1.0f / 2048.0f) + EPS);
#pragma unroll
        for (int i = 0; i < 8; ++i) { const int d = (i * 64 + lane) * 4; const f32x4 g = *(const f32x4*)(p.g_final + d);
            *(f32x4*)(p.out + (size_t)t * 2048 + d) = v[i] * rstd * g; }
    }
}

__global__ void __launch_bounds__(512, 2) fwd(Params p) {
    extern __shared__ __attribute__((aligned(16))) unsigned char lds_raw[];
    Frame F;
    F.lds = (LAS unsigned char*)lds_raw;
    F.tid = threadIdx.x; F.lane = F.tid & 63; F.wave = __builtin_amdgcn_readfirstlane(F.tid >> 6);
    F.G = gridDim.x; F.bid = blockIdx.x; F.ws = p.ws;
    volatile LAS unsigned* xbw = (volatile LAS unsigned*)(F.lds + LDS_BYTES - 16);
    if (F.tid < 4) xbw[F.tid] = 0u;
    __syncthreads();
    const int lo = p.lo, hi = p.hi;
    const bool multi = (hi - lo) > 1;
    XcdBarrier bar; bar.bar = (unsigned*)(p.ws + WS_CTL); bar.x = 0; bar.st = xbw;
    if (multi) bar = xcd_barrier_post((unsigned*)(p.ws + WS_CTL), xbw);
#define IN(k) (lo <= (k) && (k) < hi)
#define SEAM(k) do { if (IN((k) + 1)) xcd_barrier(bar); } while (0)

    if (IN(0)) { phase0(p, F); SEAM(0); }
    if (IN(1)) { phase1(p, F);
#if IN_MODE == 2
        __syncthreads(); wtile_pass<0>(p, F, 0, 896);
#endif
        SEAM(1); }
    if (IN(2)) {
        cum_scan(F);
        pg8::SplitOrder S; S.init(T_, NPROJ, F.G, F.bid, CONV_NCG, CONV_NA, WGM_IN);
        if ((F.G & 63) != 0) conv8_range(p, F, F.bid, F.G);
        else if (S.conv) conv8_range(p, F, S.conv_rank(CONV_NCG), (F.G >> 3) * CONV_NCG);
        __syncthreads();
#if IN_MODE == 2
        pg8::SrcPlain X{WSP(bf16_t, WS_H1), WSP(bf16_t, WS_WIN), 1024};
        pg8::EpiProjI8 E{WSP(bf16_t, WS_PROJ), NPROJ, WSP(float, WS_RS), WSP(float, WS_CMAX)};
        pg8::gemm_phase<2>(F.lds, 1024, S, X, E);
#elif IN_MODE == 1
        pg8::SrcPlain X{WSP(bf16_t, WS_H1), WSP(bf16_t, WS_WIN), 1024};
        pg8::EpiProj E{WSP(bf16_t, WS_PROJ), NPROJ, 1.0f / 256.0f};
        pg8::gemm_phase<1>(F.lds, 1024, S, X, E);
#else
        pg8::SrcPlain X{WSP(bf16_t, WS_H1), WSP(bf16_t, WS_WIN), 2048};
        pg8::EpiProj E{WSP(bf16_t, WS_PROJ), NPROJ, 1.0f};
        pg8::gemm_phase<0>(F.lds, 2048, S, X, E);
#endif
        SEAM(2);
    }
    if (IN(3)) {
        {   unsigned short fa[16], va[16], fb[16], vb[16];
            int u = F.bid;
            if (u < 2048) { hg_load_col(F, u >> 7, u & 127, C_HF, fa); hg_load_col(F, u >> 7, u & 127, C_HI, va); }
            while (u < 2048) { const int un = u + F.G;
                if (un < 2048) { hg_load_col(F, un >> 7, un & 127, C_HF, fb); hg_load_col(F, un >> 7, un & 127, C_HI, vb); }
                hgu_unit(p, F, u >> 7, u & 127, fa, va);
#pragma unroll
                for (int i = 0; i < 16; ++i) { fa[i] = fb[i]; va[i] = vb[i]; }
                u = un; } }
        knorm_pass(F);
        SEAM(3);
    }
    if (IN(4)) {
        hg_scan(F);
        for (int a = F.bid; a < 512; a += F.G) { const int bh = a >> 5, xq = a & 31; attn_unit(F, bh, xq); attn_unit(F, bh, 63 - xq); }
        SEAM(4);
    }
    if (IN(5)) {
        {   unsigned short fa[16], qa[16], va[16], fb[16], qb[16], vb[16]; u32x4 sa[4], sb[4];
            const bf16_t* SPg = WSP(bf16_t, WS_HGSP);
#define HGO_LOAD(u_, f_, q_, v_, s_) do { hg_load_col(F, (u_) >> 7, (u_) & 127, C_HF, f_); hg_load_col(F, (u_) >> 7, (u_) & 127, C_HQ, q_); hg_load_col(F, (u_) >> 7, (u_) & 127, C_HI, v_); \
                _Pragma("unroll") for (int r = 0; r < 4; ++r) { const int q = F.tid + 512 * r; s_[r] = *(const u32x4*)(SPg + (size_t)(u_) * 16384 + (size_t)(q >> 4) * 128 + (q & 15) * 8); } } while (0)
            int u = F.bid;
            if (u < 2048) HGO_LOAD(u, fa, qa, va, sa);
            while (u < 2048) { const int un = u + F.G;
                if (un < 2048) HGO_LOAD(un, fb, qb, vb, sb);
                hgo_unit(p, F, u >> 7, u & 127, fa, qa, va, sa);
#pragma unroll
                for (int i = 0; i < 16; ++i) { fa[i] = fb[i]; qa[i] = qb[i]; va[i] = vb[i]; }
#pragma unroll
                for (int r = 0; r < 4; ++r) sa[r] = sb[r];
                u = un; }
#undef HGO_LOAD
        }
        SEAM(5);
    }
    if (IN(6)) {
        pg8::StaticOrder S; S.init(T_, 2048, F.G, F.bid, WGM_OUT);
#if FP8_OUT
        pg8::SrcPlain X{WSP(bf16_t, WS_MIX8), WSP(bf16_t, WS_WOUT), 1024};
        pg8::EpiResid E{p.x, WSP(float, WS_X1), WSP(float, WS_MOD) + 4096, 1.0f / 256.0f};
        pg8::gemm_phase<1>(F.lds, 1024, S, X, E);
#else
        pg8::SrcPlain X{WSP(bf16_t, WS_MIXED), WSP(bf16_t, WS_WOUT), 2048};
        pg8::EpiResid E{p.x, WSP(float, WS_X1), WSP(float, WS_MOD) + 4096, 1.0f};
        pg8::gemm_phase<0>(F.lds, 2048, S, X, E);
#endif
        SEAM(6);
    }
    if (IN(7)) { phase7(p, F); SEAM(7); }
    if (IN(8)) { phase8(F); SEAM(8); }
    if (IN(9)) {
        const int ntl = WSP(int, WS_TILEE)[MAXTILES];
        pg8::StaticOrder S; S.init(ntl * 256, 4096, F.G, F.bid, WGM_GU);
        pg8::SrcMoE X{WSP(bf16_t, WS_H2), WSP(bf16_t, WS_WGU), WSP(int, WS_SRC), WSP(int, WS_TILEE), 1024, (size_t)4096 * 1024};
        pg8::EpiGlu E{F.ws + WS_ACT, p.b_gu};
        pg8::gemm_phase<1>(F.lds, 1024, S, X, E);
        SEAM(9);
    }
    if (IN(10)) {
        const int ntl = WSP(int, WS_TILEE)[MAXTILES];
        pg8::StaticOrder S; S.init(ntl * 256, 2048, F.G, F.bid, WGM_DN);
        pg8::SrcMoE X{WSP(bf16_t, WS_ACT), WSP(bf16_t, WS_WDN), nullptr, WSP(int, WS_TILEE), 1024, (size_t)2048 * 1024};
        pg8::EpiDown E{F.ws + WS_YBUF, p.b_down};
        pg8::gemm_phase<1>(F.lds, 1024, S, X, E);
        SEAM(10);
    }
    if (IN(11)) { phase11(p, F); }
#undef IN
#undef SEAM
}

#ifndef N_LAUNCH_MODE
#define N_LAUNCH_MODE 1
#endif
extern "C" void kernel_launch(void* const* d_in, const int* in_sizes, int n_in, void* d_out, int out_size, void* d_ws, size_t ws_size, hipStream_t stream) {
    static int grid = 0;
    if (grid == 0) {
        if (n_in != 19 || out_size != T_ * D_ || ws_size < WS_END) { fprintf(stderr, "kernel_launch: unexpected shapes (n_in %d out %d ws %zu need %zu)\n", n_in, out_size, ws_size, (size_t)WS_END); grid = -1; return; }
        int dev = 0, cus = 0, per_cu = 0;
        if (hipGetDevice(&dev) != hipSuccess || hipDeviceGetAttribute(&cus, hipDeviceAttributeMultiprocessorCount, dev) != hipSuccess) { grid = -1; return; }
        if (hipFuncSetAttribute((const void*)fwd, hipFuncAttributeMaxDynamicSharedMemorySize, LDS_BYTES) != hipSuccess) { fprintf(stderr, "kernel_launch: hipFuncSetAttribute failed\n"); grid = -1; return; }
        if (hipOccupancyMaxActiveBlocksPerMultiprocessor(&per_cu, (const void*)fwd, 512, LDS_BYTES) != hipSuccess || per_cu < 1) fprintf(stderr, "kernel_launch: occupancy query reports %d\n", per_cu);
        (void)hipGetLastError();
        grid = cus;
    }
    if (grid < 0) return;
    (void)in_sizes;
    hipMemsetAsync((char*)d_ws + WS_CTL, 0, 65536, stream);
    Params p{};
    p.x = (const float*)d_in[0]; p.c = (const float*)d_in[1]; p.w_ada = (const float*)d_in[2]; p.b_ada = (const float*)d_in[3];
    p.g1 = (const float*)d_in[4]; p.g2 = (const float*)d_in[5]; p.w_in = (const float*)d_in[6]; p.b_fgate = (const float*)d_in[7];
    p.g_fox = (const float*)d_in[8]; p.lb_logits = (const float*)d_in[9]; p.g_hg = (const float*)d_in[10]; p.w_out = (const float*)d_in[11];
    p.w_router = (const float*)d_in[12]; p.b_router = (const float*)d_in[13]; p.w_gu = (const float*)d_in[14]; p.b_gu = (const float*)d_in[15];
    p.w_down = (const float*)d_in[16]; p.b_down = (const float*)d_in[17]; p.g_final = (const float*)d_in[18];
    p.out = (float*)d_out; p.ws = (unsigned char*)d_ws;
#if N_LAUNCH_MODE == 1
    p.lo = 0; p.hi = NPHASE;
    hipLaunchKernelGGL(fwd, dim3(grid), dim3(512), LDS_BYTES, stream, p);
#else
    for (int k = 0; k < NPHASE; ++k) { p.lo = k; p.hi = k + 1; hipLaunchKernelGGL(fwd, dim3(grid), dim3(512), LDS_BYTES, stream, p); }
#endif
}
```

```cpp
#include <hip/hip_runtime.h>
#include <cstdio>
#include <cstdint>

#define LAS __attribute__((address_space(3)))
typedef unsigned short bf16_t;
typedef short bf16x8 __attribute__((ext_vector_type(8)));
typedef short s16x4 __attribute__((ext_vector_type(4)));
typedef float f32x4 __attribute__((ext_vector_type(4)));
typedef float f32x2 __attribute__((ext_vector_type(2)));
typedef unsigned u32x4 __attribute__((ext_vector_type(4)));
typedef unsigned u32x2 __attribute__((ext_vector_type(2)));
typedef int i32x4 __attribute__((ext_vector_type(4)));
typedef int i32x8 __attribute__((ext_vector_type(8)));

constexpr int T_ = 16384, D_ = 2048, S_ = 8192;
constexpr int NPROJ = 7168;
constexpr int C_FQ = 0, C_FK = 1024, C_FV = 2048, C_HQ = 3072, C_HF = 4096, C_HI = 5120, C_HG = 6144;
constexpr int NE = 32;
constexpr int MAXTILES = 288, MAXROWS = MAXTILES * 256;
constexpr int LDS_BYTES = 155648;
constexpr int NPHASE = 12;
#ifndef WGM_IN
#define WGM_IN 2
#endif
#ifndef WGM_OUT
#define WGM_OUT 2
#endif
#ifndef WGM_GU
#define WGM_GU 2
#endif
#ifndef WGM_DN
#define WGM_DN 2
#endif
#ifndef CONV_NCG
#define IN_MODE 2
#define FP8_OUT 0
#define CONV_NCG 4
#endif
#ifndef CONV_NA
#define CONV_NA 1
#endif
constexpr float EPS = 1e-6f;
constexpr float LOG2E = 1.4426950408889634f;

constexpr size_t al256(size_t x) { return (x + 255) & ~(size_t)255; }
constexpr size_t WS_CTL   = 0;
constexpr size_t WS_MODP  = 65536;
constexpr size_t WS_MOD   = WS_MODP + al256(8 * 2 * 12288 * 4);
constexpr size_t WS_WIN   = WS_MOD + al256(2 * 12288 * 4);
constexpr size_t WS_WOUT  = WS_WIN + (size_t)NPROJ * 2048 * 2;
constexpr size_t WS_WGU   = WS_WOUT + (size_t)2048 * 2048 * 2;
constexpr size_t WS_WDN   = WS_WGU + (size_t)32 * 4096 * 2048 * 2;
constexpr size_t WS_H1    = WS_WDN + (size_t)32 * 2048 * 2048 * 2;
constexpr size_t WS_PROJ  = WS_H1 + (size_t)T_ * 2048 * 2;
constexpr size_t WS_LOGF  = WS_PROJ + (size_t)T_ * NPROJ * 2;
constexpr size_t WS_CUM   = WS_LOGF + (size_t)T_ * 8 * 4;
constexpr size_t WS_HGU   = WS_CUM + (size_t)T_ * 8 * 4;
constexpr size_t WS_HGSP  = WS_HGU + (size_t)16 * 128 * 128 * 128 * 4;
constexpr size_t WS_HGDEC = WS_HGSP + (size_t)16 * 128 * 128 * 128 * 2;
constexpr size_t WS_MIXED = WS_HGDEC + (size_t)16 * 128 * 128 * 4;
constexpr size_t WS_SSQ   = WS_MIXED + (size_t)T_ * 2048 * 2;
constexpr size_t WS_X1    = WS_SSQ + (size_t)T_ * 8 * 4;
constexpr size_t WS_H2    = WS_X1 + (size_t)T_ * 2048 * 4;
constexpr size_t WS_TOPI  = WS_H2 + (size_t)T_ * 2048 * 2;
constexpr size_t WS_TOPG  = WS_TOPI + (size_t)T_ * 16;
constexpr size_t WS_POS   = WS_TOPG + (size_t)T_ * 16;
constexpr size_t WS_CNT   = WS_POS + (size_t)T_ * 16;
constexpr size_t WS_SRC   = WS_CNT + 256 * 32 * 4;
constexpr size_t WS_TILEE = WS_SRC + (size_t)MAXROWS * 4;
constexpr size_t WS_ACT   = WS_TILEE + 4096;
constexpr size_t WS_YBUF  = WS_ACT + (size_t)MAXROWS * 2048 * 2;
constexpr size_t WS_KN    = WS_YBUF + (size_t)MAXROWS * 2048 * 2;
constexpr size_t WS_MIX8  = WS_KN + 16 * 128 * 4;
constexpr size_t WS_RS    = WS_MIX8 + (size_t)T_ * 2048;
constexpr size_t WS_END   = WS_RS + (size_t)T_ * 4;
constexpr size_t WS_CMAX  = 16384;

struct Params {
    const float* x; const float* c; const float* w_ada; const float* b_ada; const float* g1; const float* g2;
    const float* w_in; const float* b_fgate; const float* g_fox; const float* lb_logits; const float* g_hg;
    const float* w_out; const float* w_router; const float* b_router; const float* w_gu; const float* b_gu;
    const float* w_down; const float* b_down; const float* g_final;
    float* out; unsigned char* ws; int lo, hi;
};

__device__ __forceinline__ unsigned cvt_pk_bf16(float lo, float hi) { unsigned r; asm volatile("v_cvt_pk_bf16_f32 %0, %1, %2" : "=v"(r) : "v"(lo), "v"(hi)); return r; }
__device__ __forceinline__ unsigned pack4_fp8(float a, float b, float c, float d) { int w = 0; w = __builtin_amdgcn_cvt_pk_fp8_f32(a, b, w, false); w = __builtin_amdgcn_cvt_pk_fp8_f32(c, d, w, true); return (unsigned)w; }
__device__ __forceinline__ unsigned pack4_i8(float a, float b, float c, float d) {
    const int ia = __float2int_rn(a), ib = __float2int_rn(b), ic = __float2int_rn(c), id = __float2int_rn(d);
    return (unsigned)(ia & 255) | ((unsigned)(ib & 255) << 8) | ((unsigned)(ic & 255) << 16) | ((unsigned)id << 24);
}
__device__ __forceinline__ i32x8 cat8(bf16x8 a, bf16x8 b) { const i32x4 x = __builtin_bit_cast(i32x4, a), y = __builtin_bit_cast(i32x4, b); return __builtin_shufflevector(x, y, 0, 1, 2, 3, 4, 5, 6, 7); }
__device__ __forceinline__ float bf2f(bf16_t b) { return __uint_as_float(((unsigned)b) << 16); }
__device__ __forceinline__ float bflo(unsigned w) { return __uint_as_float(w << 16); }
__device__ __forceinline__ float bfhi(unsigned w) { return __uint_as_float(w & 0xffff0000u); }
__device__ __forceinline__ float wave_sum(float v) {
#pragma unroll
    for (int o = 32; o >= 1; o >>= 1) v += __shfl_xor(v, o);
    return v;
}

#define XB_TMO      128
#define XB_XCNT(j)  (256  + 64 * (j))
#define XB_XSUB(j)  (1280 + 64 * (j))
#define XB_XGEN(j)  (2304 + 64 * (j))
#define XB_TOP      3328
#define XB_TOPGEN   3392
#define XCD_BAR_WORDS 3456
#define XB_SPIN_CAP (1u << 18)

__device__ __forceinline__ unsigned xb_ld(unsigned* p)              { return __hip_atomic_load(p, __ATOMIC_RELAXED, __HIP_MEMORY_SCOPE_AGENT); }
__device__ __forceinline__ unsigned xb_add(unsigned* p, unsigned v) { return __hip_atomic_fetch_add(p, v, __ATOMIC_RELAXED, __HIP_MEMORY_SCOPE_AGENT); }
__device__ __forceinline__ unsigned xb_xcc_id() { return (unsigned)__builtin_amdgcn_s_getreg((3 << 11) | 20) & 0xFu; }
#define XB_SPIN(cond, bar) do { unsigned _sp = 0; while (cond) { __builtin_amdgcn_s_sleep(1); \
    if ((++_sp & 255u) == 0u) { if (xb_ld(&(bar)[XB_TMO])) break; if (_sp > XB_SPIN_CAP) { atomicAdd(&(bar)[XB_TMO], 1u); break; } } } } while (0)

struct XcdBarrier { unsigned* bar; unsigned x; volatile LAS unsigned* st; };

__device__ __forceinline__ XcdBarrier xcd_barrier_post(unsigned* bar, volatile LAS unsigned* st) {
    XcdBarrier b; b.bar = bar; b.x = xb_xcc_id(); b.st = st;
    if (threadIdx.x == 0) (void)xb_add(&bar[XB_XCNT(b.x)], 1u);
    return b;
}
__device__ __forceinline__ void xcd_barrier_complete(unsigned* bar, unsigned x, unsigned& nloc, unsigned& nx) {
    const unsigned G = gridDim.x * gridDim.y * gridDim.z;
    unsigned sum, cnt, mine, sp = 0u;
    for (;;) {
        sum = 0u; cnt = 0u; mine = 0u;
#pragma unroll
        for (unsigned j = 0; j < 16; ++j) { const unsigned c = xb_ld(&bar[XB_XCNT(j)]); sum += c; cnt += (c > 0u) ? 1u : 0u; mine = (j == x) ? c : mine; }
        if (sum == G) break;
        __builtin_amdgcn_s_sleep(1);
        if ((++sp & 255u) == 0u) { if (xb_ld(&bar[XB_TMO])) break; if (sp > XB_SPIN_CAP) { atomicAdd(&bar[XB_TMO], 1u); break; } }
    }
    nloc = mine > 0u ? mine : 1u; nx = cnt > 0u ? cnt : 1u;
}
__device__ __forceinline__ void xcd_barrier(const XcdBarrier& b) {
    asm volatile("s_waitcnt vmcnt(0)" ::: "memory");
    __syncthreads();
    if (threadIdx.x == 0) {
        unsigned* bar = b.bar;
        __builtin_amdgcn_s_waitcnt(0);
        unsigned nloc = b.st[0], nx = b.st[1];
        if (nloc == 0u) { xcd_barrier_complete(bar, b.x, nloc, nx); b.st[0] = nloc; b.st[1] = nx; }
        const unsigned old = xb_add(&bar[XB_XSUB(b.x)], 1u);
        const unsigned gen = old / nloc;
        if (old + 1u == (gen + 1u) * nloc) {
            __builtin_amdgcn_fence(__ATOMIC_RELEASE, "agent");
            asm volatile("s_waitcnt vmcnt(0)" ::: "memory");
            const unsigned og = xb_add(&bar[XB_TOP], 1u);
            const unsigned tg = og / nx;
            if (og + 1u == (tg + 1u) * nx) xb_add(&bar[XB_TOPGEN], 1u);
            else XB_SPIN(xb_ld(&bar[XB_TOPGEN]) == tg, bar);
            __builtin_amdgcn_fence(__ATOMIC_ACQUIRE, "agent");
            xb_add(&bar[XB_XGEN(b.x)], 1u);
            asm volatile("s_waitcnt vmcnt(0)" ::: "memory");
        } else {
            XB_SPIN(xb_ld(&bar[XB_XGEN(b.x)]) == gen, bar);
            __builtin_amdgcn_fence(__ATOMIC_ACQUIRE, "agent");
            asm volatile("s_waitcnt vmcnt(0)" ::: "memory");
        }
    }
    __syncthreads();
}

namespace pg8 {
constexpr int BM = 256, BK = 64, HALF = 128, HTB = HALF * BK * 2, STAGE_BYTES = 8 * HTB, NXCD = 8;
__device__ __forceinline__ int lds_byte(int r, int c) { const int st = (r >> 4) * 2 + (c >> 5), rr = r & 15, cc = c & 31, ob = rr * 64 + cc * 2; return st * 1024 + (ob ^ (((ob >> 9) & 1) << 5)); }
__device__ __forceinline__ void stage_rc(int b, int& R, int& C) { const int st = b / 1024, sb = b % 1024, swz = sb ^ (((sb >> 9) & 1) << 5); R = (st >> 1) * 16 + swz / 64; C = (st & 1) * 32 + (swz % 64) / 2; }
__device__ __forceinline__ int perm32(int rho) { const int n = rho >> 4, i = rho & 15; return 8 * (i >> 2) + 4 * n + (i & 3); }
struct Unit { int pm, pn; };
struct StaticOrder {
    int nM, nN, nwg, G, c, WGM;
    __device__ void init(int M, int N, int G_, int c_, int wgm) { nM = M / BM; nN = N / BM; nwg = nM * nN; G = G_; c = c_; WGM = wgm; }
    __device__ bool next(int i, Unit& u) const {
        const long L = (long)i * G + c; if (L >= nwg) return false;
        int wgid = (int)L; { const int q = nwg / NXCD, r = nwg % NXCD, xcd = wgid % NXCD, off = wgid / NXCD; wgid = (xcd < r ? xcd * (q + 1) : r * (q + 1) + (xcd - r) * q) + off; }
        const int nig = WGM * nN, gid = wgid / nig, fm = gid * WGM, gsz = (nM - fm) < WGM ? (nM - fm) : WGM;
        u.pm = fm + ((wgid % nig) % gsz); u.pn = (wgid % nig) / gsz; return true;
    }
};

struct SplitOrder {
    int nM, nN, nwg, G, c, na, nb, n_nc, rank_nc, WGM; bool conv;
    __device__ void init(int M, int N, int G_, int c_, int ncg, int na_, int wgm) {
        nM = M / BM; nN = N / BM; nwg = nM * nN; G = G_; c = c_; WGM = wgm;
        if ((G & 63) != 0) ncg = 0;
        const int g = c >> 3, oct = g >> 3, gi = g & 7;
        conv = gi < ncg;
        n_nc = G - (G >> 3) * ncg;
        rank_nc = 8 * (oct * (8 - ncg) + (gi > ncg ? gi - ncg : 0)) + (c & 7);
        na = ncg ? na_ : 0x3fffffff;
        const int rem = nwg - na * G;
        nb = ncg ? na + (rem > 0 ? (rem + n_nc - 1) / n_nc : 0) : 0x3fffffff;
    }
    __device__ int conv_rank(int ncg) const { const int g = c >> 3; return 8 * ((g >> 3) * ncg + ((g & 7) < ncg ? (g & 7) : ncg)) + (c & 7); }
    __device__ bool next(int i, Unit& u) const {
        long L;
        if (i < na) L = (long)i * G + c;
        else { if (conv || i >= nb) return false; L = (long)na * G + (long)(i - na) * n_nc + rank_nc; }
        if (L >= nwg) return false;
        int wgid = (int)L; { const int q = nwg / NXCD, r = nwg % NXCD, xcd = wgid % NXCD, off = wgid / NXCD; wgid = (xcd < r ? xcd * (q + 1) : r * (q + 1) + (xcd - r) * q) + off; }
        const int nig = WGM * nN, gid = wgid / nig, fm = gid * WGM, gsz = (nM - fm) < WGM ? (nM - fm) : WGM;
        u.pm = fm + ((wgid % nig) % gsz); u.pn = (wgid % nig) / gsz; return true;
    }
};
struct SrcPlain {
    static constexpr bool SIDE = false;
    const bf16_t* A; const bf16_t* Bt; int K;
    __device__ __forceinline__ void load_map(LAS int*, int) const {}
    __device__ __forceinline__ const char* a_base(const Unit& u) const { return (const char*)A + (size_t)u.pm * BM * K * 2; }
    __device__ __forceinline__ const char* b_base(const Unit& u, const LAS int*) const { return (const char*)Bt + (size_t)u.pn * BM * K * 2; }
    __device__ __forceinline__ void a_voff(const Unit&, const int (&R)[2], const int (&C)[2], unsigned (&v)[2][2]) const {
#pragma unroll
        for (int h = 0; h < 2; ++h)
#pragma unroll
            for (int i = 0; i < 2; ++i) v[h][i] = (unsigned)((h * HALF + R[i]) * K + C[i]) * 2u;
    }
    __device__ __forceinline__ void side_issue(const Unit&, LAS int*, int, int) const {}
    __device__ __forceinline__ void a_voff_side(const Unit& u, const LAS int*, const int (&R)[2], const int (&C)[2], unsigned (&v)[2][2]) const { a_voff(u, R, C, v); }
};
struct SrcMoE {
    static constexpr bool SIDE = true;
    const bf16_t* A; const bf16_t* Bt; const int* src; const int* tile_e; int K; size_t estride;
    __device__ __forceinline__ void load_map(LAS int* lte, int nM) const { for (int i = threadIdx.x; i < nM; i += 512) lte[i] = tile_e[i]; }
    __device__ __forceinline__ const char* a_base(const Unit& u) const { return src ? (const char*)A : (const char*)A + (size_t)u.pm * BM * K * 2; }
    __device__ __forceinline__ const char* b_base(const Unit& u, const LAS int* lte) const { const int e = lte[u.pm]; return (const char*)Bt + ((size_t)e * estride + (size_t)u.pn * BM * K) * 2; }
    __device__ __forceinline__ void a_voff(const Unit& u, const int (&R)[2], const int (&C)[2], unsigned (&v)[2][2]) const {
#pragma unroll
        for (int h = 0; h < 2; ++h)
#pragma unroll
            for (int i = 0; i < 2; ++i) {
                const int r = src ? src[u.pm * BM + h * HALF + R[i]] : (h * HALF + R[i]);
                v[h][i] = (unsigned)(r * K + C[i]) * 2u; }
    }
    __device__ __forceinline__ void side_issue(const Unit& u, LAS int* tbl, int wid, int lane) const {
        if (src && wid < 4) __builtin_amdgcn_global_load_lds((const unsigned*)(src + u.pm * BM + wid * 64 + lane), (LAS unsigned*)(tbl + wid * 64), 4, 0, 0);
    }
    __device__ __forceinline__ void a_voff_side(const Unit& u, const LAS int* tbl, const int (&R)[2], const int (&C)[2], unsigned (&v)[2][2]) const {
#pragma unroll
        for (int h = 0; h < 2; ++h)
#pragma unroll
            for (int i = 0; i < 2; ++i) {
                const int r = src ? tbl[h * HALF + R[i]] : (h * HALF + R[i]);
                v[h][i] = (unsigned)(r * K + C[i]) * 2u; }
    }
};

template <int MODE, class Epi, class Sched, class Src>
__device__ __forceinline__ void gemm_phase(LAS unsigned char* lds, const int K, const Sched& S, const Src& X, const Epi& E) {
    const int tid = threadIdx.x, wid = __builtin_amdgcn_readfirstlane(tid >> 6), lane = tid & 63, wr = wid >> 2, wc = wid & 3, fr = lane & 15, fq = lane >> 4;
    const int nt = K / BK;
    int Rr[2], Cc[2]; unsigned voffB[2];
#pragma unroll
    for (int i = 0; i < 2; ++i) { int R, C; stage_rc(tid * 16 + i * 8192, R, C); Rr[i] = R; Cc[i] = C; const int Rb = Epi::PERM ? ((R & ~31) + perm32(R & 31)) : R; voffB[i] = (unsigned)(Rb * K + C) * 2u; }
    const size_t kstep = (size_t)(BK * 2);
    const size_t hstep = (size_t)HALF * K * 2;
    const unsigned ldsw = (unsigned)wid * 1024u;
    const int aoff = lds_byte(wr * 64 + fr, fq * 8), boff = lds_byte(wc * 32 + fr, fq * 8);
#define PG8_SA(b, h) (((b) * 2 + (h)) * HTB)
#define PG8_SB(b, h) ((4 + (b) * 2 + (h)) * HTB)
#define PG8_STAGE(bufoff, gbase, voff) do { _Pragma("unroll") for (int _i = 0; _i < 2; ++_i) \
        __builtin_amdgcn_global_load_lds((const unsigned*)((const char*)(gbase) + (voff)[_i]), (LAS unsigned*)(lds + (bufoff) + ldsw + _i * 8192), 16, 0, 0); } while (0)
#define PG8_LDA(dst, b, h) do { _Pragma("unroll") for (int m = 0; m < 4; ++m) _Pragma("unroll") for (int k = 0; k < 2; ++k) dst[m][k] = *(const LAS bf16x8*)(lds + PG8_SA(b, h) + aoff + m * 2048 + k * 1024); } while (0)
#define PG8_LDB(dst, b, h) do { _Pragma("unroll") for (int n = 0; n < 2; ++n) _Pragma("unroll") for (int k = 0; k < 2; ++k) dst[n][k] = *(const LAS bf16x8*)(lds + PG8_SB(b, h) + boff + n * 2048 + k * 1024); } while (0)
#define PG8_MMA(ai, bj, At, Bt) do { __builtin_amdgcn_s_setprio(1); if constexpr (MODE == 2) { \
        _Pragma("unroll") for (int m = 0; m < 4; ++m) _Pragma("unroll") for (int n = 0; n < 2; ++n) _Pragma("unroll") for (int k = 0; k < 2; ++k) \
        acc[ai][bj][m][n] = __builtin_bit_cast(f32x4, __builtin_amdgcn_mfma_i32_16x16x64_i8(__builtin_bit_cast(i32x4, Bt[n][k]), __builtin_bit_cast(i32x4, At[m][k]), __builtin_bit_cast(i32x4, acc[ai][bj][m][n]), 0, 0, 0)); \
        } else if constexpr (MODE == 1) { _Pragma("unroll") for (int m = 0; m < 4; ++m) _Pragma("unroll") for (int n = 0; n < 2; ++n) \
        asm volatile("v_mfma_f32_16x16x128_f8f6f4 %0, %1, %2, %0" : "+v"(acc[ai][bj][m][n]) : "v"(cat8(Bt[n][0], Bt[n][1])), "v"(cat8(At[m][0], At[m][1]))); } else { \
        _Pragma("unroll") for (int m = 0; m < 4; ++m) _Pragma("unroll") for (int n = 0; n < 2; ++n) _Pragma("unroll") for (int k = 0; k < 2; ++k) \
        acc[ai][bj][m][n] = __builtin_amdgcn_mfma_f32_16x16x32_bf16(Bt[n][k], At[m][k], acc[ai][bj][m][n], 0, 0, 0); } __builtin_amdgcn_s_setprio(0); } while (0)
#define PG8_WAIT_V(n) asm volatile("s_waitcnt vmcnt(" #n ")" ::: "memory")
#define PG8_WAIT_L(n) asm volatile("s_waitcnt lgkmcnt(" #n ")" ::: "memory")
#define PG8_BAR __builtin_amdgcn_s_barrier()
#define PG8_SCHED __builtin_amdgcn_sched_barrier(0)
    Unit cur, nxt; int ui = 0;
    if (!S.next(0, cur)) return;
    f32x4 acc[2][2][4][2];
#pragma unroll
    for (int a = 0; a < 2; ++a)
#pragma unroll
        for (int b = 0; b < 2; ++b)
#pragma unroll
            for (int m = 0; m < 4; ++m)
#pragma unroll
                for (int n = 0; n < 2; ++n) acc[a][b][m][n] = (f32x4){0.f, 0.f, 0.f, 0.f};
    bf16x8 At[4][2], B0[2][2], B1[2][2];
    unsigned vA[2][2], nvA[2][2];
    LAS unsigned char* side = lds + STAGE_BYTES;
    LAS int* lte = (LAS int*)(side + 5120);
#define PG8_TSRC(sl) ((LAS int*)(side + (sl) * 1024))
#define PG8_TBIAS(sl) ((LAS float*)(side + 2048 + (sl) * 1024))
    if constexpr (Src::SIDE) { X.load_map(lte, S.nM); __syncthreads(); }
    X.a_voff(cur, Rr, Cc, vA);
    E.side_issue(cur, PG8_TBIAS(0), lte, wid, lane);
    const char* cA = X.a_base(cur); const char* cB = X.b_base(cur, lte);
    PG8_STAGE(PG8_SB(0, 0), cB, voffB); PG8_STAGE(PG8_SB(0, 1), cB + hstep, voffB); PG8_STAGE(PG8_SA(0, 0), cA, vA[0]); PG8_STAGE(PG8_SA(0, 1), cA, vA[1]);
    if (wr == 1) PG8_BAR;
    PG8_WAIT_V(2); PG8_BAR;
    PG8_STAGE(PG8_SB(1, 0), cB + kstep, voffB); PG8_STAGE(PG8_SA(1, 0), cA + kstep, vA[0]); PG8_STAGE(PG8_SB(1, 1), cB + hstep + kstep, voffB);
    PG8_WAIT_V(6); PG8_BAR;
    for (;;) {
        const bool has_next = S.next(ui + 1, nxt);
        const char* nA = cA; const char* nB = cB;
#pragma unroll
        for (int h = 0; h < 2; ++h)
#pragma unroll
            for (int i = 0; i < 2; ++i) nvA[h][i] = vA[h][i];
        const int tsl = (ui + 1) & 1, bsl = (ui + 1) % 3;
        if (has_next) { nA = X.a_base(nxt); nB = X.b_base(nxt, lte); X.side_issue(nxt, PG8_TSRC(tsl), wid, lane); E.side_issue(nxt, PG8_TBIAS(bsl), lte, wid, lane); }
        for (int t = 0; t < nt; t += 2) {
            const bool last = (t == nt - 2);
            const char* a1 = cA + (size_t)(t + 1) * kstep;
            const char* a2 = last ? nA : cA + (size_t)(t + 2) * kstep; const char* b2 = last ? nB : cB + (size_t)(t + 2) * kstep;
            const char* a3 = a2 + kstep; const char* b3 = b2 + kstep;
            unsigned w0[2], w1[2];
            if (last && has_next) X.a_voff_side(nxt, PG8_TSRC(tsl), Rr, Cc, nvA);
            w0[0] = last ? nvA[0][0] : vA[0][0]; w0[1] = last ? nvA[0][1] : vA[0][1];
            w1[0] = last ? nvA[1][0] : vA[1][0]; w1[1] = last ? nvA[1][1] : vA[1][1];
            PG8_LDB(B0, 0, 0); PG8_LDB(B1, 0, 1); PG8_SCHED; PG8_LDA(At, 0, 0); PG8_STAGE(PG8_SA(1, 1), a1, vA[1]);
            PG8_WAIT_V(8); PG8_WAIT_L(0); PG8_BAR; PG8_MMA(0, 0, At, B0); PG8_MMA(0, 1, At, B1); PG8_BAR; PG8_SCHED;
            PG8_LDA(At, 0, 1); PG8_STAGE(PG8_SB(0, 0), b2, voffB); PG8_STAGE(PG8_SB(0, 1), b2 + hstep, voffB); PG8_STAGE(PG8_SA(0, 0), a2, w0);
            PG8_WAIT_V(8); PG8_WAIT_L(0); PG8_BAR; PG8_MMA(1, 0, At, B0); PG8_MMA(1, 1, At, B1); PG8_BAR; PG8_SCHED;
            PG8_LDB(B0, 1, 0); PG8_LDB(B1, 1, 1); PG8_SCHED; PG8_LDA(At, 1, 0); PG8_STAGE(PG8_SA(0, 1), a2, w1);
            PG8_WAIT_V(8); PG8_WAIT_L(0); PG8_BAR; PG8_MMA(0, 0, At, B0); PG8_MMA(0, 1, At, B1); PG8_BAR; PG8_SCHED;
            PG8_LDA(At, 1, 1); PG8_STAGE(PG8_SB(1, 0), b3, voffB); PG8_STAGE(PG8_SB(1, 1), b3 + hstep, voffB); PG8_STAGE(PG8_SA(1, 0), a3, w0);
            PG8_WAIT_V(8); PG8_WAIT_L(0); PG8_BAR; PG8_MMA(1, 0, At, B0); PG8_MMA(1, 1, At, B1); PG8_BAR; PG8_SCHED;
        }
        if (wr == 0) PG8_BAR;
        if constexpr (MODE == 1) asm volatile("s_nop 15\n\ts_nop 15\n\ts_nop 15" ::: "memory");
        E(acc, cur, wr, wc, fr, fq, PG8_TBIAS(ui % 3), lte);
        if (!has_next) break;
#pragma unroll
        for (int a = 0; a < 2; ++a)
#pragma unroll
            for (int b = 0; b < 2; ++b)
#pragma unroll
                for (int m = 0; m < 4; ++m)
#pragma unroll
                    for (int n = 0; n < 2; ++n) acc[a][b][m][n] = (f32x4){0.f, 0.f, 0.f, 0.f};
        cur = nxt; cA = nA; cB = nB; ++ui;
#pragma unroll
        for (int h = 0; h < 2; ++h)
#pragma unroll
            for (int i = 0; i < 2; ++i) vA[h][i] = nvA[h][i];
        if (wr == 1) PG8_BAR;
    }
    PG8_WAIT_V(0);
    PG8_BAR;
#undef PG8_TSRC
#undef PG8_TBIAS
#undef PG8_SA
#undef PG8_SB
#undef PG8_STAGE
#undef PG8_LDA
#undef PG8_LDB
#undef PG8_MMA
#undef PG8_WAIT_V
#undef PG8_WAIT_L
#undef PG8_BAR
#undef PG8_SCHED
}

struct EpiProj {
    static constexpr bool PERM = true;
    bf16_t* O; int ldc; float sc;
    __device__ __forceinline__ void side_issue(const Unit&, LAS float*, const LAS int*, int, int) const {}
    __device__ __forceinline__ void operator()(const f32x4 (&acc)[2][2][4][2], const Unit& u, int wr, int wc, int fr, int fq, const LAS float*, const LAS int*) const {
        const int row0 = u.pm * BM + wr * 64 + fr, col0 = u.pn * BM + wc * 32 + 8 * fq;
#pragma unroll
        for (int ai = 0; ai < 2; ++ai)
#pragma unroll
            for (int m = 0; m < 4; ++m) { bf16_t* rowp = O + (size_t)(row0 + ai * HALF + m * 16) * ldc + col0;
#pragma unroll
                for (int bj = 0; bj < 2; ++bj) { const f32x4 v0 = acc[ai][bj][m][0] * sc, v1 = acc[ai][bj][m][1] * sc;
                    u32x4 w; w.x = cvt_pk_bf16(v0[0], v0[1]); w.y = cvt_pk_bf16(v0[2], v0[3]); w.z = cvt_pk_bf16(v1[0], v1[1]); w.w = cvt_pk_bf16(v1[2], v1[3]);
                    *(u32x4*)(rowp + bj * HALF) = w; } }
    }
};
struct EpiProjI8 {
    static constexpr bool PERM = true;
    bf16_t* O; int ldc; const float* rs; const float* cmax;
    __device__ __forceinline__ void side_issue(const Unit&, LAS float*, const LAS int*, int, int) const {}
    __device__ __forceinline__ void operator()(const f32x4 (&acc)[2][2][4][2], const Unit& u, int wr, int wc, int fr, int fq, const LAS float*, const LAS int*) const {
        const int row0 = u.pm * BM + wr * 64 + fr, col0 = u.pn * BM + wc * 32 + 8 * fq;
        f32x4 cs[2][2];
#pragma unroll
        for (int bj = 0; bj < 2; ++bj)
#pragma unroll
            for (int n = 0; n < 2; ++n) cs[bj][n] = *(const f32x4*)(cmax + col0 + bj * HALF + n * 4) * (1.0f / 127.0f);
#pragma unroll
        for (int ai = 0; ai < 2; ++ai)
#pragma unroll
            for (int m = 0; m < 4; ++m) { const int row = row0 + ai * HALF + m * 16; bf16_t* rowp = O + (size_t)row * ldc + col0; const float r = rs[row];
#pragma unroll
                for (int bj = 0; bj < 2; ++bj) { const i32x4 a0 = __builtin_bit_cast(i32x4, acc[ai][bj][m][0]), a1 = __builtin_bit_cast(i32x4, acc[ai][bj][m][1]);
                    const f32x4 c0 = cs[bj][0] * r, c1 = cs[bj][1] * r;
                    u32x4 w; w.x = cvt_pk_bf16((float)a0[0] * c0[0], (float)a0[1] * c0[1]); w.y = cvt_pk_bf16((float)a0[2] * c0[2], (float)a0[3] * c0[3]);
                    w.z = cvt_pk_bf16((float)a1[0] * c1[0], (float)a1[1] * c1[1]); w.w = cvt_pk_bf16((float)a1[2] * c1[2], (float)a1[3] * c1[3]);
                    *(u32x4*)(rowp + bj * HALF) = w; } }
    }
};
struct EpiResid {
    static constexpr bool PERM = false;
    const float* x; bf16_t* x1; const float* gate; float sc;
    __device__ __forceinline__ void side_issue(const Unit&, LAS float*, const LAS int*, int, int) const {}
    __device__ __forceinline__ void operator()(const f32x4 (&acc)[2][2][4][2], const Unit& u, int wr, int wc, int fr, int fq, const LAS float*, const LAS int*) const {
        const int row0 = u.pm * BM + wr * 64 + fr, col0 = u.pn * BM + wc * 32 + 4 * fq;
        const float* gp = gate + ((u.pm * BM) >> 13) * 12288 + col0;
        f32x4 gv[2][2];
#pragma unroll
        for (int bj = 0; bj < 2; ++bj)
#pragma unroll
            for (int n = 0; n < 2; ++n) gv[bj][n] = *(const f32x4*)(gp + bj * HALF + n * 16) * sc;
#pragma unroll
        for (int ai = 0; ai < 2; ++ai) {
            f32x4 xs[4][2][2];
#pragma unroll
            for (int m = 0; m < 4; ++m) { const size_t off = (size_t)(row0 + ai * HALF + m * 16) * 2048 + col0;
#pragma unroll
                for (int bj = 0; bj < 2; ++bj)
#pragma unroll
                    for (int n = 0; n < 2; ++n) xs[m][bj][n] = *(const f32x4*)(x + off + bj * HALF + n * 16); }
#pragma unroll
            for (int m = 0; m < 4; ++m) { const size_t off = (size_t)(row0 + ai * HALF + m * 16) * 2048 + col0;
#pragma unroll
                for (int bj = 0; bj < 2; ++bj)
#pragma unroll
                    for (int n = 0; n < 2; ++n) { const f32x4 r = xs[m][bj][n] + gv[bj][n] * acc[ai][bj][m][n];
                        u32x2 w; w.x = cvt_pk_bf16(r[0], r[1]); w.y = cvt_pk_bf16(r[2], r[3]); *(u32x2*)(x1 + off + bj * HALF + n * 16) = w; } }
            asm volatile("" ::: "memory"); }
    }
};
struct EpiGlu {
    static constexpr bool PERM = true;
    unsigned char* O; const float* b_gu;
    __device__ __forceinline__ void side_issue(const Unit& u, LAS float* bt, const LAS int* lte, int wid, int lane) const {
        if (wid >= 4) { const int w4 = wid - 4, e = lte[u.pm];
            __builtin_amdgcn_global_load_lds((const unsigned*)(b_gu + (size_t)e * 4096 + (w4 >> 1) * 2048 + u.pn * HALF + (w4 & 1) * 64 + lane), (LAS unsigned*)(bt + w4 * 64), 4, 0, 0); }
    }
    __device__ __forceinline__ void operator()(const f32x4 (&acc)[2][2][4][2], const Unit& u, int wr, int wc, int fr, int fq, const LAS float* bt, const LAS int*) const {
        const int row0 = u.pm * BM + wr * 64 + fr, col0 = u.pn * HALF + wc * 32 + 8 * fq;
        f32x2 bg4[2][2], bl1[2][2];
#pragma unroll
        for (int n = 0; n < 2; ++n) { const f32x4 g = *(const LAS f32x4*)(bt + wc * 32 + 8 * fq + 4 * n), l = *(const LAS f32x4*)(bt + HALF + wc * 32 + 8 * fq + 4 * n);
            bg4[n][0] = (f32x2){4.0f * g[0], 4.0f * g[1]}; bg4[n][1] = (f32x2){4.0f * g[2], 4.0f * g[3]}; bl1[n][0] = (f32x2){l[0] + 1.0f, l[1] + 1.0f}; bl1[n][1] = (f32x2){l[2] + 1.0f, l[3] + 1.0f}; }
#pragma unroll
        for (int ai = 0; ai < 2; ++ai)
#pragma unroll
            for (int m = 0; m < 4; ++m) { unsigned char* rowp = O + (size_t)(row0 + ai * HALF + m * 16) * 2048 + col0;
                f32x2 r[4];
#pragma unroll
                for (int n = 0; n < 2; ++n)
#pragma unroll
                    for (int hp = 0; hp < 2; ++hp) {
                        const f32x2 ga = (f32x2){acc[ai][0][m][n][2 * hp], acc[ai][0][m][n][2 * hp + 1]}, la = (f32x2){acc[ai][1][m][n][2 * hp], acc[ai][1][m][n][2 * hp + 1]};
                        f32x2 g4 = ga * (4.0f / 64.0f) + bg4[n][hp]; g4[0] = fminf(g4[0], 28.0f); g4[1] = fminf(g4[1], 28.0f);
                        f32x2 l1 = la * (1.0f / 64.0f) + bl1[n][hp]; l1[0] = __builtin_amdgcn_fmed3f(l1[0], -6.0f, 8.0f); l1[1] = __builtin_amdgcn_fmed3f(l1[1], -6.0f, 8.0f);
                        const f32x2 z = g4 * (-1.702f * LOG2E * 0.25f);
                        f32x2 d = (f32x2){__builtin_amdgcn_exp2f(z[0]), __builtin_amdgcn_exp2f(z[1])} + 1.0f;
                        const f32x2 sg = (f32x2){__builtin_amdgcn_rcpf(d[0]), __builtin_amdgcn_rcpf(d[1])};
                        r[n * 2 + hp] = (g4 * sg) * l1; }
                u32x2 w; w.x = pack4_fp8(r[0][0], r[0][1], r[1][0], r[1][1]); w.y = pack4_fp8(r[2][0], r[2][1], r[3][0], r[3][1]);
                *(u32x2*)rowp = w; }
    }
};
struct EpiDown {
    static constexpr bool PERM = true;
    unsigned char* O; const float* b_down;
    __device__ __forceinline__ void side_issue(const Unit& u, LAS float* bt, const LAS int* lte, int wid, int lane) const {
        if (wid >= 4) { const int w4 = wid - 4, e = lte[u.pm];
            __builtin_amdgcn_global_load_lds((const unsigned*)(b_down + (size_t)e * 2048 + u.pn * BM + w4 * 64 + lane), (LAS unsigned*)(bt + w4 * 64), 4, 0, 0); }
    }
    __device__ __forceinline__ void operator()(const f32x4 (&acc)[2][2][4][2], const Unit& u, int wr, int wc, int fr, int fq, const LAS float* bt, const LAS int*) const {
        const int row0 = u.pm * BM + wr * 64 + fr, col0 = u.pn * BM + wc * 32 + 8 * fq;
        f32x4 bv[2][2];
#pragma unroll
        for (int bj = 0; bj < 2; ++bj)
#pragma unroll
            for (int n = 0; n < 2; ++n) bv[bj][n] = *(const LAS f32x4*)(bt + bj * HALF + wc * 32 + 8 * fq + 4 * n) * 16.0f;
#pragma unroll
        for (int ai = 0; ai < 2; ++ai)
#pragma unroll
            for (int m = 0; m < 4; ++m) { unsigned char* rowp = O + (size_t)(row0 + ai * HALF + m * 16) * 2048 + col0;
#pragma unroll
                for (int bj = 0; bj < 2; ++bj) { const f32x4 v0 = acc[ai][bj][m][0] * (16.0f / 256.0f) + bv[bj][0], v1 = acc[ai][bj][m][1] * (16.0f / 256.0f) + bv[bj][1];
                    u32x2 w; w.x = pack4_fp8(v0[0], v0[1], v0[2], v0[3]); w.y = pack4_fp8(v1[0], v1[1], v1[2], v1[3]);
                    *(u32x2*)(rowp + bj * HALF) = w; } }
    }
};
}

struct Frame {
    LAS unsigned char* lds; int tid, lane, wave, G, bid;
    unsigned char* ws;
};
#define WSP(T, off) ((T*)(F.ws + (off)))

struct TileInfo { const float* src; unsigned char* dst; int ld, colA, colB, f8, n0, pad_; };
__device__ __forceinline__ TileInfo conv_decode(const Params& p, const Frame& F, int i) {
    TileInfo t;
    if (i < 896) { const int kt = i / 28, nt = i % 28, r0 = nt * 256; t.colA = r0 < 3072 ? r0 : r0 + 8; t.colB = t.colA + 128; t.ld = 7176;
        t.src = p.w_in + (size_t)kt * 64 * 7176; t.f8 = IN_MODE; t.n0 = r0; t.pad_ = 0; t.dst = F.ws + WS_WIN + (IN_MODE ? (size_t)r0 * 2048 + kt * 64 : ((size_t)r0 * 2048 + kt * 64) * 2); }
    else { const int j = i - 896, kt = j / 8, nt = j % 8; t.colA = nt * 256; t.colB = t.colA + 128; t.ld = 2048;
        t.src = p.w_out + (size_t)kt * 64 * 2048; t.f8 = FP8_OUT != 0; t.n0 = 0; t.pad_ = 0; t.dst = F.ws + WS_WOUT + (FP8_OUT ? (size_t)nt * 256 * 2048 + kt * 64 : ((size_t)nt * 256 * 2048 + kt * 64) * 2); }
    return t;
}
constexpr int CONV_TILES = 1152;
constexpr int CONV8_TILES = 16384 + 8192;
struct Tile8 { const float* src; unsigned char* dst; int ld; };
__device__ __forceinline__ Tile8 conv8_decode(const Params& p, const Frame& F, int i) {
    Tile8 t;
    if (i < 16384) { const int e = i / 512, r = i % 512, kt = r / 32, nt = r % 32, pn = nt >> 1, half = nt & 1; t.ld = 4096;
        t.src = p.w_gu + (size_t)e * 2048 * 4096 + (size_t)kt * 128 * 4096 + half * 2048 + pn * 128; t.dst = F.ws + WS_WGU + ((size_t)e * 4096 + nt * 128) * 2048 + kt * 128; }
    else { const int j = i - 16384, e = j / 256, r = j % 256, kt = r / 16, nt = r % 16; t.ld = 2048;
        t.src = p.w_down + (size_t)e * 2048 * 2048 + (size_t)kt * 128 * 2048 + nt * 128; t.dst = F.ws + WS_WDN + ((size_t)e * 2048 + nt * 128) * 2048 + kt * 128; }
    return t;
}
__device__ __forceinline__ void conv8_load(const Tile8& t, int g, int kq, f32x4 (&L)[2][4]) {
#pragma unroll
    for (int i = 0; i < 2; ++i)
#pragma unroll
        for (int r = 0; r < 4; ++r) L[i][r] = __builtin_nontemporal_load((const f32x4*)(t.src + (size_t)(4 * (kq + 16 * i) + r) * t.ld + 4 * g));
}
__device__ __forceinline__ void conv_load(const TileInfo& t, int g, int kq, f32x4 (&L)[4][2]) {
    const int col = g < 32 ? t.colA + 4 * g : t.colB + 4 * (g - 32);
#pragma unroll
    for (int i = 0; i < 4; ++i) { const int k0 = t.f8 ? 4 * (kq + 8 * (i >> 1)) + 2 * (i & 1) : 2 * (kq + 8 * i);
        L[i][0] = *(const f32x4*)(t.src + (size_t)k0 * t.ld + col);
        L[i][1] = *(const f32x4*)(t.src + (size_t)(k0 + 1) * t.ld + col); }
}
template <int KIND>
__device__ __forceinline__ void wtile_pass(const Params& p, const Frame& F, int lo, int hi) {
    const int tid = F.tid;
    LAS unsigned* tt = (LAS unsigned*)F.lds;
    const int g = tid & 63, kq = tid >> 6;
    f32x4 cur[4][2], nxt[4][2];
    int i = lo + F.bid;
    TileInfo ti;
    if (i < hi) { ti = conv_decode(p, F, i); conv_load(ti, g, kq, cur); }
    while (i < hi) {
        const int inext = i + F.G;
        TileInfo tn = ti;
        if (inext < hi) { tn = conv_decode(p, F, inext); conv_load(tn, g, kq, nxt); }
        if constexpr (KIND == 1) {
            f32x4 m = __builtin_elementwise_max(__builtin_elementwise_abs(cur[0][0]), __builtin_elementwise_abs(cur[0][1]));
#pragma unroll
            for (int q = 1; q < 4; ++q) m = __builtin_elementwise_max(m, __builtin_elementwise_max(__builtin_elementwise_abs(cur[q][0]), __builtin_elementwise_abs(cur[q][1])));
            *(LAS f32x4*)((LAS float*)tt + kq * 256 + 4 * g) = m;
            __syncthreads();
            if (tid < 256) { float v = ((LAS float*)tt)[tid];
#pragma unroll
                for (int w = 1; w < 8; ++w) v = fmaxf(v, ((LAS float*)tt)[w * 256 + tid]);
                __hip_atomic_fetch_max((unsigned*)(F.ws + WS_CMAX) + ti.n0 + tid, __float_as_uint(v), __ATOMIC_RELAXED, __HIP_MEMORY_SCOPE_AGENT); }
        } else if (ti.f8 == 2) {
            const f32x4 cm = *(const f32x4*)((const float*)(F.ws + WS_CMAX) + ti.n0 + 4 * g);
            f32x4 inv;
#pragma unroll
            for (int j = 0; j < 4; ++j) inv[j] = cm[j] > 0.f ? 127.0f / cm[j] : 0.f;
#pragma unroll
            for (int q = 0; q < 2; ++q)
#pragma unroll
                for (int j = 0; j < 4; ++j) tt[(4 * g + j) * 17 + kq + 8 * q] = pack4_i8(inv[j] * cur[2 * q][0][j], inv[j] * cur[2 * q][1][j], inv[j] * cur[2 * q + 1][0][j], inv[j] * cur[2 * q + 1][1][j]);
            __syncthreads();
#pragma unroll
            for (int r = 0; r < 2; ++r) { const int q = tid + 512 * r, n = q >> 2, ch = q & 3;
                u32x4 v; v.x = tt[n * 17 + ch * 4 + 0]; v.y = tt[n * 17 + ch * 4 + 1]; v.z = tt[n * 17 + ch * 4 + 2]; v.w = tt[n * 17 + ch * 4 + 3];
                *(u32x4*)(ti.dst + (size_t)n * 2048 + ch * 16) = v; }
        } else if (ti.f8) {
#pragma unroll
            for (int q = 0; q < 2; ++q)
#pragma unroll
                for (int j = 0; j < 4; ++j) tt[(4 * g + j) * 17 + kq + 8 * q] = pack4_fp8(64.0f * cur[2 * q][0][j], 64.0f * cur[2 * q][1][j], 64.0f * cur[2 * q + 1][0][j], 64.0f * cur[2 * q + 1][1][j]);
            __syncthreads();
#pragma unroll
            for (int r = 0; r < 2; ++r) { const int q = tid + 512 * r, n = q >> 2, ch = q & 3;
                u32x4 v; v.x = tt[n * 17 + ch * 4 + 0]; v.y = tt[n * 17 + ch * 4 + 1]; v.z = tt[n * 17 + ch * 4 + 2]; v.w = tt[n * 17 + ch * 4 + 3];
                *(u32x4*)(ti.dst + (size_t)n * 2048 + ch * 16) = v; }
        } else {
#pragma unroll
            for (int q = 0; q < 4; ++q)
#pragma unroll
                for (int j = 0; j < 4; ++j) tt[(4 * g + j) * 33 + kq + 8 * q] = cvt_pk_bf16(cur[q][0][j], cur[q][1][j]);
            __syncthreads();
#pragma unroll
            for (int r = 0; r < 4; ++r) { const int q = tid + 512 * r, n = q >> 3, ch = q & 7;
                u32x4 v; v.x = tt[n * 33 + ch * 4 + 0]; v.y = tt[n * 33 + ch * 4 + 1]; v.z = tt[n * 33 + ch * 4 + 2]; v.w = tt[n * 33 + ch * 4 + 3];
                *(u32x4*)(ti.dst + (size_t)n * 4096 + ch * 16) = v; }
        }
        __syncthreads();
#pragma unroll
        for (int q = 0; q < 4; ++q) { cur[q][0] = nxt[q][0]; cur[q][1] = nxt[q][1]; }
        ti = tn; i = inext;
    }
}


__device__ __forceinline__ void phase0(const Params& p, const Frame& F) {
    const int tid = F.tid;
    LAS float* cs = (LAS float*)F.lds;
    LAS float* red = cs + 4096;
    for (int i = tid; i < 4096; i += 512) { const float v = p.c[i]; cs[i] = v / (1.0f + expf(-v)); }
    __syncthreads();
    float* modp = WSP(float, WS_MODP);
    for (int u = F.bid; u < 384; u += F.G) {
        const int cc = u % 48, dc = u / 48, w = F.wave, lane = F.lane;
        const int d0 = dc * 256 + w * 32;
        const float* wp = p.w_ada + (size_t)d0 * 12288 + cc * 256 + lane * 4;
        f32x4 a0 = {0.f, 0.f, 0.f, 0.f}, a1 = {0.f, 0.f, 0.f, 0.f};
#pragma unroll 8
        for (int i = 0; i < 32; ++i) { const f32x4 v = *(const f32x4*)(wp + (size_t)i * 12288); const float c0 = cs[d0 + i], c1 = cs[2048 + d0 + i]; a0 += v * c0; a1 += v * c1; }
        *(LAS f32x4*)(red + (w * 2 + 0) * 256 + lane * 4) = a0;
        *(LAS f32x4*)(red + (w * 2 + 1) * 256 + lane * 4) = a1;
        __syncthreads();
        { const int b = tid >> 8, col = tid & 255; float s = 0.f;
#pragma unroll
          for (int w8 = 0; w8 < 8; ++w8) s += red[(w8 * 2 + b) * 256 + col];
          modp[(dc * 2 + b) * 12288 + cc * 256 + col] = s; }
        __syncthreads();
    }
#if IN_MODE == 2
    wtile_pass<1>(p, F, 0, 896);
    wtile_pass<0>(p, F, 896, CONV_TILES);
#else
    wtile_pass<0>(p, F, 0, CONV_TILES);
#endif
}

__device__ __forceinline__ void conv8_range(const Params& p, const Frame& F, int first, int stride) {
    const int tid = F.tid;
    LAS unsigned* tt = (LAS unsigned*)F.lds;
    const int g8 = tid & 31, kq8 = tid >> 5;
    f32x4 r0[2][4], r1[2][4], r2[2][4], r3[2][4], r4[2][4]; Tile8 t0, t1, t2, t3, t4;
#define C8_PROCESS(R, T) do { \
        _Pragma("unroll") for (int q = 0; q < 2; ++q) _Pragma("unroll") for (int j = 0; j < 4; ++j) \
            tt[(4 * g8 + j) * 33 + kq8 + 16 * q] = pack4_fp8(64.0f * R[q][0][j], 64.0f * R[q][1][j], 64.0f * R[q][2][j], 64.0f * R[q][3][j]); \
        __syncthreads(); \
        _Pragma("unroll") for (int r = 0; r < 2; ++r) { const int q = tid + 512 * r, n = q >> 3, ch = q & 7; \
            u32x4 v; v.x = tt[n * 33 + ch * 4 + 0]; v.y = tt[n * 33 + ch * 4 + 1]; v.z = tt[n * 33 + ch * 4 + 2]; v.w = tt[n * 33 + ch * 4 + 3]; \
            __builtin_nontemporal_store(v, (u32x4*)(T.dst + (size_t)n * 2048 + ch * 16)); } \
        __syncthreads(); } while (0)
#define C8_FETCH(R, T, idx) do { if ((idx) < CONV8_TILES) { T = conv8_decode(p, F, (idx)); conv8_load(T, g8, kq8, R); } } while (0)
    int i = first;
    C8_FETCH(r0, t0, i); C8_FETCH(r1, t1, i + stride); C8_FETCH(r2, t2, i + 2 * stride); C8_FETCH(r3, t3, i + 3 * stride);
    for (;;) {
        if (i >= CONV8_TILES) break;
        C8_FETCH(r4, t4, i + 4 * stride); C8_PROCESS(r0, t0); i += stride;
        if (i >= CONV8_TILES) break;
        C8_FETCH(r0, t0, i + 4 * stride); C8_PROCESS(r1, t1); i += stride;
        if (i >= CONV8_TILES) break;
        C8_FETCH(r1, t1, i + 4 * stride); C8_PROCESS(r2, t2); i += stride;
        if (i >= CONV8_TILES) break;
        C8_FETCH(r2, t2, i + 4 * stride); C8_PROCESS(r3, t3); i += stride;
        if (i >= CONV8_TILES) break;
        C8_FETCH(r3, t3, i + 4 * stride); C8_PROCESS(r4, t4); i += stride;
    }
#undef C8_FETCH
#undef C8_PROCESS
}

__device__ __forceinline__ void phase1(const Params& p, const Frame& F) {
    const int tid = F.tid, lane = F.lane;
    LAS float* wfT = (LAS float*)F.lds;
    LAS float* a1 = wfT + 8 * 2048;
    LAS float* s1 = a1 + 4096;
    const float* modp = WSP(float, WS_MODP);
    for (int q = tid; q < 4096; q += 512) { const int d = q >> 1, hf = q & 1; const f32x4 v = *(const f32x4*)(p.w_in + (size_t)d * 7176 + 3072 + hf * 4);
#pragma unroll
        for (int j = 0; j < 4; ++j) wfT[(hf * 4 + j) * 2048 + d] = v[j]; }
    for (int q = tid; q < 8192; q += 512) { const int b = q >> 12, r = q & 4095; float s = p.b_ada[r];
#pragma unroll
        for (int dc = 0; dc < 8; ++dc) s += modp[(dc * 2 + b) * 12288 + r];
        if (r < 2048) s1[b * 2048 + r] = s; else a1[b * 2048 + (r - 2048)] = p.g1[r - 2048] * (1.0f + s); }
    float* mod = WSP(float, WS_MOD);
    for (int q = F.bid * 512 + tid; q < 24576; q += F.G * 512) { const int b = q / 12288, r = q % 12288; float s = p.b_ada[r];
#pragma unroll
        for (int dc = 0; dc < 8; ++dc) s += modp[(dc * 2 + b) * 12288 + r];
        mod[q] = s; }
    __syncthreads();
    bf16_t* H1 = WSP(bf16_t, WS_H1); float* LOGF = WSP(float, WS_LOGF);
    for (int t = F.bid * 8 + F.wave; t < T_; t += F.G * 8) {
        asm volatile("" ::: "memory");
        const int b = t >> 13;
        const float* xr = p.x + (size_t)t * 2048;
        f32x4 v[8]; float ss = 0.f;
#pragma unroll
        for (int i = 0; i < 8; ++i) { v[i] = *(const f32x4*)(xr + (i * 64 + lane) * 4); ss += v[i][0] * v[i][0] + v[i][1] * v[i][1] + v[i][2] * v[i][2] + v[i][3] * v[i][3]; }
        ss = wave_sum(ss);
        const float rstd = rsqrtf(ss * (1.0f / 2048.0f) + EPS);
        float acc[8];
#pragma unroll
        for (int j = 0; j < 8; ++j) acc[j] = 0.f;
#if IN_MODE == 2
        float amax = 0.f;
#pragma unroll
        for (int i = 0; i < 8; ++i) { const int d = (i * 64 + lane) * 4;
            const f32x4 a = *(const LAS f32x4*)(a1 + b * 2048 + d), s = *(const LAS f32x4*)(s1 + b * 2048 + d);
            const f32x4 h = v[i] * rstd * a + s;
            amax = fmaxf(fmaxf(amax, fmaxf(fabsf(h[0]), fabsf(h[1]))), fmaxf(fabsf(h[2]), fabsf(h[3]))); }
#pragma unroll
        for (int o = 32; o > 0; o >>= 1) amax = fmaxf(amax, __shfl_xor(amax, o));
        const float qinv = amax > 0.f ? 127.0f / amax : 0.f;
        if (lane == 0) WSP(float, WS_RS)[t] = amax * (1.0f / 127.0f);
        asm volatile("" ::: "memory");
#pragma unroll
        for (int i = 0; i < 8; ++i) { const int d = (i * 64 + lane) * 4;
            const f32x4 a = *(const LAS f32x4*)(a1 + b * 2048 + d), s = *(const LAS f32x4*)(s1 + b * 2048 + d);
            const f32x4 h = v[i] * rstd * a + s;
            *(unsigned*)((unsigned char*)H1 + (size_t)t * 2048 + d) = pack4_i8(qinv * h[0], qinv * h[1], qinv * h[2], qinv * h[3]);
#pragma unroll
            for (int j = 0; j < 8; ++j) { const f32x4 wv = *(const LAS f32x4*)(wfT + j * 2048 + d); acc[j] += h[0] * wv[0] + h[1] * wv[1] + h[2] * wv[2] + h[3] * wv[3]; } }
#else
#pragma unroll
        for (int i = 0; i < 8; ++i) { const int d = (i * 64 + lane) * 4;
            const f32x4 a = *(const LAS f32x4*)(a1 + b * 2048 + d), s = *(const LAS f32x4*)(s1 + b * 2048 + d);
            const f32x4 h = v[i] * rstd * a + s;
#if IN_MODE == 1
            *(unsigned*)((unsigned char*)H1 + (size_t)t * 2048 + d) = pack4_fp8(4.0f * h[0], 4.0f * h[1], 4.0f * h[2], 4.0f * h[3]);
#else
            u32x2 w; w.x = cvt_pk_bf16(h[0], h[1]); w.y = cvt_pk_bf16(h[2], h[3]);
            *(u32x2*)(H1 + (size_t)t * 2048 + d) = w;
#endif
#pragma unroll
            for (int j = 0; j < 8; ++j) { const f32x4 wv = *(const LAS f32x4*)(wfT + j * 2048 + d); acc[j] += h[0] * wv[0] + h[1] * wv[1] + h[2] * wv[2] + h[3] * wv[3]; } }
#endif
        float z = 0.f;
#pragma unroll
        for (int j = 0; j < 8; ++j) { const float r = wave_sum(acc[j]); if (lane == j) z = r; }
        if (lane < 8) { z += p.b_fgate[lane]; LOGF[(size_t)t * 8 + lane] = fminf(z, 0.f) - log1pf(expf(-fabsf(z))); }
    }
}

__device__ __forceinline__ void cum_scan(const Frame& F) {
    const int tid = F.tid;
    LAS float* sc = (LAS float*)F.lds;
    const float* LOGF = WSP(float, WS_LOGF); float* CUM = WSP(float, WS_CUM);
    for (int seq = F.bid; seq < 16; seq += F.G) { const int b = seq >> 3, h = seq & 7;
        float v[16]; float run = 0.f; const size_t base = (size_t)b * S_ + tid * 16;
#pragma unroll
        for (int i = 0; i < 16; ++i) { run += LOGF[(base + i) * 8 + h]; v[i] = run; }
        sc[tid] = run; __syncthreads();
        for (int off = 1; off < 512; off <<= 1) { const float tv = tid >= off ? sc[tid - off] : 0.f; __syncthreads(); sc[tid] += tv; __syncthreads(); }
        const float excl = tid ? sc[tid - 1] : 0.f;
#pragma unroll
        for (int i = 0; i < 16; ++i) CUM[(size_t)seq * S_ + tid * 16 + i] = excl + v[i];
        __syncthreads();
    }
}

constexpr int AT_KS = 288;
__device__ __forceinline__ void attn_unit(const Frame& F, int bh, int qb) {
    const int tid = F.tid, lane = F.lane, w = F.wave, fr = lane & 15, fq = lane >> 4;
    const int b = bh >> 3, h = bh & 7;
    const bf16_t* proj = WSP(bf16_t, WS_PROJ) + (size_t)b * S_ * NPROJ + h * 128;
    const bf16_t* Qp = proj + C_FQ; const bf16_t* Kp = proj + C_FK; const bf16_t* Vp = proj + C_FV;
    const float* cum = WSP(float, WS_CUM) + (size_t)bh * S_;
    LAS unsigned char* Kt = F.lds;
    LAS unsigned char* Vt = F.lds + 2 * 64 * AT_KS;
    LAS float* cs = (LAS float*)(F.lds + 4 * 64 * AT_KS);
    const int r0 = qb * 128 + w * 16;
    const int qpos = r0 + fr;
    bf16x8 qf[4];
#pragma unroll
    for (int ks = 0; ks < 4; ++ks) qf[ks] = *(const bf16x8*)(Qp + (size_t)qpos * NPROJ + ks * 32 + fq * 8);
    const float cq = cum[qpos] * LOG2E;
    const int ntiles = 2 * qb + 2;
    const float SC2 = 0.08838834764831845f * LOG2E;
    LAS float* wmax = cs + 128;
    LAS int* shi = (LAS int*)(cs + 136);
    float qn = 0.f, sdiag = 0.f;
    {
#pragma unroll
      for (int ks = 0; ks < 4; ++ks) { const u32x4 v = __builtin_bit_cast(u32x4, qf[ks]); const u32x4 kk = *(const u32x4*)(Kp + (size_t)qpos * NPROJ + ks * 32 + fq * 8);
          const float q0 = bflo(v.x), q1 = bfhi(v.x), q2 = bflo(v.y), q3 = bfhi(v.y), q4 = bflo(v.z), q5 = bfhi(v.z), q6 = bflo(v.w), q7 = bfhi(v.w);
          qn += q0 * q0 + q1 * q1 + q2 * q2 + q3 * q3 + q4 * q4 + q5 * q5 + q6 * q6 + q7 * q7;
          sdiag += q0 * bflo(kk.x) + q1 * bfhi(kk.x) + q2 * bflo(kk.y) + q3 * bfhi(kk.y) + q4 * bflo(kk.z) + q5 * bfhi(kk.z) + q6 * bflo(kk.w) + q7 * bfhi(kk.w); }
      qn += __shfl_xor(qn, 16); qn += __shfl_xor(qn, 32); sdiag += __shfl_xor(sdiag, 16); sdiag += __shfl_xor(sdiag, 32);
      if (tid < 2) shi[tid] = 0; }
    __syncthreads();
    float ce = 0.f;
    if (tid < ntiles) { const float kv = WSP(float, WS_KN)[bh * 128 + tid]; ce = cum[(tid + 1) * 64 - 1] * LOG2E; atomicMax((int*)(shi + 0), __float_as_int(kv)); }
    __syncthreads();
    { float rt = SC2 * sqrtf(qn) * sqrtf(__int_as_float(shi[0])) * 1.001f + cq - SC2 * sdiag;
#pragma unroll
      for (int o = 8; o >= 1; o >>= 1) rt = fmaxf(rt, __shfl_xor(rt, o));
      if (lane == 0) wmax[w] = rt; }
    __syncthreads();
    { float rmax = wmax[0];
#pragma unroll
      for (int i = 1; i < 8; ++i) rmax = fmaxf(rmax, wmax[i]);
      const float bound = rmax - ce + 0.02f;
      if (tid < 2 * qb && bound < -40.0f) atomicMax((int*)(shi + 1), tid + 1); }
    __syncthreads();
    const int j_lo = shi[1];
    float m = -1e30f, l = 0.f;
    f32x4 oT[8];
#pragma unroll
    for (int n = 0; n < 8; ++n) oT[n] = (f32x4){0.f, 0.f, 0.f, 0.f};
    const int skey = tid >> 3, sc16 = (tid & 7) * 16;
    u32x4 kA0, kA1, vA0, vA1, kB0, kB1, vB0, vB1; float cA = 0.f, cB = 0.f;
#define AT_LOAD(S_, j) do { const size_t ro = (size_t)((j) * 64 + skey) * NPROJ + sc16; \
        k##S_##0 = *(const u32x4*)(Kp + ro); k##S_##1 = *(const u32x4*)(Kp + ro + 8); v##S_##0 = *(const u32x4*)(Vp + ro); v##S_##1 = *(const u32x4*)(Vp + ro + 8); \
        if (tid < 64) c##S_ = cum[(j) * 64 + tid]; } while (0)
#define AT_WRITE(S_, buf) do { LAS unsigned char* kd = Kt + (buf) * 64 * AT_KS + skey * AT_KS + sc16 * 2; LAS unsigned char* vd = Vt + (buf) * 64 * AT_KS + skey * AT_KS + sc16 * 2; \
        *(LAS u32x4*)kd = k##S_##0; *(LAS u32x4*)(kd + 16) = k##S_##1; *(LAS u32x4*)vd = v##S_##0; *(LAS u32x4*)(vd + 16) = v##S_##1; if (tid < 64) cs[(buf) * 64 + tid] = c##S_ * LOG2E; } while (0)
#define AT_COMPUTE(j, buf) do { \
        const LAS unsigned char* kb = Kt + (buf) * 64 * AT_KS; \
        f32x4 st[4]; \
        _Pragma("unroll") for (int kt = 0; kt < 4; ++kt) { st[kt] = (f32x4){0.f, 0.f, 0.f, 0.f}; \
            _Pragma("unroll") for (int ks = 0; ks < 4; ++ks) { const bf16x8 a = *(const LAS bf16x8*)(kb + (kt * 16 + fr) * AT_KS + (ks * 32 + fq * 8) * 2); \
                st[kt] = __builtin_amdgcn_mfma_f32_16x16x32_bf16(a, qf[ks], st[kt], 0, 0, 0); } } \
        const int kbase = (j) * 64; \
        const bool diag = (kbase + 63 > r0); \
        float mx = -1e30f; \
        if (diag) {     \
            _Pragma("unroll") for (int kt = 0; kt < 4; ++kt) { const f32x4 ck = *(const LAS f32x4*)(cs + (buf) * 64 + kt * 16 + fq * 4); \
                _Pragma("unroll") for (int i = 0; i < 4; ++i) { float s2 = st[kt][i] * SC2 + (cq - ck[i]); \
                    if (kbase + kt * 16 + fq * 4 + i > qpos) s2 = -__builtin_inff(); \
                    st[kt][i] = s2; mx = fmaxf(mx, s2); } } \
        } else { \
            _Pragma("unroll") for (int kt = 0; kt < 4; ++kt) { const f32x4 ck = *(const LAS f32x4*)(cs + (buf) * 64 + kt * 16 + fq * 4); \
                _Pragma("unroll") for (int i = 0; i < 4; ++i) { const float s2 = st[kt][i] * SC2 + (cq - ck[i]); st[kt][i] = s2; mx = fmaxf(mx, s2); } } \
        } \
        mx = fmaxf(mx, __shfl_xor(mx, 16)); mx = fmaxf(mx, __shfl_xor(mx, 32)); \
        const float mn = fmaxf(m, mx); \
        const float alpha = __builtin_amdgcn_exp2f(m - mn); \
        m = mn; \
        float ps = 0.f; \
        _Pragma("unroll") for (int kt = 0; kt < 4; ++kt) \
            _Pragma("unroll") for (int i = 0; i < 4; ++i) { const float pv = __builtin_amdgcn_exp2f(st[kt][i] - mn); st[kt][i] = pv; ps += pv; } \
        ps += __shfl_xor(ps, 16); ps += __shfl_xor(ps, 32); \
        l = l * alpha + ps; \
        _Pragma("unroll") for (int n = 0; n < 8; ++n) oT[n] *= alpha; \
        bf16x8 pf[2]; \
        _Pragma("unroll") for (int kk = 0; kk < 2; ++kk) { u32x4 pw; pw.x = cvt_pk_bf16(st[2 * kk][0], st[2 * kk][1]); pw.y = cvt_pk_bf16(st[2 * kk][2], st[2 * kk][3]); \
            pw.z = cvt_pk_bf16(st[2 * kk + 1][0], st[2 * kk + 1][1]); pw.w = cvt_pk_bf16(st[2 * kk + 1][2], st[2 * kk + 1][3]); pf[kk] = __builtin_bit_cast(bf16x8, pw); } \
        const unsigned vaddr = (unsigned)(uintptr_t)(Vt + (buf) * 64 * AT_KS) + (unsigned)((fq * 4 + (fr >> 2)) * AT_KS + (fr & 3) * 8); \
        s16x4 va[8][4]; \
          \
        _Pragma("unroll") for (int g2 = 0; g2 < 5; ++g2) { \
            if (g2 < 4) asm volatile("ds_read_b64_tr_b16 %0, %8 offset:%9\n\tds_read_b64_tr_b16 %1, %8 offset:%10\n\tds_read_b64_tr_b16 %2, %8 offset:%11\n\tds_read_b64_tr_b16 %3, %8 offset:%12\n\t" \
                         "ds_read_b64_tr_b16 %4, %8 offset:%13\n\tds_read_b64_tr_b16 %5, %8 offset:%14\n\tds_read_b64_tr_b16 %6, %8 offset:%15\n\tds_read_b64_tr_b16 %7, %8 offset:%16" \
                         : "=&v"(va[2 * (g2 & 3) + 0][0]), "=&v"(va[2 * (g2 & 3) + 0][1]), "=&v"(va[2 * (g2 & 3) + 0][2]), "=&v"(va[2 * (g2 & 3) + 0][3]), \
                           "=&v"(va[2 * (g2 & 3) + 1][0]), "=&v"(va[2 * (g2 & 3) + 1][1]), "=&v"(va[2 * (g2 & 3) + 1][2]), "=&v"(va[2 * (g2 & 3) + 1][3]) \
                         : "v"(vaddr), \
                           "i"((2 * (g2 & 3) + 0) * 32), "i"(16 * AT_KS + (2 * (g2 & 3) + 0) * 32), "i"(32 * AT_KS + (2 * (g2 & 3) + 0) * 32), "i"(48 * AT_KS + (2 * (g2 & 3) + 0) * 32), \
                           "i"((2 * (g2 & 3) + 1) * 32), "i"(16 * AT_KS + (2 * (g2 & 3) + 1) * 32), "i"(32 * AT_KS + (2 * (g2 & 3) + 1) * 32), "i"(48 * AT_KS + (2 * (g2 & 3) + 1) * 32) : "memory"); \
            if (g2 >= 1) { \
                if (g2 < 4) asm volatile("s_waitcnt lgkmcnt(8)" ::: "memory"); else asm volatile("s_waitcnt lgkmcnt(0)" ::: "memory"); \
                __builtin_amdgcn_sched_barrier(0);     \
                _Pragma("unroll") for (int nn = 0; nn < 2; ++nn) { const int n = 2 * (g2 - 1) + nn; \
                    const bf16x8 v0 = (bf16x8){va[n][0][0], va[n][0][1], va[n][0][2], va[n][0][3], va[n][1][0], va[n][1][1], va[n][1][2], va[n][1][3]}; \
                    const bf16x8 v1 = (bf16x8){va[n][2][0], va[n][2][1], va[n][2][2], va[n][2][3], va[n][3][0], va[n][3][1], va[n][3][2], va[n][3][3]}; \
                    oT[n] = __builtin_amdgcn_mfma_f32_16x16x32_bf16(v0, pf[0], oT[n], 0, 0, 0); \
                    oT[n] = __builtin_amdgcn_mfma_f32_16x16x32_bf16(v1, pf[1], oT[n], 0, 0, 0); } } } \
    } while (0)
    AT_LOAD(A, j_lo); AT_WRITE(A, 0);
    if (j_lo + 1 < ntiles) AT_LOAD(B, j_lo + 1);
    __syncthreads();
    for (int j = j_lo; j < ntiles; j += 2) {
        {
            if (j + 2 < ntiles) AT_LOAD(A, j + 2);
            AT_COMPUTE(j, 0);
            if (j + 1 < ntiles) AT_WRITE(B, 1);
            __syncthreads();
        }
        if (j + 1 < ntiles) {
            if (j + 3 < ntiles) AT_LOAD(B, j + 3);
            AT_COMPUTE(j + 1, 1);
            if (j + 2 < ntiles) AT_WRITE(A, 0);
            __syncthreads();
        }
    }
#undef AT_LOAD
#undef AT_WRITE
#undef AT_COMPUTE
    const float rl = 1.0f / l;
    float ssq = 0.f;
    bf16_t* orow = WSP(bf16_t, WS_MIXED) + ((size_t)b * S_ + qpos) * 2048 + h * 128 + fq * 4;
#pragma unroll
    for (int n = 0; n < 8; ++n) { const f32x4 o = oT[n] * rl; ssq += o[0] * o[0] + o[1] * o[1] + o[2] * o[2] + o[3] * o[3];
        u32x2 wv; wv.x = cvt_pk_bf16(o[0], o[1]); wv.y = cvt_pk_bf16(o[2], o[3]); *(u32x2*)(orow + n * 16) = wv; }
    ssq += __shfl_xor(ssq, 16); ssq += __shfl_xor(ssq, 32);
    if (fq == 0) WSP(float, WS_SSQ)[((size_t)b * S_ + qpos) * 8 + h] = ssq;
    __syncthreads();
}


__device__ __forceinline__ void knorm_pass(const Frame& F) {
    const int lane = F.lane, r = lane >> 4, c = lane & 15;
    float* KN = WSP(float, WS_KN);
    for (int u = F.bid * 8 + F.wave; u < 2048; u += F.G * 8) { const int bh = u >> 7, j = u & 127, b = bh >> 3, h = bh & 7;
        const bf16_t* kp = WSP(bf16_t, WS_PROJ) + ((size_t)b * S_ + j * 64 + r) * NPROJ + C_FK + h * 128 + c * 8;
        float mx = 0.f;
#pragma unroll
        for (int it = 0; it < 16; ++it) { const u32x4 v = *(const u32x4*)(kp + (size_t)it * 4 * NPROJ);
            float s = bflo(v.x) * bflo(v.x) + bfhi(v.x) * bfhi(v.x) + bflo(v.y) * bflo(v.y) + bfhi(v.y) * bfhi(v.y) + bflo(v.z) * bflo(v.z) + bfhi(v.z) * bfhi(v.z) + bflo(v.w) * bflo(v.w) + bfhi(v.w) * bfhi(v.w);
#pragma unroll
            for (int o = 8; o >= 1; o >>= 1) s += __shfl_xor(s, o);
            mx = fmaxf(mx, s); }
        mx = fmaxf(mx, __shfl_xor(mx, 16)); mx = fmaxf(mx, __shfl_xor(mx, 32));
        if (lane == 0) KN[u] = mx; }
}

__device__ __forceinline__ void hg_load_col(const Frame& F, int bh, int n, int colbase, unsigned short (&r)[16]) {
    const int tid = F.tid, dk = tid & 127, rq = tid >> 7, b = bh >> 3, h = bh & 7;
    const bf16_t* ptr = WSP(bf16_t, WS_PROJ) + ((size_t)b * S_ + n * 64 + rq * 16) * NPROJ + colbase + h * 128 + dk;
#pragma unroll
    for (int i = 0; i < 16; ++i) r[i] = ptr[(size_t)i * NPROJ];
}
__device__ __forceinline__ void hg_gates(const Params& p, const Frame& F, LAS float* qsum, int h, const unsigned short (&hf)[16], float (&fv)[16], float (&bc)[16], float& blast) {
    const int tid = F.tid, dk = tid & 127, rq = tid >> 7;
    const float l0 = p.lb_logits[h * 128 + dk], l1 = p.lb_logits[1024 + h * 128 + dk];
    const float lb = __builtin_amdgcn_rcpf(1.0f + __expf(l1 - l0));
    float run = 0.f;
#pragma unroll
    for (int i = 0; i < 16; ++i) { const float z = bf2f(hf[i]); const float f = lb + (1.0f - lb) * __builtin_amdgcn_rcpf(1.0f + __builtin_amdgcn_exp2f(z * -LOG2E)); fv[i] = f; run += __builtin_amdgcn_logf(f); bc[i] = run; }
    qsum[rq * 128 + dk] = run;
    __syncthreads();
    float off = 0.f, tot = 0.f;
#pragma unroll
    for (int q = 0; q < 4; ++q) { const float v = qsum[q * 128 + dk]; tot += v; if (q < rq) off += v; }
#pragma unroll
    for (int i = 0; i < 16; ++i) bc[i] += off;
    blast = tot;
}

__device__ __forceinline__ void hgu_unit(const Params& p, const Frame& F, int bh, int n, const unsigned short (&hf)[16], const unsigned short (&hi)[16]) {
    const int tid = F.tid, lane = F.lane, w = F.wave, fr = lane & 15, fq = lane >> 4;
    const int h = bh & 7, dk = tid & 127, rq = tid >> 7;
    LAS bf16_t* kT = (LAS bf16_t*)F.lds;
    LAS bf16_t* vT = kT + 128 * 72;
    LAS float* qsum = (LAS float*)(vT + 128 * 72);
    float fv[16], bc[16], blast;
    hg_gates(p, F, qsum, h, hf, fv, bc, blast);
#pragma unroll
    for (int i = 0; i < 16; i += 2) { const float k0 = (1.0f - fv[i]) * __builtin_amdgcn_exp2f(blast - bc[i]), k1 = (1.0f - fv[i + 1]) * __builtin_amdgcn_exp2f(blast - bc[i + 1]);
        *(LAS unsigned*)(kT + dk * 72 + rq * 16 + i) = cvt_pk_bf16(k0, k1); }
    if (rq == 0) WSP(float, WS_HGDEC)[((size_t)bh * 128 + n) * 128 + dk] = __builtin_amdgcn_exp2f(blast);
#pragma unroll
    for (int i = 0; i < 16; i += 2) *(LAS unsigned*)(vT + dk * 72 + rq * 16 + i) = (unsigned)hi[i] | ((unsigned)hi[i + 1] << 16);
    __syncthreads();
    f32x4 acc[8];
#pragma unroll
    for (int nt = 0; nt < 8; ++nt) acc[nt] = (f32x4){0.f, 0.f, 0.f, 0.f};
#pragma unroll
    for (int ks = 0; ks < 2; ++ks) { const bf16x8 a = *(const LAS bf16x8*)(kT + (w * 16 + fr) * 72 + ks * 32 + fq * 8);
#pragma unroll
        for (int nt = 0; nt < 8; ++nt) { const bf16x8 bv = *(const LAS bf16x8*)(vT + (nt * 16 + fr) * 72 + ks * 32 + fq * 8);
            acc[nt] = __builtin_amdgcn_mfma_f32_16x16x32_bf16(a, bv, acc[nt], 0, 0, 0); } }
    bf16_t* U = WSP(bf16_t, WS_HGU) + ((size_t)bh * 128 + n) * 16384;
#pragma unroll
    for (int nt = 0; nt < 8; ++nt) { u32x2 wv; wv.x = cvt_pk_bf16(acc[nt][0], acc[nt][1]); wv.y = cvt_pk_bf16(acc[nt][2], acc[nt][3]); *(u32x2*)(U + (size_t)(nt * 16 + fr) * 128 + w * 16 + fq * 4) = wv; }
    __syncthreads();
}

__device__ __forceinline__ void hg_scan(const Frame& F) {
    const bf16_t* U = WSP(bf16_t, WS_HGU); const float* DEC = WSP(float, WS_HGDEC); bf16_t* SP = WSP(bf16_t, WS_HGSP);
    for (int idx = F.bid * 512 + F.tid; idx < 16 * 8192; idx += F.G * 512) {
        const int bh = idx >> 13, rem = idx & 8191, dv = rem >> 6, dk2 = (rem & 63) * 2;
        const size_t e0 = (size_t)bh * 128 * 16384 + (size_t)dv * 128 + dk2;
        const size_t d0 = (size_t)bh * 128 * 128 + dk2;
        f32x2 s = {0.f, 0.f};
        for (int n0 = 0; n0 < 128; n0 += 8) {
            unsigned u[8]; f32x2 d[8];
#pragma unroll
            for (int k = 0; k < 8; ++k) { u[k] = *(const unsigned*)(U + e0 + (size_t)(n0 + k) * 16384); d[k] = *(const f32x2*)(DEC + d0 + (size_t)(n0 + k) * 128); }
#pragma unroll
            for (int k = 0; k < 8; ++k) { *(unsigned*)(SP + e0 + (size_t)(n0 + k) * 16384) = cvt_pk_bf16(s[0], s[1]); s = d[k] * s + (f32x2){bflo(u[k]), bfhi(u[k])}; }
        }
    }
}

__device__ __forceinline__ void hgo_unit(const Params& p, const Frame& F, int bh, int n, const unsigned short (&hf)[16], const unsigned short (&hq)[16], const unsigned short (&hi)[16], const u32x4 (&spr)[4]) {
    const int tid = F.tid, lane = F.lane, w = F.wave, fr = lane & 15, fq = lane >> 4;
    const int b = bh >> 3, h = bh & 7, dk = tid & 127, rq = tid >> 7;
    LAS bf16_t* qd = (LAS bf16_t*)F.lds;
    LAS bf16_t* ki = qd + 64 * 136;
    LAS bf16_t* vT = ki + 64 * 136;
    LAS bf16_t* at = vT + 128 * 72;
    LAS bf16_t* sp = at + 64 * 72;
    LAS float* qsum = (LAS float*)(sp + 128 * 136);
    LAS float* rs = qsum + 512;
    const size_t trow = (size_t)b * S_ + n * 64;
    bf16_t* fxp = WSP(bf16_t, WS_MIXED) + (trow + (tid >> 3)) * 2048 + h * 128 + (tid & 7) * 16;
    const u32x4 fx0 = *(const u32x4*)fxp, fx1 = *(const u32x4*)(fxp + 8);
    const f32x4 sq0 = *(const f32x4*)(WSP(float, WS_SSQ) + (trow + (tid >> 3)) * 8), sq1 = *(const f32x4*)(WSP(float, WS_SSQ) + (trow + (tid >> 3)) * 8 + 4);
    u32x2 gwv[4];
    { const bf16_t* hg = WSP(bf16_t, WS_PROJ) + (trow + (w & 3) * 16 + fr) * NPROJ + C_HG + h * 128;
#pragma unroll
      for (int q = 0; q < 4; ++q) gwv[q] = *(const u32x2*)(hg + ((w >> 2) * 4 + q) * 16 + fq * 4); }
    float fv[16], bc[16], blast;
    hg_gates(p, F, qsum, h, hf, fv, bc, blast);
#pragma unroll
    for (int i = 0; i < 16; ++i) { const float q = bf2f(hq[i]); const float qq = q * __builtin_amdgcn_rcpf(1.0f + __builtin_amdgcn_exp2f(q * -LOG2E));
        const float qdv = qq * __builtin_amdgcn_exp2f(bc[i]), kiv = (1.0f - fv[i]) * __builtin_amdgcn_exp2f(-bc[i]);
        qd[(rq * 16 + i) * 136 + dk] = (bf16_t)(cvt_pk_bf16(qdv, 0.f) & 0xffffu);
        ki[(rq * 16 + i) * 136 + dk] = (bf16_t)(cvt_pk_bf16(kiv, 0.f) & 0xffffu); }
#pragma unroll
    for (int i = 0; i < 16; i += 2) *(LAS unsigned*)(vT + dk * 72 + rq * 16 + i) = (unsigned)hi[i] | ((unsigned)hi[i + 1] << 16);
#pragma unroll
    for (int r = 0; r < 4; ++r) { const int q = tid + 512 * r, dv = q >> 4, ch = q & 15; *(LAS u32x4*)(sp + dv * 136 + ch * 8) = spr[r]; }
    __syncthreads();
    { const int ct = w & 3;
#pragma unroll
      for (int q = 0; q < 2; ++q) { const int st = (w >> 2) * 2 + q;
          f32x4 a = {0.f, 0.f, 0.f, 0.f};
          if (st <= ct) {
#pragma unroll
              for (int ks = 0; ks < 4; ++ks) { const bf16x8 ka = *(const LAS bf16x8*)(ki + (st * 16 + fr) * 136 + ks * 32 + fq * 8); const bf16x8 qb = *(const LAS bf16x8*)(qd + (ct * 16 + fr) * 136 + ks * 32 + fq * 8);
                  a = __builtin_amdgcn_mfma_f32_16x16x32_bf16(ka, qb, a, 0, 0, 0); } }
          const int c = ct * 16 + fr;
#pragma unroll
          for (int i = 0; i < 4; ++i) if (st * 16 + fq * 4 + i > c) a[i] = 0.f;
          u32x2 wv; wv.x = cvt_pk_bf16(a[0], a[1]); wv.y = cvt_pk_bf16(a[2], a[3]);
          *(LAS u32x2*)(at + c * 72 + st * 16 + fq * 4) = wv; } }
    __syncthreads();
    const int ct = w & 3, dh = w >> 2;
    f32x4 acc[4];
#pragma unroll
    for (int q = 0; q < 4; ++q) acc[q] = (f32x4){0.f, 0.f, 0.f, 0.f};
#pragma unroll
    for (int ks = 0; ks < 2; ++ks) { const bf16x8 bb = *(const LAS bf16x8*)(at + (ct * 16 + fr) * 72 + ks * 32 + fq * 8);
#pragma unroll
        for (int q = 0; q < 4; ++q) { const bf16x8 aa = *(const LAS bf16x8*)(vT + ((dh * 4 + q) * 16 + fr) * 72 + ks * 32 + fq * 8);
            acc[q] = __builtin_amdgcn_mfma_f32_16x16x32_bf16(aa, bb, acc[q], 0, 0, 0); } }
#pragma unroll
    for (int ks = 0; ks < 4; ++ks) { const bf16x8 bb = *(const LAS bf16x8*)(qd + (ct * 16 + fr) * 136 + ks * 32 + fq * 8);
#pragma unroll
        for (int q = 0; q < 4; ++q) { const bf16x8 aa = *(const LAS bf16x8*)(sp + ((dh * 4 + q) * 16 + fr) * 136 + ks * 32 + fq * 8);
            acc[q] = __builtin_amdgcn_mfma_f32_16x16x32_bf16(aa, bb, acc[q], 0, 0, 0); } }
    float ss = 0.f;
#pragma unroll
    for (int q = 0; q < 4; ++q) ss += acc[q][0] * acc[q][0] + acc[q][1] * acc[q][1] + acc[q][2] * acc[q][2] + acc[q][3] * acc[q][3];
    ss += __shfl_xor(ss, 16); ss += __shfl_xor(ss, 32);
    const int c = ct * 16 + fr;
    if (fq == 0) rs[c * 2 + dh] = ss;
    __syncthreads();
    const float rstd = rsqrtf((rs[c * 2] + rs[c * 2 + 1]) * (1.0f / 128.0f) + EPS);
    bf16_t* orow = WSP(bf16_t, WS_MIXED) + (trow + c) * 2048 + 1024 + h * 128;
#pragma unroll
    for (int q = 0; q < 4; ++q) { const int dv = (dh * 4 + q) * 16 + fq * 4;
        const u32x2 gw = gwv[q]; const f32x4 gn = *(const f32x4*)(p.g_hg + h * 128 + dv);
        const float g0 = bflo(gw.x), g1 = bfhi(gw.x), g2 = bflo(gw.y), g3 = bfhi(gw.y);
        const float o0 = acc[q][0] * rstd * gn[0] * (g0 * __builtin_amdgcn_rcpf(1.0f + __expf(-g0))), o1 = acc[q][1] * rstd * gn[1] * (g1 * __builtin_amdgcn_rcpf(1.0f + __expf(-g1)));
        const float o2 = acc[q][2] * rstd * gn[2] * (g2 * __builtin_amdgcn_rcpf(1.0f + __expf(-g2))), o3 = acc[q][3] * rstd * gn[3] * (g3 * __builtin_amdgcn_rcpf(1.0f + __expf(-g3)));
#if FP8_OUT
        *(unsigned*)(F.ws + WS_MIX8 + (trow + c) * 2048 + 1024 + h * 128 + dv) = pack4_fp8(4.0f * o0, 4.0f * o1, 4.0f * o2, 4.0f * o3);
#else
        u32x2 wv; wv.x = cvt_pk_bf16(o0, o1); wv.y = cvt_pk_bf16(o2, o3); *(u32x2*)(orow + dv) = wv;
#endif
    }
    { const float rstdf = rsqrtf(((sq0[0] + sq0[1]) + (sq0[2] + sq0[3]) + (sq1[0] + sq1[1]) + (sq1[2] + sq1[3])) * (1.0f / 1024.0f) + EPS);
      const float* gf = p.g_fox + h * 128 + (tid & 7) * 16;
#if FP8_OUT
      const float rs4 = 4.0f * rstdf;
      const f32x4 ga = *(const f32x4*)gf * rs4, gb = *(const f32x4*)(gf + 4) * rs4, gc = *(const f32x4*)(gf + 8) * rs4, gd = *(const f32x4*)(gf + 12) * rs4;
      u32x4 ov;
      ov.x = pack4_fp8(bflo(fx0.x) * ga[0], bfhi(fx0.x) * ga[1], bflo(fx0.y) * ga[2], bfhi(fx0.y) * ga[3]); ov.y = pack4_fp8(bflo(fx0.z) * gb[0], bfhi(fx0.z) * gb[1], bflo(fx0.w) * gb[2], bfhi(fx0.w) * gb[3]);
      ov.z = pack4_fp8(bflo(fx1.x) * gc[0], bfhi(fx1.x) * gc[1], bflo(fx1.y) * gc[2], bfhi(fx1.y) * gc[3]); ov.w = pack4_fp8(bflo(fx1.z) * gd[0], bfhi(fx1.z) * gd[1], bflo(fx1.w) * gd[2], bfhi(fx1.w) * gd[3]);
      *(u32x4*)(F.ws + WS_MIX8 + (trow + (tid >> 3)) * 2048 + h * 128 + (tid & 7) * 16) = ov; }
#else
      const f32x4 ga = *(const f32x4*)gf * rstdf, gb = *(const f32x4*)(gf + 4) * rstdf, gc = *(const f32x4*)(gf + 8) * rstdf, gd = *(const f32x4*)(gf + 12) * rstdf;
      u32x4 o0v, o1v;
      o0v.x = cvt_pk_bf16(bflo(fx0.x) * ga[0], bfhi(fx0.x) * ga[1]); o0v.y = cvt_pk_bf16(bflo(fx0.y) * ga[2], bfhi(fx0.y) * ga[3]); o0v.z = cvt_pk_bf16(bflo(fx0.z) * gb[0], bfhi(fx0.z) * gb[1]); o0v.w = cvt_pk_bf16(bflo(fx0.w) * gb[2], bfhi(fx0.w) * gb[3]);
      o1v.x = cvt_pk_bf16(bflo(fx1.x) * gc[0], bfhi(fx1.x) * gc[1]); o1v.y = cvt_pk_bf16(bflo(fx1.y) * gc[2], bfhi(fx1.y) * gc[3]); o1v.z = cvt_pk_bf16(bflo(fx1.z) * gd[0], bfhi(fx1.z) * gd[1]); o1v.w = cvt_pk_bf16(bflo(fx1.w) * gd[2], bfhi(fx1.w) * gd[3]);
      *(u32x4*)fxp = o0v; *(u32x4*)(fxp + 8) = o1v; }
#endif
    __syncthreads();
}

constexpr int HS_STRIDE = 2052;
__device__ __forceinline__ void phase7(const Params& p, const Frame& F) {
    const int tid = F.tid, lane = F.lane, w = F.wave;
    LAS float* hs = (LAS float*)F.lds;
    LAS float* part = hs + 16 * HS_STRIDE;
    LAS float* lg = part + 8 * 16 * 32;
    LAS int* hist = (LAS int*)(lg + 512);
    const float* mod = WSP(float, WS_MOD); const bf16_t* X1 = WSP(bf16_t, WS_X1);
    unsigned char* H2 = F.ws + WS_H2; int* TOPI = WSP(int, WS_TOPI); float* TOPG = WSP(float, WS_TOPG); int* CNT = WSP(int, WS_CNT);
    float wreg[16][4][2];
    { const int i16 = lane & 15, kq = lane >> 4;
#pragma unroll
      for (int kb = 0; kb < 16; ++kb)
#pragma unroll
          for (int sx = 0; sx < 4; ++sx) { const float* wp = p.w_router + (size_t)(256 * w + 16 * kb + 4 * kq + sx) * 32 + i16; wreg[kb][sx][0] = wp[0]; wreg[kb][sx][1] = wp[16]; } }
    for (int chunk = F.bid; chunk < 256; chunk += F.G) {
        if (tid < 32) hist[tid] = 0;
        __syncthreads();
        for (int gi = 0; gi < 4; ++gi) {
            const int t0 = chunk * 64 + gi * 16;
#pragma unroll
            for (int r = 0; r < 2; ++r) { const int tk = 2 * w + r, t = t0 + tk, b = t >> 13;
                const bf16_t* xr = X1 + (size_t)t * 2048;
                f32x4 v[8]; float ss = 0.f;
#pragma unroll
                for (int i = 0; i < 8; ++i) { const u32x2 xw = *(const u32x2*)(xr + (i * 64 + lane) * 4); v[i] = (f32x4){bflo(xw.x), bfhi(xw.x), bflo(xw.y), bfhi(xw.y)}; ss += v[i][0] * v[i][0] + v[i][1] * v[i][1] + v[i][2] * v[i][2] + v[i][3] * v[i][3]; }
                ss = wave_sum(ss);
                const float rstd = rsqrtf(ss * (1.0f / 2048.0f) + EPS);
#pragma unroll
                for (int i = 0; i < 8; ++i) { const int d = (i * 64 + lane) * 4;
                    const f32x4 sh = *(const f32x4*)(mod + b * 12288 + 6144 + d), sc = *(const f32x4*)(mod + b * 12288 + 8192 + d), g = *(const f32x4*)(p.g2 + d);
                    const f32x4 hv = v[i] * rstd * g * (sc + 1.0f) + sh;
                    *(unsigned*)(H2 + (size_t)t * 2048 + d) = pack4_fp8(hv[0], hv[1], hv[2], hv[3]);
                    *(LAS f32x4*)(hs + tk * HS_STRIDE + d) = hv; } }
            __syncthreads();
            { const int i16 = lane & 15, kq = lane >> 4;
              f32x4 c0 = {0.f, 0.f, 0.f, 0.f}, c1 = {0.f, 0.f, 0.f, 0.f};
#pragma unroll
              for (int kb = 0; kb < 16; ++kb) { const int kbase = 256 * w + 16 * kb + 4 * kq;
                  const f32x4 a4 = *(const LAS f32x4*)(hs + i16 * HS_STRIDE + kbase);
#pragma unroll
                  for (int sx = 0; sx < 4; ++sx) {
                      c0 = __builtin_amdgcn_mfma_f32_16x16x4f32(a4[sx], wreg[kb][sx][0], c0, 0, 0, 0); c1 = __builtin_amdgcn_mfma_f32_16x16x4f32(a4[sx], wreg[kb][sx][1], c1, 0, 0, 0); } }
#pragma unroll
              for (int r = 0; r < 4; ++r) { part[(w * 16 + 4 * kq + r) * 32 + i16] = c0[r]; part[(w * 16 + 4 * kq + r) * 32 + 16 + i16] = c1[r]; } }
            __syncthreads();
            {
                const int tk = tid >> 5, e = tid & 31; float cur = p.b_router[e];
#pragma unroll
                for (int w8 = 0; w8 < 8; ++w8) cur += part[(w8 * 16 + tk) * 32 + e];
                float vals[4]; int ids[4];
#pragma unroll
                for (int k = 0; k < 4; ++k) { float bv = cur; int bi = e;
#pragma unroll
                    for (int o = 16; o >= 1; o >>= 1) { const float ov = __shfl_xor(bv, o); const int oi = __shfl_xor(bi, o); if (ov > bv || (ov == bv && oi < bi)) { bv = ov; bi = oi; } }
                    vals[k] = bv; ids[k] = bi; if (e == bi) cur = -__builtin_inff(); }
                if (e == 0) { const int t = t0 + tk; float ex[4], se = 0.f;
#pragma unroll
                    for (int k = 0; k < 4; ++k) { ex[k] = __expf(vals[k] - vals[0]); se += ex[k]; }
                    const float inv = 1.0f / se;
#pragma unroll
                    for (int k = 0; k < 4; ++k) { TOPI[(size_t)t * 4 + k] = ids[k]; TOPG[(size_t)t * 4 + k] = ex[k] * inv; atomicAdd((int*)(hist + ids[k]), 1); } } }
            __syncthreads();
        }
        if (tid < 32) CNT[chunk * 32 + tid] = hist[tid];
        __syncthreads();
    }
}

__device__ __forceinline__ void phase8(const Frame& F) {
    const int tid = F.tid, lane = F.lane, w = F.wave;
    LAS int* cn = (LAS int*)F.lds;
    LAS int* part = cn + 8192;
    LAS int* tot = part + 512;
    LAS int* base = tot + 32;
    LAS int* pst = base + 32;
    LAS int* wcnt = pst + 40;
    const int* CNT = WSP(int, WS_CNT); const int* TOPI = WSP(int, WS_TOPI);
    int* POS = WSP(int, WS_POS); int* SRC = WSP(int, WS_SRC); int* TILEE = WSP(int, WS_TILEE);
    const int chunk0 = F.bid;
    int e_pre = 0;
    if (tid < 256 && chunk0 < 256) e_pre = TOPI[(size_t)chunk0 * 256 + tid];
    for (int q = tid; q < 8192; q += 512) cn[q] = CNT[q];
    __syncthreads();
    { const int e = tid & 31, g = tid >> 5; int sacc = 0;
#pragma unroll
      for (int c = 0; c < 16; ++c) sacc += cn[(g * 16 + c) * 32 + e];
      part[g * 32 + e] = sacc; }
    __syncthreads();
    if (tid < 32) { int run = 0;
#pragma unroll
        for (int g = 0; g < 16; ++g) run += part[g * 32 + tid];
        tot[tid] = run; }
    __syncthreads();
    if (tid < 32) {
        const int pad = (tot[tid] + 255) / 256 * 256; int incl = pad;
#pragma unroll
        for (int o = 1; o < 32; o <<= 1) { const int v = __shfl_up(incl, o); if (tid >= o) incl += v; }
        pst[tid] = incl - pad; if (tid == 31) pst[32] = incl; }
    __syncthreads();
    for (int chunk = chunk0; chunk < 256; chunk += F.G) {
        if (tid < 32) { const int g = chunk >> 4; int run = 0;
            for (int gg = 0; gg < g; ++gg) run += part[gg * 32 + tid];
            for (int c = g * 16; c < chunk; ++c) run += cn[c * 32 + tid];
            base[tid] = run; }
        int e = e_pre; if (chunk != chunk0 && tid < 256) e = TOPI[(size_t)chunk * 256 + tid];
        int rk = 0;
        if (tid < 256) {
#pragma unroll 8
            for (int k = 0; k < 32; ++k) { const unsigned long long mk = __ballot(e == k);
                if (e == k) rk = __popcll(mk & ((1ull << lane) - 1ull));
                if (lane == k) wcnt[w * 32 + k] = __popcll(mk); } }
        __syncthreads();
        if (tid < 256) { int before = 0;
            for (int ww = 0; ww < w; ++ww) before += wcnt[ww * 32 + e];
            const int pos = pst[e] + base[e] + before + rk; POS[(size_t)chunk * 256 + tid] = pos; SRC[pos] = chunk * 64 + (tid >> 2); }
        if (chunk < 32) { const int ee = chunk; for (int r = pst[ee] + tot[ee] + tid; r < pst[ee + 1]; r += 512) SRC[r] = 0; }
        if (chunk == 0) { const int ntl = pst[32] >> 8; for (int i = tid; i < ntl; i += 512) { int ee = 0;
#pragma unroll
                for (int k = 0; k < 32; ++k) if (pst[k] <= i * 256) ee = k;
                TILEE[i] = ee; }
            if (tid == 0) TILEE[MAXTILES] = ntl; }
        __syncthreads();
    }
}

__device__ __forceinline__ void phase11(const Params& p, const Frame& F) {
    const int lane = F.lane;
    const float* mod = WSP(float, WS_MOD); const bf16_t* X1 = WSP(bf16_t, WS_X1); const unsigned char* Y = F.ws + WS_YBUF;
    const int* POS = WSP(int, WS_POS); const float* TOPG = WSP(float, WS_TOPG);
    for (int t = F.bid * 8 + F.wave; t < T_; t += F.G * 8) {
        const int b = t >> 13;
        int ps[4]; float gk[4];
#pragma unroll
        for (int k = 0; k < 4; ++k) { ps[k] = POS[(size_t)t * 4 + k]; gk[k] = TOPG[(size_t)t * 4 + k] * (1.0f / 16.0f); }
        f32x4 v[8]; float ss = 0.f;
#pragma unroll
        for (int i = 0; i < 8; ++i) { const int d = (i * 64 + lane) * 4;
            f32x4 a = {0.f, 0.f, 0.f, 0.f};
#pragma unroll
            for (int k = 0; k < 4; ++k) { const int yw = *(const int*)(Y + (size_t)ps[k] * 2048 + d);
                const f32x2 ylo = __builtin_amdgcn_cvt_pk_f32_fp8(yw, false), yhi = __builtin_amdgcn_cvt_pk_f32_fp8(yw, true);
                a[0] += gk[k] * ylo[0]; a[1] += gk[k] * ylo[1]; a[2] += gk[k] * yhi[0]; a[3] += gk[k] * yhi[1]; }
            const f32x4 gt = *(const f32x4*)(mod + b * 12288 + 10240 + d);
            const u32x2 xw = *(const u32x2*)(X1 + (size_t)t * 2048 + d);
            v[i] = (f32x4){bflo(xw.x), bfhi(xw.x), bflo(xw.y), bfhi(xw.y)} + gt * a;
            ss += v[i][0] * v[i][0] + v[i][1] * v[i][1] + v[i][2] * v[i][2] + v[i][3] * v[i][3]; }
        ss = wave_sum(ss);
        const float rstd = rsqrtf(ss * (1.0f / 2048.0f) + EPS);
#pragma unroll
        for (int i = 0; i < 8; ++i) { const int d = (i * 64 + lane) * 4; const f32x4 g = *(const f32x4*)(p.g_final + d);
            *(f32x4*)(p.out + (size_t)t * 2048 + d) = v[i] * rstd * g; }
    }
}

__global__ void __launch_bounds__(512, 2) fwd(Params p) {
    extern __shared__ __attribute__((aligned(16))) unsigned char lds_raw[];
    Frame F;
    F.lds = (LAS unsigned char*)lds_raw;
    F.tid = threadIdx.x; F.lane = F.tid & 63; F.wave = __builtin_amdgcn_readfirstlane(F.tid >> 6);
    F.G = gridDim.x; F.bid = blockIdx.x; F.ws = p.ws;
    volatile LAS unsigned* xbw = (volatile LAS unsigned*)(F.lds + LDS_BYTES - 16);
    if (F.tid < 4) xbw[F.tid] = 0u;
    __syncthreads();
    const int lo = p.lo, hi = p.hi;
    const bool multi = (hi - lo) > 1;
    XcdBarrier bar; bar.bar = (unsigned*)(p.ws + WS_CTL); bar.x = 0; bar.st = xbw;
    if (multi) bar = xcd_barrier_post((unsigned*)(p.ws + WS_CTL), xbw);
#define IN(k) (lo <= (k) && (k) < hi)
#define SEAM(k) do { if (IN((k) + 1)) xcd_barrier(bar); } while (0)

    if (IN(0)) { phase0(p, F); SEAM(0); }
    if (IN(1)) { phase1(p, F);
#if IN_MODE == 2
        __syncthreads(); wtile_pass<0>(p, F, 0, 896);
#endif
        SEAM(1); }
    if (IN(2)) {
        cum_scan(F);
        pg8::SplitOrder S; S.init(T_, NPROJ, F.G, F.bid, CONV_NCG, CONV_NA, WGM_IN);
        if ((F.G & 63) != 0) conv8_range(p, F, F.bid, F.G);
        else if (S.conv) conv8_range(p, F, S.conv_rank(CONV_NCG), (F.G >> 3) * CONV_NCG);
        __syncthreads();
#if IN_MODE == 2
        pg8::SrcPlain X{WSP(bf16_t, WS_H1), WSP(bf16_t, WS_WIN), 1024};
        pg8::EpiProjI8 E{WSP(bf16_t, WS_PROJ), NPROJ, WSP(float, WS_RS), WSP(float, WS_CMAX)};
        pg8::gemm_phase<2>(F.lds, 1024, S, X, E);
#elif IN_MODE == 1
        pg8::SrcPlain X{WSP(bf16_t, WS_H1), WSP(bf16_t, WS_WIN), 1024};
        pg8::EpiProj E{WSP(bf16_t, WS_PROJ), NPROJ, 1.0f / 256.0f};
        pg8::gemm_phase<1>(F.lds, 1024, S, X, E);
#else
        pg8::SrcPlain X{WSP(bf16_t, WS_H1), WSP(bf16_t, WS_WIN), 2048};
        pg8::EpiProj E{WSP(bf16_t, WS_PROJ), NPROJ, 1.0f};
        pg8::gemm_phase<0>(F.lds, 2048, S, X, E);
#endif
        SEAM(2);
    }
    if (IN(3)) {
        {   unsigned short fa[16], va[16], fb[16], vb[16];
            int u = F.bid;
            if (u < 2048) { hg_load_col(F, u >> 7, u & 127, C_HF, fa); hg_load_col(F, u >> 7, u & 127, C_HI, va); }
            while (u < 2048) { const int un = u + F.G;
                if (un < 2048) { hg_load_col(F, un >> 7, un & 127, C_HF, fb); hg_load_col(F, un >> 7, un & 127, C_HI, vb); }
                hgu_unit(p, F, u >> 7, u & 127, fa, va);
#pragma unroll
                for (int i = 0; i < 16; ++i) { fa[i] = fb[i]; va[i] = vb[i]; }
                u = un; } }
        knorm_pass(F);
        SEAM(3);
    }
    if (IN(4)) {
        hg_scan(F);
        for (int a = F.bid; a < 512; a += F.G) { const int bh = a >> 5, xq = a & 31; attn_unit(F, bh, xq); attn_unit(F, bh, 63 - xq); }
        SEAM(4);
    }
    if (IN(5)) {
        {   unsigned short fa[16], qa[16], va[16], fb[16], qb[16], vb[16]; u32x4 sa[4], sb[4];
            const bf16_t* SPg = WSP(bf16_t, WS_HGSP);
#define HGO_LOAD(u_, f_, q_, v_, s_) do { hg_load_col(F, (u_) >> 7, (u_) & 127, C_HF, f_); hg_load_col(F, (u_) >> 7, (u_) & 127, C_HQ, q_); hg_load_col(F, (u_) >> 7, (u_) & 127, C_HI, v_); \
                _Pragma("unroll") for (int r = 0; r < 4; ++r) { const int q = F.tid + 512 * r; s_[r] = *(const u32x4*)(SPg + (size_t)(u_) * 16384 + (size_t)(q >> 4) * 128 + (q & 15) * 8); } } while (0)
            int u = F.bid;
            if (u < 2048) HGO_LOAD(u, fa, qa, va, sa);
            while (u < 2048) { const int un = u + F.G;
                if (un < 2048) HGO_LOAD(un, fb, qb, vb, sb);
                hgo_unit(p, F, u >> 7, u & 127, fa, qa, va, sa);
#pragma unroll
                for (int i = 0; i < 16; ++i) { fa[i] = fb[i]; qa[i] = qb[i]; va[i] = vb[i]; }
#pragma unroll
                for (int r = 0; r < 4; ++r) sa[r] = sb[r];
                u = un; }
#undef HGO_LOAD
        }
        SEAM(5);
    }
    if (IN(6)) {
        pg8::StaticOrder S; S.init(T_, 2048, F.G, F.bid, WGM_OUT);
#if FP8_OUT
        pg8::SrcPlain X{WSP(bf16_t, WS_MIX8), WSP(bf16_t, WS_WOUT), 1024};
        pg8::EpiResid E{p.x, WSP(bf16_t, WS_X1), WSP(float, WS_MOD) + 4096, 1.0f / 256.0f};
        pg8::gemm_phase<1>(F.lds, 1024, S, X, E);
#else
        pg8::SrcPlain X{WSP(bf16_t, WS_MIXED), WSP(bf16_t, WS_WOUT), 2048};
        pg8::EpiResid E{p.x, WSP(bf16_t, WS_X1), WSP(float, WS_MOD) + 4096, 1.0f};
        pg8::gemm_phase<0>(F.lds, 2048, S, X, E);
#endif
        SEAM(6);
    }
    if (IN(7)) { phase7(p, F); SEAM(7); }
    if (IN(8)) { phase8(F); SEAM(8); }
    if (IN(9)) {
        const int ntl = WSP(int, WS_TILEE)[MAXTILES];
        pg8::StaticOrder S; S.init(ntl * 256, 4096, F.G, F.bid, WGM_GU);
        pg8::SrcMoE X{WSP(bf16_t, WS_H2), WSP(bf16_t, WS_WGU), WSP(int, WS_SRC), WSP(int, WS_TILEE), 1024, (size_t)4096 * 1024};
        pg8::EpiGlu E{F.ws + WS_ACT, p.b_gu};
        pg8::gemm_phase<1>(F.lds, 1024, S, X, E);
        SEAM(9);
    }
    if (IN(10)) {
        const int ntl = WSP(int, WS_TILEE)[MAXTILES];
        pg8::StaticOrder S; S.init(ntl * 256, 2048, F.G, F.bid, WGM_DN);
        pg8::SrcMoE X{WSP(bf16_t, WS_ACT), WSP(bf16_t, WS_WDN), nullptr, WSP(int, WS_TILEE), 1024, (size_t)2048 * 1024};
        pg8::EpiDown E{F.ws + WS_YBUF, p.b_down};
        pg8::gemm_phase<1>(F.lds, 1024, S, X, E);
        SEAM(10);
    }
    if (IN(11)) { phase11(p, F); }
#undef IN
#undef SEAM
}

#ifndef N_LAUNCH_MODE
#define N_LAUNCH_MODE 1
#endif
extern "C" void kernel_launch(void* const* d_in, const int* in_sizes, int n_in, void* d_out, int out_size, void* d_ws, size_t ws_size, hipStream_t stream) {
    static int grid = 0;
    if (grid == 0) {
        if (n_in != 19 || out_size != T_ * D_ || ws_size < WS_END) { fprintf(stderr, "kernel_launch: unexpected shapes (n_in %d out %d ws %zu need %zu)\n", n_in, out_size, ws_size, (size_t)WS_END); grid = -1; return; }
        int dev = 0, cus = 0, per_cu = 0;
        if (hipGetDevice(&dev) != hipSuccess || hipDeviceGetAttribute(&cus, hipDeviceAttributeMultiprocessorCount, dev) != hipSuccess) { grid = -1; return; }
        if (hipFuncSetAttribute((const void*)fwd, hipFuncAttributeMaxDynamicSharedMemorySize, LDS_BYTES) != hipSuccess) { fprintf(stderr, "kernel_launch: hipFuncSetAttribute failed\n"); grid = -1; return; }
        if (hipOccupancyMaxActiveBlocksPerMultiprocessor(&per_cu, (const void*)fwd, 512, LDS_BYTES) != hipSuccess || per_cu < 1) fprintf(stderr, "kernel_launch: occupancy query reports %d\n", per_cu);
        (void)hipGetLastError();
        grid = cus;
    }
    if (grid < 0) return;
    (void)in_sizes;
    hipMemsetAsync((char*)d_ws + WS_CTL, 0, 65536, stream);
    Params p{};
    p.x = (const float*)d_in[0]; p.c = (const float*)d_in[1]; p.w_ada = (const float*)d_in[2]; p.b_ada = (const float*)d_in[3];
    p.g1 = (const float*)d_in[4]; p.g2 = (const float*)d_in[5]; p.w_in = (const float*)d_in[6]; p.b_fgate = (const float*)d_in[7];
    p.g_fox = (const float*)d_in[8]; p.lb_logits = (const float*)d_in[9]; p.g_hg = (const float*)d_in[10]; p.w_out = (const float*)d_in[11];
    p.w_router = (const float*)d_in[12]; p.b_router = (const float*)d_in[13]; p.w_gu = (const float*)d_in[14]; p.b_gu = (const float*)d_in[15];
    p.w_down = (const float*)d_in[16]; p.b_down = (const float*)d_in[17]; p.g_final = (const float*)d_in[18];
    p.out = (float*)d_out; p.ws = (unsigned char*)d_ws;
#if N_LAUNCH_MODE == 1
    p.lo = 0; p.hi = NPHASE;
    hipLaunchKernelGGL(fwd, dim3(grid), dim3(512), LDS_BYTES, stream, p);
#else
    for (int k = 0; k < NPHASE; ++k) { p.lo = k; p.hi = k + 1; hipLaunchKernelGGL(fwd, dim3(grid), dim3(512), LDS_BYTES, stream, p); }
#endif
}
```

```cpp
#include <hip/hip_runtime.h>
#include <cstdio>
#include <cstdint>

#define LAS __attribute__((address_space(3)))
typedef unsigned short bf16_t;
typedef short bf16x8 __attribute__((ext_vector_type(8)));
typedef short s16x4 __attribute__((ext_vector_type(4)));
typedef float f32x4 __attribute__((ext_vector_type(4)));
typedef float f32x2 __attribute__((ext_vector_type(2)));
typedef unsigned u32x4 __attribute__((ext_vector_type(4)));
typedef unsigned u32x2 __attribute__((ext_vector_type(2)));
typedef int i32x4 __attribute__((ext_vector_type(4)));
typedef int i32x8 __attribute__((ext_vector_type(8)));

constexpr int T_ = 16384, D_ = 2048, S_ = 8192;
constexpr int NPROJ = 7168;
constexpr int C_FQ = 0, C_FK = 1024, C_FV = 2048, C_HQ = 3072, C_HF = 4096, C_HI = 5120, C_HG = 6144;
constexpr int NE = 32;
constexpr int MAXTILES = 288, MAXROWS = MAXTILES * 256;
constexpr int LDS_BYTES = 155648;
constexpr int NPHASE = 12;
#ifndef WGM_IN
#define WGM_IN 2
#endif
#ifndef WGM_OUT
#define WGM_OUT 2
#endif
#ifndef WGM_GU
#define WGM_GU 2
#endif
#ifndef WGM_DN
#define WGM_DN 2
#endif
#ifndef CONV_NCG
#define IN_MODE 2
#define OUT_MODE 2
#define CONV_NCG 4
#endif
#ifndef CONV_NA
#define CONV_NA 1
#endif
constexpr float EPS = 1e-6f;
constexpr float LOG2E = 1.4426950408889634f;

constexpr size_t al256(size_t x) { return (x + 255) & ~(size_t)255; }
constexpr size_t WS_CTL   = 0;
constexpr size_t WS_MODP  = 65536;
constexpr size_t WS_MOD   = WS_MODP + al256(8 * 2 * 12288 * 4);
constexpr size_t WS_WIN   = WS_MOD + al256(2 * 12288 * 4);
constexpr size_t WS_WOUT  = WS_WIN + (size_t)NPROJ * 2048 * 2;
constexpr size_t WS_WGU   = WS_WOUT + (size_t)2048 * 2048 * 2;
constexpr size_t WS_WDN   = WS_WGU + (size_t)32 * 4096 * 2048 * 2;
constexpr size_t WS_H1    = WS_WDN + (size_t)32 * 2048 * 2048 * 2;
constexpr size_t WS_PROJ  = WS_H1 + (size_t)T_ * 2048 * 2;
constexpr size_t WS_LOGF  = WS_PROJ + (size_t)T_ * NPROJ * 2;
constexpr size_t WS_CUM   = WS_LOGF + (size_t)T_ * 8 * 4;
constexpr size_t WS_HGU   = WS_CUM + (size_t)T_ * 8 * 4;
constexpr size_t WS_HGSP  = WS_HGU + (size_t)16 * 128 * 128 * 128 * 4;
constexpr size_t WS_HGDEC = WS_HGSP + (size_t)16 * 128 * 128 * 128 * 2;
constexpr size_t WS_MIXED = WS_HGDEC + (size_t)16 * 128 * 128 * 4;
constexpr size_t WS_SSQ   = WS_MIXED + (size_t)T_ * 2048 * 2;
constexpr size_t WS_X1    = WS_SSQ + (size_t)T_ * 8 * 4;
constexpr size_t WS_H2    = WS_X1 + (size_t)T_ * 2048 * 4;
constexpr size_t WS_TOPI  = WS_H2 + (size_t)T_ * 2048 * 2;
constexpr size_t WS_TOPG  = WS_TOPI + (size_t)T_ * 16;
constexpr size_t WS_POS   = WS_TOPG + (size_t)T_ * 16;
constexpr size_t WS_CNT   = WS_POS + (size_t)T_ * 16;
constexpr size_t WS_SRC   = WS_CNT + 256 * 32 * 4;
constexpr size_t WS_TILEE = WS_SRC + (size_t)MAXROWS * 4;
constexpr size_t WS_ACT   = WS_TILEE + 4096;
constexpr size_t WS_YBUF  = WS_ACT + (size_t)MAXROWS * 2048 * 2;
constexpr size_t WS_KN    = WS_YBUF + (size_t)MAXROWS * 2048 * 2;
constexpr size_t WS_MIX8  = WS_KN + 16 * 128 * 4;
constexpr size_t WS_RS    = WS_MIX8 + (size_t)T_ * 2048;
constexpr size_t WS_MIXN  = WS_RS + (size_t)T_ * 4;
constexpr size_t WS_RS2   = WS_MIXN + (size_t)T_ * 2048 * 2;
constexpr size_t WS_END   = WS_RS2 + (size_t)T_ * 4;
constexpr size_t WS_CMAX  = 16384;

struct Params {
    const float* x; const float* c; const float* w_ada; const float* b_ada; const float* g1; const float* g2;
    const float* w_in; const float* b_fgate; const float* g_fox; const float* lb_logits; const float* g_hg;
    const float* w_out; const float* w_router; const float* b_router; const float* w_gu; const float* b_gu;
    const float* w_down; const float* b_down; const float* g_final;
    float* out; unsigned char* ws; int lo, hi;
};

__device__ __forceinline__ unsigned cvt_pk_bf16(float lo, float hi) { unsigned r; asm volatile("v_cvt_pk_bf16_f32 %0, %1, %2" : "=v"(r) : "v"(lo), "v"(hi)); return r; }
__device__ __forceinline__ unsigned pack4_fp8(float a, float b, float c, float d) { int w = 0; w = __builtin_amdgcn_cvt_pk_fp8_f32(a, b, w, false); w = __builtin_amdgcn_cvt_pk_fp8_f32(c, d, w, true); return (unsigned)w; }
__device__ __forceinline__ unsigned pack4_i8(float a, float b, float c, float d) {
    const int ia = __float2int_rn(a), ib = __float2int_rn(b), ic = __float2int_rn(c), id = __float2int_rn(d);
    return (unsigned)(ia & 255) | ((unsigned)(ib & 255) << 8) | ((unsigned)(ic & 255) << 16) | ((unsigned)id << 24);
}
__device__ __forceinline__ i32x8 cat8(bf16x8 a, bf16x8 b) { const i32x4 x = __builtin_bit_cast(i32x4, a), y = __builtin_bit_cast(i32x4, b); return __builtin_shufflevector(x, y, 0, 1, 2, 3, 4, 5, 6, 7); }
__device__ __forceinline__ float bf2f(bf16_t b) { return __uint_as_float(((unsigned)b) << 16); }
__device__ __forceinline__ float bflo(unsigned w) { return __uint_as_float(w << 16); }
__device__ __forceinline__ float bfhi(unsigned w) { return __uint_as_float(w & 0xffff0000u); }
__device__ __forceinline__ float wave_sum(float v) {
#pragma unroll
    for (int o = 32; o >= 1; o >>= 1) v += __shfl_xor(v, o);
    return v;
}

#define XB_TMO      128
#define XB_XCNT(j)  (256  + 64 * (j))
#define XB_XSUB(j)  (1280 + 64 * (j))
#define XB_XGEN(j)  (2304 + 64 * (j))
#define XB_TOP      3328
#define XB_TOPGEN   3392
#define XCD_BAR_WORDS 3456
#define XB_SPIN_CAP (1u << 18)

__device__ __forceinline__ unsigned xb_ld(unsigned* p)              { return __hip_atomic_load(p, __ATOMIC_RELAXED, __HIP_MEMORY_SCOPE_AGENT); }
__device__ __forceinline__ unsigned xb_add(unsigned* p, unsigned v) { return __hip_atomic_fetch_add(p, v, __ATOMIC_RELAXED, __HIP_MEMORY_SCOPE_AGENT); }
__device__ __forceinline__ unsigned xb_xcc_id() { return (unsigned)__builtin_amdgcn_s_getreg((3 << 11) | 20) & 0xFu; }
#define XB_SPIN(cond, bar) do { unsigned _sp = 0; while (cond) { __builtin_amdgcn_s_sleep(1); \
    if ((++_sp & 255u) == 0u) { if (xb_ld(&(bar)[XB_TMO])) break; if (_sp > XB_SPIN_CAP) { atomicAdd(&(bar)[XB_TMO], 1u); break; } } } } while (0)

struct XcdBarrier { unsigned* bar; unsigned x; volatile LAS unsigned* st; };

__device__ __forceinline__ XcdBarrier xcd_barrier_post(unsigned* bar, volatile LAS unsigned* st) {
    XcdBarrier b; b.bar = bar; b.x = xb_xcc_id(); b.st = st;
    if (threadIdx.x == 0) (void)xb_add(&bar[XB_XCNT(b.x)], 1u);
    return b;
}
__device__ __forceinline__ void xcd_barrier_complete(unsigned* bar, unsigned x, unsigned& nloc, unsigned& nx) {
    const unsigned G = gridDim.x * gridDim.y * gridDim.z;
    unsigned sum, cnt, mine, sp = 0u;
    for (;;) {
        sum = 0u; cnt = 0u; mine = 0u;
#pragma unroll
        for (unsigned j = 0; j < 16; ++j) { const unsigned c = xb_ld(&bar[XB_XCNT(j)]); sum += c; cnt += (c > 0u) ? 1u : 0u; mine = (j == x) ? c : mine; }
        if (sum == G) break;
        __builtin_amdgcn_s_sleep(1);
        if ((++sp & 255u) == 0u) { if (xb_ld(&bar[XB_TMO])) break; if (sp > XB_SPIN_CAP) { atomicAdd(&bar[XB_TMO], 1u); break; } }
    }
    nloc = mine > 0u ? mine : 1u; nx = cnt > 0u ? cnt : 1u;
}
__device__ __forceinline__ void xcd_barrier(const XcdBarrier& b) {
    asm volatile("s_waitcnt vmcnt(0)" ::: "memory");
    __syncthreads();
    if (threadIdx.x == 0) {
        unsigned* bar = b.bar;
        __builtin_amdgcn_s_waitcnt(0);
        unsigned nloc = b.st[0], nx = b.st[1];
        if (nloc == 0u) { xcd_barrier_complete(bar, b.x, nloc, nx); b.st[0] = nloc; b.st[1] = nx; }
        const unsigned old = xb_add(&bar[XB_XSUB(b.x)], 1u);
        const unsigned gen = old / nloc;
        if (old + 1u == (gen + 1u) * nloc) {
            __builtin_amdgcn_fence(__ATOMIC_RELEASE, "agent");
            asm volatile("s_waitcnt vmcnt(0)" ::: "memory");
            const unsigned og = xb_add(&bar[XB_TOP], 1u);
            const unsigned tg = og / nx;
            if (og + 1u == (tg + 1u) * nx) xb_add(&bar[XB_TOPGEN], 1u);
            else XB_SPIN(xb_ld(&bar[XB_TOPGEN]) == tg, bar);
            __builtin_amdgcn_fence(__ATOMIC_ACQUIRE, "agent");
            xb_add(&bar[XB_XGEN(b.x)], 1u);
            asm volatile("s_waitcnt vmcnt(0)" ::: "memory");
        } else {
            XB_SPIN(xb_ld(&bar[XB_XGEN(b.x)]) == gen, bar);
            __builtin_amdgcn_fence(__ATOMIC_ACQUIRE, "agent");
            asm volatile("s_waitcnt vmcnt(0)" ::: "memory");
        }
    }
    __syncthreads();
}

namespace pg8 {
constexpr int BM = 256, BK = 64, HALF = 128, HTB = HALF * BK * 2, STAGE_BYTES = 8 * HTB, NXCD = 8;
__device__ __forceinline__ int lds_byte(int r, int c) { const int st = (r >> 4) * 2 + (c >> 5), rr = r & 15, cc = c & 31, ob = rr * 64 + cc * 2; return st * 1024 + (ob ^ (((ob >> 9) & 1) << 5)); }
__device__ __forceinline__ void stage_rc(int b, int& R, int& C) { const int st = b / 1024, sb = b % 1024, swz = sb ^ (((sb >> 9) & 1) << 5); R = (st >> 1) * 16 + swz / 64; C = (st & 1) * 32 + (swz % 64) / 2; }
__device__ __forceinline__ int perm32(int rho) { const int n = rho >> 4, i = rho & 15; return 8 * (i >> 2) + 4 * n + (i & 3); }
struct Unit { int pm, pn; };
struct StaticOrder {
    int nM, nN, nwg, G, c, WGM;
    __device__ void init(int M, int N, int G_, int c_, int wgm) { nM = M / BM; nN = N / BM; nwg = nM * nN; G = G_; c = c_; WGM = wgm; }
    __device__ bool next(int i, Unit& u) const {
        const long L = (long)i * G + c; if (L >= nwg) return false;
        int wgid = (int)L; { const int q = nwg / NXCD, r = nwg % NXCD, xcd = wgid % NXCD, off = wgid / NXCD; wgid = (xcd < r ? xcd * (q + 1) : r * (q + 1) + (xcd - r) * q) + off; }
        const int nig = WGM * nN, gid = wgid / nig, fm = gid * WGM, gsz = (nM - fm) < WGM ? (nM - fm) : WGM;
        u.pm = fm + ((wgid % nig) % gsz); u.pn = (wgid % nig) / gsz; return true;
    }
};

struct SplitOrder {
    int nM, nN, nwg, G, c, na, nb, n_nc, rank_nc, WGM; bool conv;
    __device__ void init(int M, int N, int G_, int c_, int ncg, int na_, int wgm) {
        nM = M / BM; nN = N / BM; nwg = nM * nN; G = G_; c = c_; WGM = wgm;
        if ((G & 63) != 0) ncg = 0;
        const int g = c >> 3, oct = g >> 3, gi = g & 7;
        conv = gi < ncg;
        n_nc = G - (G >> 3) * ncg;
        rank_nc = 8 * (oct * (8 - ncg) + (gi > ncg ? gi - ncg : 0)) + (c & 7);
        na = ncg ? na_ : 0x3fffffff;
        const int rem = nwg - na * G;
        nb = ncg ? na + (rem > 0 ? (rem + n_nc - 1) / n_nc : 0) : 0x3fffffff;
    }
    __device__ int conv_rank(int ncg) const { const int g = c >> 3; return 8 * ((g >> 3) * ncg + ((g & 7) < ncg ? (g & 7) : ncg)) + (c & 7); }
    __device__ bool next(int i, Unit& u) const {
        long L;
        if (i < na) L = (long)i * G + c;
        else { if (conv || i >= nb) return false; L = (long)na * G + (long)(i - na) * n_nc + rank_nc; }
        if (L >= nwg) return false;
        int wgid = (int)L; { const int q = nwg / NXCD, r = nwg % NXCD, xcd = wgid % NXCD, off = wgid / NXCD; wgid = (xcd < r ? xcd * (q + 1) : r * (q + 1) + (xcd - r) * q) + off; }
        const int nig = WGM * nN, gid = wgid / nig, fm = gid * WGM, gsz = (nM - fm) < WGM ? (nM - fm) : WGM;
        u.pm = fm + ((wgid % nig) % gsz); u.pn = (wgid % nig) / gsz; return true;
    }
};
struct SrcPlain {
    static constexpr bool SIDE = false;
    const bf16_t* A; const bf16_t* Bt; int K;
    __device__ __forceinline__ void load_map(LAS int*, int) const {}
    __device__ __forceinline__ const char* a_base(const Unit& u) const { return (const char*)A + (size_t)u.pm * BM * K * 2; }
    __device__ __forceinline__ const char* b_base(const Unit& u, const LAS int*) const { return (const char*)Bt + (size_t)u.pn * BM * K * 2; }
    __device__ __forceinline__ void a_voff(const Unit&, const int (&R)[2], const int (&C)[2], unsigned (&v)[2][2]) const {
#pragma unroll
        for (int h = 0; h < 2; ++h)
#pragma unroll
            for (int i = 0; i < 2; ++i) v[h][i] = (unsigned)((h * HALF + R[i]) * K + C[i]) * 2u;
    }
    __device__ __forceinline__ void side_issue(const Unit&, LAS int*, int, int) const {}
    __device__ __forceinline__ void a_voff_side(const Unit& u, const LAS int*, const int (&R)[2], const int (&C)[2], unsigned (&v)[2][2]) const { a_voff(u, R, C, v); }
};
struct SrcMoE {
    static constexpr bool SIDE = true;
    const bf16_t* A; const bf16_t* Bt; const int* src; const int* tile_e; int K; size_t estride;
    __device__ __forceinline__ void load_map(LAS int* lte, int nM) const { for (int i = threadIdx.x; i < nM; i += 512) lte[i] = tile_e[i]; }
    __device__ __forceinline__ const char* a_base(const Unit& u) const { return src ? (const char*)A : (const char*)A + (size_t)u.pm * BM * K * 2; }
    __device__ __forceinline__ const char* b_base(const Unit& u, const LAS int* lte) const { const int e = lte[u.pm]; return (const char*)Bt + ((size_t)e * estride + (size_t)u.pn * BM * K) * 2; }
    __device__ __forceinline__ void a_voff(const Unit& u, const int (&R)[2], const int (&C)[2], unsigned (&v)[2][2]) const {
#pragma unroll
        for (int h = 0; h < 2; ++h)
#pragma unroll
            for (int i = 0; i < 2; ++i) {
                const int r = src ? src[u.pm * BM + h * HALF + R[i]] : (h * HALF + R[i]);
                v[h][i] = (unsigned)(r * K + C[i]) * 2u; }
    }
    __device__ __forceinline__ void side_issue(const Unit& u, LAS int* tbl, int wid, int lane) const {
        if (src && wid < 4) __builtin_amdgcn_global_load_lds((const unsigned*)(src + u.pm * BM + wid * 64 + lane), (LAS unsigned*)(tbl + wid * 64), 4, 0, 0);
    }
    __device__ __forceinline__ void a_voff_side(const Unit& u, const LAS int* tbl, const int (&R)[2], const int (&C)[2], unsigned (&v)[2][2]) const {
#pragma unroll
        for (int h = 0; h < 2; ++h)
#pragma unroll
            for (int i = 0; i < 2; ++i) {
                const int r = src ? tbl[h * HALF + R[i]] : (h * HALF + R[i]);
                v[h][i] = (unsigned)(r * K + C[i]) * 2u; }
    }
};

template <int MODE, class Epi, class Sched, class Src>
__device__ __forceinline__ void gemm_phase(LAS unsigned char* lds, const int K, const Sched& S, const Src& X, const Epi& E) {
    const int tid = threadIdx.x, wid = __builtin_amdgcn_readfirstlane(tid >> 6), lane = tid & 63, wr = wid >> 2, wc = wid & 3, fr = lane & 15, fq = lane >> 4;
    const int nt = K / BK;
    int Rr[2], Cc[2]; unsigned voffB[2];
#pragma unroll
    for (int i = 0; i < 2; ++i) { int R, C; stage_rc(tid * 16 + i * 8192, R, C); Rr[i] = R; Cc[i] = C; const int Rb = Epi::PERM ? ((R & ~31) + perm32(R & 31)) : R; voffB[i] = (unsigned)(Rb * K + C) * 2u; }
    const size_t kstep = (size_t)(BK * 2);
    const size_t hstep = (size_t)HALF * K * 2;
    const unsigned ldsw = (unsigned)wid * 1024u;
    const int aoff = lds_byte(wr * 64 + fr, fq * 8), boff = lds_byte(wc * 32 + fr, fq * 8);
#define PG8_SA(b, h) (((b) * 2 + (h)) * HTB)
#define PG8_SB(b, h) ((4 + (b) * 2 + (h)) * HTB)
#define PG8_STAGE(bufoff, gbase, voff) do { _Pragma("unroll") for (int _i = 0; _i < 2; ++_i) \
        __builtin_amdgcn_global_load_lds((const unsigned*)((const char*)(gbase) + (voff)[_i]), (LAS unsigned*)(lds + (bufoff) + ldsw + _i * 8192), 16, 0, 0); } while (0)
#define PG8_LDA(dst, b, h) do { _Pragma("unroll") for (int m = 0; m < 4; ++m) _Pragma("unroll") for (int k = 0; k < 2; ++k) dst[m][k] = *(const LAS bf16x8*)(lds + PG8_SA(b, h) + aoff + m * 2048 + k * 1024); } while (0)
#define PG8_LDB(dst, b, h) do { _Pragma("unroll") for (int n = 0; n < 2; ++n) _Pragma("unroll") for (int k = 0; k < 2; ++k) dst[n][k] = *(const LAS bf16x8*)(lds + PG8_SB(b, h) + boff + n * 2048 + k * 1024); } while (0)
#define PG8_MMA(ai, bj, At, Bt) do { __builtin_amdgcn_s_setprio(1); if constexpr (MODE == 2) { \
        _Pragma("unroll") for (int m = 0; m < 4; ++m) _Pragma("unroll") for (int n = 0; n < 2; ++n) _Pragma("unroll") for (int k = 0; k < 2; ++k) \
        acc[ai][bj][m][n] = __builtin_bit_cast(f32x4, __builtin_amdgcn_mfma_i32_16x16x64_i8(__builtin_bit_cast(i32x4, Bt[n][k]), __builtin_bit_cast(i32x4, At[m][k]), __builtin_bit_cast(i32x4, acc[ai][bj][m][n]), 0, 0, 0)); \
        } else if constexpr (MODE == 1) { _Pragma("unroll") for (int m = 0; m < 4; ++m) _Pragma("unroll") for (int n = 0; n < 2; ++n) \
        asm volatile("v_mfma_f32_16x16x128_f8f6f4 %0, %1, %2, %0" : "+v"(acc[ai][bj][m][n]) : "v"(cat8(Bt[n][0], Bt[n][1])), "v"(cat8(At[m][0], At[m][1]))); } else { \
        _Pragma("unroll") for (int m = 0; m < 4; ++m) _Pragma("unroll") for (int n = 0; n < 2; ++n) _Pragma("unroll") for (int k = 0; k < 2; ++k) \
        acc[ai][bj][m][n] = __builtin_amdgcn_mfma_f32_16x16x32_bf16(Bt[n][k], At[m][k], acc[ai][bj][m][n], 0, 0, 0); } __builtin_amdgcn_s_setprio(0); } while (0)
#define PG8_WAIT_V(n) asm volatile("s_waitcnt vmcnt(" #n ")" ::: "memory")
#define PG8_WAIT_L(n) asm volatile("s_waitcnt lgkmcnt(" #n ")" ::: "memory")
#define PG8_BAR __builtin_amdgcn_s_barrier()
#define PG8_SCHED __builtin_amdgcn_sched_barrier(0)
    Unit cur, nxt; int ui = 0;
    if (!S.next(0, cur)) return;
    f32x4 acc[2][2][4][2];
#pragma unroll
    for (int a = 0; a < 2; ++a)
#pragma unroll
        for (int b = 0; b < 2; ++b)
#pragma unroll
            for (int m = 0; m < 4; ++m)
#pragma unroll
                for (int n = 0; n < 2; ++n) acc[a][b][m][n] = (f32x4){0.f, 0.f, 0.f, 0.f};
    bf16x8 At[4][2], B0[2][2], B1[2][2];
    unsigned vA[2][2], nvA[2][2];
    LAS unsigned char* side = lds + STAGE_BYTES;
    LAS int* lte = (LAS int*)(side + 5120);
#define PG8_TSRC(sl) ((LAS int*)(side + (sl) * 1024))
#define PG8_TBIAS(sl) ((LAS float*)(side + 2048 + (sl) * 1024))
    if constexpr (Src::SIDE) { X.load_map(lte, S.nM); __syncthreads(); }
    X.a_voff(cur, Rr, Cc, vA);
    E.side_issue(cur, PG8_TBIAS(0), lte, wid, lane);
    const char* cA = X.a_base(cur); const char* cB = X.b_base(cur, lte);
    PG8_STAGE(PG8_SB(0, 0), cB, voffB); PG8_STAGE(PG8_SB(0, 1), cB + hstep, voffB); PG8_STAGE(PG8_SA(0, 0), cA, vA[0]); PG8_STAGE(PG8_SA(0, 1), cA, vA[1]);
    if (wr == 1) PG8_BAR;
    PG8_WAIT_V(2); PG8_BAR;
    PG8_STAGE(PG8_SB(1, 0), cB + kstep, voffB); PG8_STAGE(PG8_SA(1, 0), cA + kstep, vA[0]); PG8_STAGE(PG8_SB(1, 1), cB + hstep + kstep, voffB);
    PG8_WAIT_V(6); PG8_BAR;
    for (;;) {
        const bool has_next = S.next(ui + 1, nxt);
        const char* nA = cA; const char* nB = cB;
#pragma unroll
        for (int h = 0; h < 2; ++h)
#pragma unroll
            for (int i = 0; i < 2; ++i) nvA[h][i] = vA[h][i];
        const int tsl = (ui + 1) & 1, bsl = (ui + 1) % 3;
        if (has_next) { nA = X.a_base(nxt); nB = X.b_base(nxt, lte); X.side_issue(nxt, PG8_TSRC(tsl), wid, lane); E.side_issue(nxt, PG8_TBIAS(bsl), lte, wid, lane); }
        for (int t = 0; t < nt; t += 2) {
            const bool last = (t == nt - 2);
            const char* a1 = cA + (size_t)(t + 1) * kstep;
            const char* a2 = last ? nA : cA + (size_t)(t + 2) * kstep; const char* b2 = last ? nB : cB + (size_t)(t + 2) * kstep;
            const char* a3 = a2 + kstep; const char* b3 = b2 + kstep;
            unsigned w0[2], w1[2];
            if (last && has_next) X.a_voff_side(nxt, PG8_TSRC(tsl), Rr, Cc, nvA);
            w0[0] = last ? nvA[0][0] : vA[0][0]; w0[1] = last ? nvA[0][1] : vA[0][1];
            w1[0] = last ? nvA[1][0] : vA[1][0]; w1[1] = last ? nvA[1][1] : vA[1][1];
            PG8_LDB(B0, 0, 0); PG8_LDB(B1, 0, 1); PG8_SCHED; PG8_LDA(At, 0, 0); PG8_STAGE(PG8_SA(1, 1), a1, vA[1]);
            PG8_WAIT_V(8); PG8_WAIT_L(0); PG8_BAR; PG8_MMA(0, 0, At, B0); PG8_MMA(0, 1, At, B1); PG8_BAR; PG8_SCHED;
            PG8_LDA(At, 0, 1); PG8_STAGE(PG8_SB(0, 0), b2, voffB); PG8_STAGE(PG8_SB(0, 1), b2 + hstep, voffB); PG8_STAGE(PG8_SA(0, 0), a2, w0);
            PG8_WAIT_V(8); PG8_WAIT_L(0); PG8_BAR; PG8_MMA(1, 0, At, B0); PG8_MMA(1, 1, At, B1); PG8_BAR; PG8_SCHED;
            PG8_LDB(B0, 1, 0); PG8_LDB(B1, 1, 1); PG8_SCHED; PG8_LDA(At, 1, 0); PG8_STAGE(PG8_SA(0, 1), a2, w1);
            PG8_WAIT_V(8); PG8_WAIT_L(0); PG8_BAR; PG8_MMA(0, 0, At, B0); PG8_MMA(0, 1, At, B1); PG8_BAR; PG8_SCHED;
            PG8_LDA(At, 1, 1); PG8_STAGE(PG8_SB(1, 0), b3, voffB); PG8_STAGE(PG8_SB(1, 1), b3 + hstep, voffB); PG8_STAGE(PG8_SA(1, 0), a3, w0);
            PG8_WAIT_V(8); PG8_WAIT_L(0); PG8_BAR; PG8_MMA(1, 0, At, B0); PG8_MMA(1, 1, At, B1); PG8_BAR; PG8_SCHED;
        }
        if (wr == 0) PG8_BAR;
        if constexpr (MODE == 1) asm volatile("s_nop 15\n\ts_nop 15\n\ts_nop 15" ::: "memory");
        E(acc, cur, wr, wc, fr, fq, PG8_TBIAS(ui % 3), lte);
        if (!has_next) break;
#pragma unroll
        for (int a = 0; a < 2; ++a)
#pragma unroll
            for (int b = 0; b < 2; ++b)
#pragma unroll
                for (int m = 0; m < 4; ++m)
#pragma unroll
                    for (int n = 0; n < 2; ++n) acc[a][b][m][n] = (f32x4){0.f, 0.f, 0.f, 0.f};
        cur = nxt; cA = nA; cB = nB; ++ui;
#pragma unroll
        for (int h = 0; h < 2; ++h)
#pragma unroll
            for (int i = 0; i < 2; ++i) vA[h][i] = nvA[h][i];
        if (wr == 1) PG8_BAR;
    }
    PG8_WAIT_V(0);
    PG8_BAR;
#undef PG8_TSRC
#undef PG8_TBIAS
#undef PG8_SA
#undef PG8_SB
#undef PG8_STAGE
#undef PG8_LDA
#undef PG8_LDB
#undef PG8_MMA
#undef PG8_WAIT_V
#undef PG8_WAIT_L
#undef PG8_BAR
#undef PG8_SCHED
}

struct EpiProj {
    static constexpr bool PERM = true;
    bf16_t* O; int ldc; float sc;
    __device__ __forceinline__ void side_issue(const Unit&, LAS float*, const LAS int*, int, int) const {}
    __device__ __forceinline__ void operator()(const f32x4 (&acc)[2][2][4][2], const Unit& u, int wr, int wc, int fr, int fq, const LAS float*, const LAS int*) const {
        const int row0 = u.pm * BM + wr * 64 + fr, col0 = u.pn * BM + wc * 32 + 8 * fq;
#pragma unroll
        for (int ai = 0; ai < 2; ++ai)
#pragma unroll
            for (int m = 0; m < 4; ++m) { bf16_t* rowp = O + (size_t)(row0 + ai * HALF + m * 16) * ldc + col0;
#pragma unroll
                for (int bj = 0; bj < 2; ++bj) { const f32x4 v0 = acc[ai][bj][m][0] * sc, v1 = acc[ai][bj][m][1] * sc;
                    u32x4 w; w.x = cvt_pk_bf16(v0[0], v0[1]); w.y = cvt_pk_bf16(v0[2], v0[3]); w.z = cvt_pk_bf16(v1[0], v1[1]); w.w = cvt_pk_bf16(v1[2], v1[3]);
                    *(u32x4*)(rowp + bj * HALF) = w; } }
    }
};
struct EpiProjI8 {
    static constexpr bool PERM = true;
    bf16_t* O; int ldc; const float* rs; const float* cmax;
    __device__ __forceinline__ void side_issue(const Unit&, LAS float*, const LAS int*, int, int) const {}
    __device__ __forceinline__ void operator()(const f32x4 (&acc)[2][2][4][2], const Unit& u, int wr, int wc, int fr, int fq, const LAS float*, const LAS int*) const {
        const int row0 = u.pm * BM + wr * 64 + fr, col0 = u.pn * BM + wc * 32 + 8 * fq;
        f32x4 cs[2][2];
#pragma unroll
        for (int bj = 0; bj < 2; ++bj)
#pragma unroll
            for (int n = 0; n < 2; ++n) cs[bj][n] = *(const f32x4*)(cmax + col0 + bj * HALF + n * 4) * (1.0f / 127.0f);
#pragma unroll
        for (int ai = 0; ai < 2; ++ai)
#pragma unroll
            for (int m = 0; m < 4; ++m) { const int row = row0 + ai * HALF + m * 16; bf16_t* rowp = O + (size_t)row * ldc + col0; const float r = rs[row];
#pragma unroll
                for (int bj = 0; bj < 2; ++bj) { const i32x4 a0 = __builtin_bit_cast(i32x4, acc[ai][bj][m][0]), a1 = __builtin_bit_cast(i32x4, acc[ai][bj][m][1]);
                    const f32x4 c0 = cs[bj][0] * r, c1 = cs[bj][1] * r;
                    u32x4 w; w.x = cvt_pk_bf16((float)a0[0] * c0[0], (float)a0[1] * c0[1]); w.y = cvt_pk_bf16((float)a0[2] * c0[2], (float)a0[3] * c0[3]);
                    w.z = cvt_pk_bf16((float)a1[0] * c1[0], (float)a1[1] * c1[1]); w.w = cvt_pk_bf16((float)a1[2] * c1[2], (float)a1[3] * c1[3]);
                    *(u32x4*)(rowp + bj * HALF) = w; } }
    }
};
struct EpiResid {
    static constexpr bool PERM = false;
    const float* x; bf16_t* x1; const float* gate; float sc;
    __device__ __forceinline__ void side_issue(const Unit&, LAS float*, const LAS int*, int, int) const {}
    __device__ __forceinline__ void operator()(const f32x4 (&acc)[2][2][4][2], const Unit& u, int wr, int wc, int fr, int fq, const LAS float*, const LAS int*) const {
        const int row0 = u.pm * BM + wr * 64 + fr, col0 = u.pn * BM + wc * 32 + 4 * fq;
        const float* gp = gate + ((u.pm * BM) >> 13) * 12288 + col0;
        f32x4 gv[2][2];
#pragma unroll
        for (int bj = 0; bj < 2; ++bj)
#pragma unroll
            for (int n = 0; n < 2; ++n) gv[bj][n] = *(const f32x4*)(gp + bj * HALF + n * 16) * sc;
#pragma unroll
        for (int ai = 0; ai < 2; ++ai) {
            f32x4 xs[4][2][2];
#pragma unroll
            for (int m = 0; m < 4; ++m) { const size_t off = (size_t)(row0 + ai * HALF + m * 16) * 2048 + col0;
#pragma unroll
                for (int bj = 0; bj < 2; ++bj)
#pragma unroll
                    for (int n = 0; n < 2; ++n) xs[m][bj][n] = *(const f32x4*)(x + off + bj * HALF + n * 16); }
#pragma unroll
            for (int m = 0; m < 4; ++m) { const size_t off = (size_t)(row0 + ai * HALF + m * 16) * 2048 + col0;
#pragma unroll
                for (int bj = 0; bj < 2; ++bj)
#pragma unroll
                    for (int n = 0; n < 2; ++n) { const f32x4 r = xs[m][bj][n] + gv[bj][n] * acc[ai][bj][m][n];
                        u32x2 w; w.x = cvt_pk_bf16(r[0], r[1]); w.y = cvt_pk_bf16(r[2], r[3]); *(u32x2*)(x1 + off + bj * HALF + n * 16) = w; } }
            asm volatile("" ::: "memory"); }
    }
};
struct EpiResidI8 {
    static constexpr bool PERM = false;
    const float* x; bf16_t* x1; const float* gate; const float* rs; const float* cmax;
    __device__ __forceinline__ void side_issue(const Unit&, LAS float*, const LAS int*, int, int) const {}
    __device__ __forceinline__ void operator()(const f32x4 (&acc)[2][2][4][2], const Unit& u, int wr, int wc, int fr, int fq, const LAS float*, const LAS int*) const {
        const int row0 = u.pm * BM + wr * 64 + fr, col0 = u.pn * BM + wc * 32 + 4 * fq;
        const float* gp = gate + ((u.pm * BM) >> 13) * 12288 + col0;
        f32x4 gv[2][2];
#pragma unroll
        for (int bj = 0; bj < 2; ++bj)
#pragma unroll
            for (int n = 0; n < 2; ++n) gv[bj][n] = *(const f32x4*)(gp + bj * HALF + n * 16) * *(const f32x4*)(cmax + col0 + bj * HALF + n * 16) * (1.0f / 127.0f);
#pragma unroll
        for (int ai = 0; ai < 2; ++ai) {
            f32x4 xs[4][2][2]; float rr[4];
#pragma unroll
            for (int m = 0; m < 4; ++m) { const size_t off = (size_t)(row0 + ai * HALF + m * 16) * 2048 + col0; rr[m] = rs[row0 + ai * HALF + m * 16];
#pragma unroll
                for (int bj = 0; bj < 2; ++bj)
#pragma unroll
                    for (int n = 0; n < 2; ++n) xs[m][bj][n] = *(const f32x4*)(x + off + bj * HALF + n * 16); }
#pragma unroll
            for (int m = 0; m < 4; ++m) { const size_t off = (size_t)(row0 + ai * HALF + m * 16) * 2048 + col0;
#pragma unroll
                for (int bj = 0; bj < 2; ++bj)
#pragma unroll
                    for (int n = 0; n < 2; ++n) { const i32x4 a = __builtin_bit_cast(i32x4, acc[ai][bj][m][n]); const f32x4 g = gv[bj][n] * rr[m];
                        const f32x4 r = xs[m][bj][n] + g * (f32x4){(float)a[0], (float)a[1], (float)a[2], (float)a[3]};
                        u32x2 w; w.x = cvt_pk_bf16(r[0], r[1]); w.y = cvt_pk_bf16(r[2], r[3]); *(u32x2*)(x1 + off + bj * HALF + n * 16) = w; } }
            asm volatile("" ::: "memory"); }
    }
};
struct EpiGlu {
    static constexpr bool PERM = true;
    unsigned char* O; const float* b_gu;
    __device__ __forceinline__ void side_issue(const Unit& u, LAS float* bt, const LAS int* lte, int wid, int lane) const {
        if (wid >= 4) { const int w4 = wid - 4, e = lte[u.pm];
            __builtin_amdgcn_global_load_lds((const unsigned*)(b_gu + (size_t)e * 4096 + (w4 >> 1) * 2048 + u.pn * HALF + (w4 & 1) * 64 + lane), (LAS unsigned*)(bt + w4 * 64), 4, 0, 0); }
    }
    __device__ __forceinline__ void operator()(const f32x4 (&acc)[2][2][4][2], const Unit& u, int wr, int wc, int fr, int fq, const LAS float* bt, const LAS int*) const {
        const int row0 = u.pm * BM + wr * 64 + fr, col0 = u.pn * HALF + wc * 32 + 8 * fq;
        f32x2 bg4[2][2], bl1[2][2];
#pragma unroll
        for (int n = 0; n < 2; ++n) { const f32x4 g = *(const LAS f32x4*)(bt + wc * 32 + 8 * fq + 4 * n), l = *(const LAS f32x4*)(bt + HALF + wc * 32 + 8 * fq + 4 * n);
            bg4[n][0] = (f32x2){4.0f * g[0], 4.0f * g[1]}; bg4[n][1] = (f32x2){4.0f * g[2], 4.0f * g[3]}; bl1[n][0] = (f32x2){l[0] + 1.0f, l[1] + 1.0f}; bl1[n][1] = (f32x2){l[2] + 1.0f, l[3] + 1.0f}; }
#pragma unroll
        for (int ai = 0; ai < 2; ++ai)
#pragma unroll
            for (int m = 0; m < 4; ++m) { unsigned char* rowp = O + (size_t)(row0 + ai * HALF + m * 16) * 2048 + col0;
                f32x2 r[4];
#pragma unroll
                for (int n = 0; n < 2; ++n)
#pragma unroll
                    for (int hp = 0; hp < 2; ++hp) {
                        const f32x2 ga = (f32x2){acc[ai][0][m][n][2 * hp], acc[ai][0][m][n][2 * hp + 1]}, la = (f32x2){acc[ai][1][m][n][2 * hp], acc[ai][1][m][n][2 * hp + 1]};
                        f32x2 g4 = ga * (4.0f / 64.0f) + bg4[n][hp]; g4[0] = fminf(g4[0], 28.0f); g4[1] = fminf(g4[1], 28.0f);
                        f32x2 l1 = la * (1.0f / 64.0f) + bl1[n][hp]; l1[0] = __builtin_amdgcn_fmed3f(l1[0], -6.0f, 8.0f); l1[1] = __builtin_amdgcn_fmed3f(l1[1], -6.0f, 8.0f);
                        const f32x2 z = g4 * (-1.702f * LOG2E * 0.25f);
                        f32x2 d = (f32x2){__builtin_amdgcn_exp2f(z[0]), __builtin_amdgcn_exp2f(z[1])} + 1.0f;
                        const f32x2 sg = (f32x2){__builtin_amdgcn_rcpf(d[0]), __builtin_amdgcn_rcpf(d[1])};
                        r[n * 2 + hp] = (g4 * sg) * l1; }
                u32x2 w; w.x = pack4_fp8(r[0][0], r[0][1], r[1][0], r[1][1]); w.y = pack4_fp8(r[2][0], r[2][1], r[3][0], r[3][1]);
                *(u32x2*)rowp = w; }
    }
};
struct EpiDown {
    static constexpr bool PERM = true;
    unsigned char* O; const float* b_down;
    __device__ __forceinline__ void side_issue(const Unit& u, LAS float* bt, const LAS int* lte, int wid, int lane) const {
        if (wid >= 4) { const int w4 = wid - 4, e = lte[u.pm];
            __builtin_amdgcn_global_load_lds((const unsigned*)(b_down + (size_t)e * 2048 + u.pn * BM + w4 * 64 + lane), (LAS unsigned*)(bt + w4 * 64), 4, 0, 0); }
    }
    __device__ __forceinline__ void operator()(const f32x4 (&acc)[2][2][4][2], const Unit& u, int wr, int wc, int fr, int fq, const LAS float* bt, const LAS int*) const {
        const int row0 = u.pm * BM + wr * 64 + fr, col0 = u.pn * BM + wc * 32 + 8 * fq;
        f32x4 bv[2][2];
#pragma unroll
        for (int bj = 0; bj < 2; ++bj)
#pragma unroll
            for (int n = 0; n < 2; ++n) bv[bj][n] = *(const LAS f32x4*)(bt + bj * HALF + wc * 32 + 8 * fq + 4 * n) * 16.0f;
#pragma unroll
        for (int ai = 0; ai < 2; ++ai)
#pragma unroll
            for (int m = 0; m < 4; ++m) { unsigned char* rowp = O + (size_t)(row0 + ai * HALF + m * 16) * 2048 + col0;
#pragma unroll
                for (int bj = 0; bj < 2; ++bj) { const f32x4 v0 = acc[ai][bj][m][0] * (16.0f / 256.0f) + bv[bj][0], v1 = acc[ai][bj][m][1] * (16.0f / 256.0f) + bv[bj][1];
                    u32x2 w; w.x = pack4_fp8(v0[0], v0[1], v0[2], v0[3]); w.y = pack4_fp8(v1[0], v1[1], v1[2], v1[3]);
                    *(u32x2*)(rowp + bj * HALF) = w; } }
    }
};
}

struct Frame {
    LAS unsigned char* lds; int tid, lane, wave, G, bid;
    unsigned char* ws;
};
#define WSP(T, off) ((T*)(F.ws + (off)))

struct TileInfo { const float* src; unsigned char* dst; int ld, colA, colB, f8, n0, pad_; };
__device__ __forceinline__ TileInfo conv_decode(const Params& p, const Frame& F, int i) {
    TileInfo t;
    if (i < 896) { const int kt = i / 28, nt = i % 28, r0 = nt * 256; t.colA = r0 < 3072 ? r0 : r0 + 8; t.colB = t.colA + 128; t.ld = 7176;
        t.src = p.w_in + (size_t)kt * 64 * 7176; t.f8 = IN_MODE; t.n0 = r0; t.pad_ = 0; t.dst = F.ws + WS_WIN + (IN_MODE ? (size_t)r0 * 2048 + kt * 64 : ((size_t)r0 * 2048 + kt * 64) * 2); }
    else { const int j = i - 896, kt = j / 8, nt = j % 8; t.colA = nt * 256; t.colB = t.colA + 128; t.ld = 2048;
        t.src = p.w_out + (size_t)kt * 64 * 2048; t.f8 = OUT_MODE; t.n0 = NPROJ + nt * 256; t.pad_ = 0; t.dst = F.ws + WS_WOUT + (OUT_MODE ? (size_t)nt * 256 * 2048 + kt * 64 : ((size_t)nt * 256 * 2048 + kt * 64) * 2); }
    return t;
}
constexpr int CONV_TILES = 1152;
constexpr int CONV8_TILES = 16384 + 8192;
struct Tile8 { const float* src; unsigned char* dst; int ld; };
__device__ __forceinline__ Tile8 conv8_decode(const Params& p, const Frame& F, int i) {
    Tile8 t;
    if (i < 16384) { const int e = i / 512, r = i % 512, kt = r / 32, nt = r % 32, pn = nt >> 1, half = nt & 1; t.ld = 4096;
        t.src = p.w_gu + (size_t)e * 2048 * 4096 + (size_t)kt * 128 * 4096 + half * 2048 + pn * 128; t.dst = F.ws + WS_WGU + ((size_t)e * 4096 + nt * 128) * 2048 + kt * 128; }
    else { const int j = i - 16384, e = j / 256, r = j % 256, kt = r / 16, nt = r % 16; t.ld = 2048;
        t.src = p.w_down + (size_t)e * 2048 * 2048 + (size_t)kt * 128 * 2048 + nt * 128; t.dst = F.ws + WS_WDN + ((size_t)e * 2048 + nt * 128) * 2048 + kt * 128; }
    return t;
}
__device__ __forceinline__ void conv8_load(const Tile8& t, int g, int kq, f32x4 (&L)[2][4]) {
#pragma unroll
    for (int i = 0; i < 2; ++i)
#pragma unroll
        for (int r = 0; r < 4; ++r) L[i][r] = __builtin_nontemporal_load((const f32x4*)(t.src + (size_t)(4 * (kq + 16 * i) + r) * t.ld + 4 * g));
}
__device__ __forceinline__ void conv_load(const TileInfo& t, int g, int kq, f32x4 (&L)[4][2]) {
    const int col = g < 32 ? t.colA + 4 * g : t.colB + 4 * (g - 32);
#pragma unroll
    for (int i = 0; i < 4; ++i) { const int k0 = t.f8 ? 4 * (kq + 8 * (i >> 1)) + 2 * (i & 1) : 2 * (kq + 8 * i);
        L[i][0] = *(const f32x4*)(t.src + (size_t)k0 * t.ld + col);
        L[i][1] = *(const f32x4*)(t.src + (size_t)(k0 + 1) * t.ld + col); }
}
template <int KIND>
__device__ __forceinline__ void wtile_pass(const Params& p, const Frame& F, int lo, int hi) {
    const int tid = F.tid;
    LAS unsigned* tt = (LAS unsigned*)F.lds;
    const int g = tid & 63, kq = tid >> 6;
    f32x4 cur[4][2], nxt[4][2];
    int i = lo + F.bid;
    TileInfo ti;
    if (i < hi) { ti = conv_decode(p, F, i); conv_load(ti, g, kq, cur); }
    while (i < hi) {
        const int inext = i + F.G;
        TileInfo tn = ti;
        if (inext < hi) { tn = conv_decode(p, F, inext); conv_load(tn, g, kq, nxt); }
        if constexpr (KIND == 1) {
            f32x4 m = __builtin_elementwise_max(__builtin_elementwise_abs(cur[0][0]), __builtin_elementwise_abs(cur[0][1]));
#pragma unroll
            for (int q = 1; q < 4; ++q) m = __builtin_elementwise_max(m, __builtin_elementwise_max(__builtin_elementwise_abs(cur[q][0]), __builtin_elementwise_abs(cur[q][1])));
            *(LAS f32x4*)((LAS float*)tt + kq * 256 + 4 * g) = m;
            __syncthreads();
            if (tid < 256) { float v = ((LAS float*)tt)[tid];
#pragma unroll
                for (int w = 1; w < 8; ++w) v = fmaxf(v, ((LAS float*)tt)[w * 256 + tid]);
                __hip_atomic_fetch_max((unsigned*)(F.ws + WS_CMAX) + ti.n0 + tid, __float_as_uint(v), __ATOMIC_RELAXED, __HIP_MEMORY_SCOPE_AGENT); }
        } else if (ti.f8 == 2) {
            const f32x4 cm = *(const f32x4*)((const float*)(F.ws + WS_CMAX) + ti.n0 + 4 * g);
            f32x4 inv;
#pragma unroll
            for (int j = 0; j < 4; ++j) inv[j] = cm[j] > 0.f ? 127.0f / cm[j] : 0.f;
#pragma unroll
            for (int q = 0; q < 2; ++q)
#pragma unroll
                for (int j = 0; j < 4; ++j) tt[(4 * g + j) * 17 + kq + 8 * q] = pack4_i8(inv[j] * cur[2 * q][0][j], inv[j] * cur[2 * q][1][j], inv[j] * cur[2 * q + 1][0][j], inv[j] * cur[2 * q + 1][1][j]);
            __syncthreads();
#pragma unroll
            for (int r = 0; r < 2; ++r) { const int q = tid + 512 * r, n = q >> 2, ch = q & 3;
                u32x4 v; v.x = tt[n * 17 + ch * 4 + 0]; v.y = tt[n * 17 + ch * 4 + 1]; v.z = tt[n * 17 + ch * 4 + 2]; v.w = tt[n * 17 + ch * 4 + 3];
                *(u32x4*)(ti.dst + (size_t)n * 2048 + ch * 16) = v; }
        } else if (ti.f8) {
#pragma unroll
            for (int q = 0; q < 2; ++q)
#pragma unroll
                for (int j = 0; j < 4; ++j) tt[(4 * g + j) * 17 + kq + 8 * q] = pack4_fp8(64.0f * cur[2 * q][0][j], 64.0f * cur[2 * q][1][j], 64.0f * cur[2 * q + 1][0][j], 64.0f * cur[2 * q + 1][1][j]);
            __syncthreads();
#pragma unroll
            for (int r = 0; r < 2; ++r) { const int q = tid + 512 * r, n = q >> 2, ch = q & 3;
                u32x4 v; v.x = tt[n * 17 + ch * 4 + 0]; v.y = tt[n * 17 + ch * 4 + 1]; v.z = tt[n * 17 + ch * 4 + 2]; v.w = tt[n * 17 + ch * 4 + 3];
                *(u32x4*)(ti.dst + (size_t)n * 2048 + ch * 16) = v; }
        } else {
#pragma unroll
            for (int q = 0; q < 4; ++q)
#pragma unroll
                for (int j = 0; j < 4; ++j) tt[(4 * g + j) * 33 + kq + 8 * q] = cvt_pk_bf16(cur[q][0][j], cur[q][1][j]);
            __syncthreads();
#pragma unroll
            for (int r = 0; r < 4; ++r) { const int q = tid + 512 * r, n = q >> 3, ch = q & 7;
                u32x4 v; v.x = tt[n * 33 + ch * 4 + 0]; v.y = tt[n * 33 + ch * 4 + 1]; v.z = tt[n * 33 + ch * 4 + 2]; v.w = tt[n * 33 + ch * 4 + 3];
                *(u32x4*)(ti.dst + (size_t)n * 4096 + ch * 16) = v; }
        }
        __syncthreads();
#pragma unroll
        for (int q = 0; q < 4; ++q) { cur[q][0] = nxt[q][0]; cur[q][1] = nxt[q][1]; }
        ti = tn; i = inext;
    }
}


__device__ __forceinline__ void phase0(const Params& p, const Frame& F) {
    const int tid = F.tid;
    LAS float* cs = (LAS float*)F.lds;
    LAS float* red = cs + 4096;
    for (int i = tid; i < 4096; i += 512) { const float v = p.c[i]; cs[i] = v / (1.0f + expf(-v)); }
    __syncthreads();
    float* modp = WSP(float, WS_MODP);
    for (int u = F.bid; u < 384; u += F.G) {
        const int cc = u % 48, dc = u / 48, w = F.wave, lane = F.lane;
        const int d0 = dc * 256 + w * 32;
        const float* wp = p.w_ada + (size_t)d0 * 12288 + cc * 256 + lane * 4;
        f32x4 a0 = {0.f, 0.f, 0.f, 0.f}, a1 = {0.f, 0.f, 0.f, 0.f};
#pragma unroll 8
        for (int i = 0; i < 32; ++i) { const f32x4 v = *(const f32x4*)(wp + (size_t)i * 12288); const float c0 = cs[d0 + i], c1 = cs[2048 + d0 + i]; a0 += v * c0; a1 += v * c1; }
        *(LAS f32x4*)(red + (w * 2 + 0) * 256 + lane * 4) = a0;
        *(LAS f32x4*)(red + (w * 2 + 1) * 256 + lane * 4) = a1;
        __syncthreads();
        { const int b = tid >> 8, col = tid & 255; float s = 0.f;
#pragma unroll
          for (int w8 = 0; w8 < 8; ++w8) s += red[(w8 * 2 + b) * 256 + col];
          modp[(dc * 2 + b) * 12288 + cc * 256 + col] = s; }
        __syncthreads();
    }
#if IN_MODE == 2 && OUT_MODE == 2
    wtile_pass<1>(p, F, 0, CONV_TILES);
#elif IN_MODE == 2
    wtile_pass<1>(p, F, 0, 896);
    wtile_pass<0>(p, F, 896, CONV_TILES);
#else
    wtile_pass<0>(p, F, 0, CONV_TILES);
#endif
}

__device__ __forceinline__ void conv8_range(const Params& p, const Frame& F, int first, int stride) {
    const int tid = F.tid;
    LAS unsigned* tt = (LAS unsigned*)F.lds;
    const int g8 = tid & 31, kq8 = tid >> 5;
    f32x4 r0[2][4], r1[2][4], r2[2][4], r3[2][4], r4[2][4]; Tile8 t0, t1, t2, t3, t4;
#define C8_PROCESS(R, T) do { \
        _Pragma("unroll") for (int q = 0; q < 2; ++q) _Pragma("unroll") for (int j = 0; j < 4; ++j) \
            tt[(4 * g8 + j) * 33 + kq8 + 16 * q] = pack4_fp8(64.0f * R[q][0][j], 64.0f * R[q][1][j], 64.0f * R[q][2][j], 64.0f * R[q][3][j]); \
        __syncthreads(); \
        _Pragma("unroll") for (int r = 0; r < 2; ++r) { const int q = tid + 512 * r, n = q >> 3, ch = q & 7; \
            u32x4 v; v.x = tt[n * 33 + ch * 4 + 0]; v.y = tt[n * 33 + ch * 4 + 1]; v.z = tt[n * 33 + ch * 4 + 2]; v.w = tt[n * 33 + ch * 4 + 3]; \
            __builtin_nontemporal_store(v, (u32x4*)(T.dst + (size_t)n * 2048 + ch * 16)); } \
        __syncthreads(); } while (0)
#define C8_FETCH(R, T, idx) do { if ((idx) < CONV8_TILES) { T = conv8_decode(p, F, (idx)); conv8_load(T, g8, kq8, R); } } while (0)
    int i = first;
    C8_FETCH(r0, t0, i); C8_FETCH(r1, t1, i + stride); C8_FETCH(r2, t2, i + 2 * stride); C8_FETCH(r3, t3, i + 3 * stride);
    for (;;) {
        if (i >= CONV8_TILES) break;
        C8_FETCH(r4, t4, i + 4 * stride); C8_PROCESS(r0, t0); i += stride;
        if (i >= CONV8_TILES) break;
        C8_FETCH(r0, t0, i + 4 * stride); C8_PROCESS(r1, t1); i += stride;
        if (i >= CONV8_TILES) break;
        C8_FETCH(r1, t1, i + 4 * stride); C8_PROCESS(r2, t2); i += stride;
        if (i >= CONV8_TILES) break;
        C8_FETCH(r2, t2, i + 4 * stride); C8_PROCESS(r3, t3); i += stride;
        if (i >= CONV8_TILES) break;
        C8_FETCH(r3, t3, i + 4 * stride); C8_PROCESS(r4, t4); i += stride;
    }
#undef C8_FETCH
#undef C8_PROCESS
}

__device__ __forceinline__ void phase1(const Params& p, const Frame& F) {
    const int tid = F.tid, lane = F.lane;
    LAS float* wfT = (LAS float*)F.lds;
    LAS float* a1 = wfT + 8 * 2048;
    LAS float* s1 = a1 + 4096;
    const float* modp = WSP(float, WS_MODP);
    for (int q = tid; q < 4096; q += 512) { const int d = q >> 1, hf = q & 1; const f32x4 v = *(const f32x4*)(p.w_in + (size_t)d * 7176 + 3072 + hf * 4);
#pragma unroll
        for (int j = 0; j < 4; ++j) wfT[(hf * 4 + j) * 2048 + d] = v[j]; }
    for (int q = tid; q < 8192; q += 512) { const int b = q >> 12, r = q & 4095; float s = p.b_ada[r];
#pragma unroll
        for (int dc = 0; dc < 8; ++dc) s += modp[(dc * 2 + b) * 12288 + r];
        if (r < 2048) s1[b * 2048 + r] = s; else a1[b * 2048 + (r - 2048)] = p.g1[r - 2048] * (1.0f + s); }
    float* mod = WSP(float, WS_MOD);
    for (int q = F.bid * 512 + tid; q < 24576; q += F.G * 512) { const int b = q / 12288, r = q % 12288; float s = p.b_ada[r];
#pragma unroll
        for (int dc = 0; dc < 8; ++dc) s += modp[(dc * 2 + b) * 12288 + r];
        mod[q] = s; }
    __syncthreads();
    bf16_t* H1 = WSP(bf16_t, WS_H1); float* LOGF = WSP(float, WS_LOGF);
    for (int t = F.bid * 8 + F.wave; t < T_; t += F.G * 8) {
        asm volatile("" ::: "memory");
        const int b = t >> 13;
        const float* xr = p.x + (size_t)t * 2048;
        f32x4 v[8]; float ss = 0.f;
#pragma unroll
        for (int i = 0; i < 8; ++i) { v[i] = *(const f32x4*)(xr + (i * 64 + lane) * 4); ss += v[i][0] * v[i][0] + v[i][1] * v[i][1] + v[i][2] * v[i][2] + v[i][3] * v[i][3]; }
        ss = wave_sum(ss);
        const float rstd = rsqrtf(ss * (1.0f / 2048.0f) + EPS);
        float acc[8];
#pragma unroll
        for (int j = 0; j < 8; ++j) acc[j] = 0.f;
#if IN_MODE == 2
        float amax = 0.f;
#pragma unroll
        for (int i = 0; i < 8; ++i) { const int d = (i * 64 + lane) * 4;
            const f32x4 a = *(const LAS f32x4*)(a1 + b * 2048 + d), s = *(const LAS f32x4*)(s1 + b * 2048 + d);
            const f32x4 h = v[i] * rstd * a + s;
            amax = fmaxf(fmaxf(amax, fmaxf(fabsf(h[0]), fabsf(h[1]))), fmaxf(fabsf(h[2]), fabsf(h[3]))); }
#pragma unroll
        for (int o = 32; o > 0; o >>= 1) amax = fmaxf(amax, __shfl_xor(amax, o));
        const float qinv = amax > 0.f ? 127.0f / amax : 0.f;
        if (lane == 0) WSP(float, WS_RS)[t] = amax * (1.0f / 127.0f);
        asm volatile("" ::: "memory");
#pragma unroll
        for (int i = 0; i < 8; ++i) { const int d = (i * 64 + lane) * 4;
            const f32x4 a = *(const LAS f32x4*)(a1 + b * 2048 + d), s = *(const LAS f32x4*)(s1 + b * 2048 + d);
            const f32x4 h = v[i] * rstd * a + s;
            *(unsigned*)((unsigned char*)H1 + (size_t)t * 2048 + d) = pack4_i8(qinv * h[0], qinv * h[1], qinv * h[2], qinv * h[3]);
#pragma unroll
            for (int j = 0; j < 8; ++j) { const f32x4 wv = *(const LAS f32x4*)(wfT + j * 2048 + d); acc[j] += h[0] * wv[0] + h[1] * wv[1] + h[2] * wv[2] + h[3] * wv[3]; } }
#else
#pragma unroll
        for (int i = 0; i < 8; ++i) { const int d = (i * 64 + lane) * 4;
            const f32x4 a = *(const LAS f32x4*)(a1 + b * 2048 + d), s = *(const LAS f32x4*)(s1 + b * 2048 + d);
            const f32x4 h = v[i] * rstd * a + s;
#if IN_MODE == 1
            *(unsigned*)((unsigned char*)H1 + (size_t)t * 2048 + d) = pack4_fp8(4.0f * h[0], 4.0f * h[1], 4.0f * h[2], 4.0f * h[3]);
#else
            u32x2 w; w.x = cvt_pk_bf16(h[0], h[1]); w.y = cvt_pk_bf16(h[2], h[3]);
            *(u32x2*)(H1 + (size_t)t * 2048 + d) = w;
#endif
#pragma unroll
            for (int j = 0; j < 8; ++j) { const f32x4 wv = *(const LAS f32x4*)(wfT + j * 2048 + d); acc[j] += h[0] * wv[0] + h[1] * wv[1] + h[2] * wv[2] + h[3] * wv[3]; } }
#endif
        float z = 0.f;
#pragma unroll
        for (int j = 0; j < 8; ++j) { const float r = wave_sum(acc[j]); if (lane == j) z = r; }
        if (lane < 8) { z += p.b_fgate[lane]; LOGF[(size_t)t * 8 + lane] = fminf(z, 0.f) - log1pf(expf(-fabsf(z))); }
    }
}

__device__ __forceinline__ void cum_scan(const Frame& F) {
    const int tid = F.tid;
    LAS float* sc = (LAS float*)F.lds;
    const float* LOGF = WSP(float, WS_LOGF); float* CUM = WSP(float, WS_CUM);
    for (int seq = F.bid; seq < 16; seq += F.G) { const int b = seq >> 3, h = seq & 7;
        float v[16]; float run = 0.f; const size_t base = (size_t)b * S_ + tid * 16;
#pragma unroll
        for (int i = 0; i < 16; ++i) { run += LOGF[(base + i) * 8 + h]; v[i] = run; }
        sc[tid] = run; __syncthreads();
        for (int off = 1; off < 512; off <<= 1) { const float tv = tid >= off ? sc[tid - off] : 0.f; __syncthreads(); sc[tid] += tv; __syncthreads(); }
        const float excl = tid ? sc[tid - 1] : 0.f;
#pragma unroll
        for (int i = 0; i < 16; ++i) CUM[(size_t)seq * S_ + tid * 16 + i] = excl + v[i];
        __syncthreads();
    }
}

constexpr int AT_KS = 288;
__device__ __forceinline__ void attn_unit(const Frame& F, int bh, int qb) {
    const int tid = F.tid, lane = F.lane, w = F.wave, fr = lane & 15, fq = lane >> 4;
    const int b = bh >> 3, h = bh & 7;
    const bf16_t* proj = WSP(bf16_t, WS_PROJ) + (size_t)b * S_ * NPROJ + h * 128;
    const bf16_t* Qp = proj + C_FQ; const bf16_t* Kp = proj + C_FK; const bf16_t* Vp = proj + C_FV;
    const float* cum = WSP(float, WS_CUM) + (size_t)bh * S_;
    LAS unsigned char* Kt = F.lds;
    LAS unsigned char* Vt = F.lds + 2 * 64 * AT_KS;
    LAS float* cs = (LAS float*)(F.lds + 4 * 64 * AT_KS);
    const int r0 = qb * 128 + w * 16;
    const int qpos = r0 + fr;
    bf16x8 qf[4];
#pragma unroll
    for (int ks = 0; ks < 4; ++ks) qf[ks] = *(const bf16x8*)(Qp + (size_t)qpos * NPROJ + ks * 32 + fq * 8);
    const float cq = cum[qpos] * LOG2E;
    const int ntiles = 2 * qb + 2;
    const float SC2 = 0.08838834764831845f * LOG2E;
    LAS float* wmax = cs + 128;
    LAS int* shi = (LAS int*)(cs + 136);
    float qn = 0.f, sdiag = 0.f;
    {
#pragma unroll
      for (int ks = 0; ks < 4; ++ks) { const u32x4 v = __builtin_bit_cast(u32x4, qf[ks]); const u32x4 kk = *(const u32x4*)(Kp + (size_t)qpos * NPROJ + ks * 32 + fq * 8);
          const float q0 = bflo(v.x), q1 = bfhi(v.x), q2 = bflo(v.y), q3 = bfhi(v.y), q4 = bflo(v.z), q5 = bfhi(v.z), q6 = bflo(v.w), q7 = bfhi(v.w);
          qn += q0 * q0 + q1 * q1 + q2 * q2 + q3 * q3 + q4 * q4 + q5 * q5 + q6 * q6 + q7 * q7;
          sdiag += q0 * bflo(kk.x) + q1 * bfhi(kk.x) + q2 * bflo(kk.y) + q3 * bfhi(kk.y) + q4 * bflo(kk.z) + q5 * bfhi(kk.z) + q6 * bflo(kk.w) + q7 * bfhi(kk.w); }
      qn += __shfl_xor(qn, 16); qn += __shfl_xor(qn, 32); sdiag += __shfl_xor(sdiag, 16); sdiag += __shfl_xor(sdiag, 32);
      if (tid < 2) shi[tid] = 0; }
    __syncthreads();
    float ce = 0.f;
    if (tid < ntiles) { const float kv = WSP(float, WS_KN)[bh * 128 + tid]; ce = cum[(tid + 1) * 64 - 1] * LOG2E; atomicMax((int*)(shi + 0), __float_as_int(kv)); }
    __syncthreads();
    { float rt = SC2 * sqrtf(qn) * sqrtf(__int_as_float(shi[0])) * 1.001f + cq - SC2 * sdiag;
#pragma unroll
      for (int o = 8; o >= 1; o >>= 1) rt = fmaxf(rt, __shfl_xor(rt, o));
      if (lane == 0) wmax[w] = rt; }
    __syncthreads();
    { float rmax = wmax[0];
#pragma unroll
      for (int i = 1; i < 8; ++i) rmax = fmaxf(rmax, wmax[i]);
      const float bound = rmax - ce + 0.02f;
      if (tid < 2 * qb && bound < -40.0f) atomicMax((int*)(shi + 1), tid + 1); }
    __syncthreads();
    const int j_lo = shi[1];
    float m = -1e30f, l = 0.f;
    f32x4 oT[8];
#pragma unroll
    for (int n = 0; n < 8; ++n) oT[n] = (f32x4){0.f, 0.f, 0.f, 0.f};
    const int skey = tid >> 3, sc16 = (tid & 7) * 16;
    u32x4 kA0, kA1, vA0, vA1, kB0, kB1, vB0, vB1; float cA = 0.f, cB = 0.f;
#define AT_LOAD(S_, j) do { const size_t ro = (size_t)((j) * 64 + skey) * NPROJ + sc16; \
        k##S_##0 = *(const u32x4*)(Kp + ro); k##S_##1 = *(const u32x4*)(Kp + ro + 8); v##S_##0 = *(const u32x4*)(Vp + ro); v##S_##1 = *(const u32x4*)(Vp + ro + 8); \
        if (tid < 64) c##S_ = cum[(j) * 64 + tid]; } while (0)
#define AT_WRITE(S_, buf) do { LAS unsigned char* kd = Kt + (buf) * 64 * AT_KS + skey * AT_KS + sc16 * 2; LAS unsigned char* vd = Vt + (buf) * 64 * AT_KS + skey * AT_KS + sc16 * 2; \
        *(LAS u32x4*)kd = k##S_##0; *(LAS u32x4*)(kd + 16) = k##S_##1; *(LAS u32x4*)vd = v##S_##0; *(LAS u32x4*)(vd + 16) = v##S_##1; if (tid < 64) cs[(buf) * 64 + tid] = c##S_ * LOG2E; } while (0)
#define AT_COMPUTE(j, buf) do { \
        const LAS unsigned char* kb = Kt + (buf) * 64 * AT_KS; \
        f32x4 st[4]; \
        _Pragma("unroll") for (int kt = 0; kt < 4; ++kt) { st[kt] = (f32x4){0.f, 0.f, 0.f, 0.f}; \
            _Pragma("unroll") for (int ks = 0; ks < 4; ++ks) { const bf16x8 a = *(const LAS bf16x8*)(kb + (kt * 16 + fr) * AT_KS + (ks * 32 + fq * 8) * 2); \
                st[kt] = __builtin_amdgcn_mfma_f32_16x16x32_bf16(a, qf[ks], st[kt], 0, 0, 0); } } \
        const int kbase = (j) * 64; \
        const bool diag = (kbase + 63 > r0); \
        float mx = -1e30f; \
        if (diag) {     \
            _Pragma("unroll") for (int kt = 0; kt < 4; ++kt) { const f32x4 ck = *(const LAS f32x4*)(cs + (buf) * 64 + kt * 16 + fq * 4); \
                _Pragma("unroll") for (int i = 0; i < 4; ++i) { float s2 = st[kt][i] * SC2 + (cq - ck[i]); \
                    if (kbase + kt * 16 + fq * 4 + i > qpos) s2 = -__builtin_inff(); \
                    st[kt][i] = s2; mx = fmaxf(mx, s2); } } \
        } else { \
            _Pragma("unroll") for (int kt = 0; kt < 4; ++kt) { const f32x4 ck = *(const LAS f32x4*)(cs + (buf) * 64 + kt * 16 + fq * 4); \
                _Pragma("unroll") for (int i = 0; i < 4; ++i) { const float s2 = st[kt][i] * SC2 + (cq - ck[i]); st[kt][i] = s2; mx = fmaxf(mx, s2); } } \
        } \
        mx = fmaxf(mx, __shfl_xor(mx, 16)); mx = fmaxf(mx, __shfl_xor(mx, 32)); \
        const float mn = fmaxf(m, mx); \
        const float alpha = __builtin_amdgcn_exp2f(m - mn); \
        m = mn; \
        float ps = 0.f; \
        _Pragma("unroll") for (int kt = 0; kt < 4; ++kt) \
            _Pragma("unroll") for (int i = 0; i < 4; ++i) { const float pv = __builtin_amdgcn_exp2f(st[kt][i] - mn); st[kt][i] = pv; ps += pv; } \
        ps += __shfl_xor(ps, 16); ps += __shfl_xor(ps, 32); \
        l = l * alpha + ps; \
        _Pragma("unroll") for (int n = 0; n < 8; ++n) oT[n] *= alpha; \
        bf16x8 pf[2]; \
        _Pragma("unroll") for (int kk = 0; kk < 2; ++kk) { u32x4 pw; pw.x = cvt_pk_bf16(st[2 * kk][0], st[2 * kk][1]); pw.y = cvt_pk_bf16(st[2 * kk][2], st[2 * kk][3]); \
            pw.z = cvt_pk_bf16(st[2 * kk + 1][0], st[2 * kk + 1][1]); pw.w = cvt_pk_bf16(st[2 * kk + 1][2], st[2 * kk + 1][3]); pf[kk] = __builtin_bit_cast(bf16x8, pw); } \
        const unsigned vaddr = (unsigned)(uintptr_t)(Vt + (buf) * 64 * AT_KS) + (unsigned)((fq * 4 + (fr >> 2)) * AT_KS + (fr & 3) * 8); \
        s16x4 va[8][4]; \
          \
        _Pragma("unroll") for (int g2 = 0; g2 < 5; ++g2) { \
            if (g2 < 4) asm volatile("ds_read_b64_tr_b16 %0, %8 offset:%9\n\tds_read_b64_tr_b16 %1, %8 offset:%10\n\tds_read_b64_tr_b16 %2, %8 offset:%11\n\tds_read_b64_tr_b16 %3, %8 offset:%12\n\t" \
                         "ds_read_b64_tr_b16 %4, %8 offset:%13\n\tds_read_b64_tr_b16 %5, %8 offset:%14\n\tds_read_b64_tr_b16 %6, %8 offset:%15\n\tds_read_b64_tr_b16 %7, %8 offset:%16" \
                         : "=&v"(va[2 * (g2 & 3) + 0][0]), "=&v"(va[2 * (g2 & 3) + 0][1]), "=&v"(va[2 * (g2 & 3) + 0][2]), "=&v"(va[2 * (g2 & 3) + 0][3]), \
                           "=&v"(va[2 * (g2 & 3) + 1][0]), "=&v"(va[2 * (g2 & 3) + 1][1]), "=&v"(va[2 * (g2 & 3) + 1][2]), "=&v"(va[2 * (g2 & 3) + 1][3]) \
                         : "v"(vaddr), \
                           "i"((2 * (g2 & 3) + 0) * 32), "i"(16 * AT_KS + (2 * (g2 & 3) + 0) * 32), "i"(32 * AT_KS + (2 * (g2 & 3) + 0) * 32), "i"(48 * AT_KS + (2 * (g2 & 3) + 0) * 32), \
                           "i"((2 * (g2 & 3) + 1) * 32), "i"(16 * AT_KS + (2 * (g2 & 3) + 1) * 32), "i"(32 * AT_KS + (2 * (g2 & 3) + 1) * 32), "i"(48 * AT_KS + (2 * (g2 & 3) + 1) * 32) : "memory"); \
            if (g2 >= 1) { \
                if (g2 < 4) asm volatile("s_waitcnt lgkmcnt(8)" ::: "memory"); else asm volatile("s_waitcnt lgkmcnt(0)" ::: "memory"); \
                __builtin_amdgcn_sched_barrier(0);     \
                _Pragma("unroll") for (int nn = 0; nn < 2; ++nn) { const int n = 2 * (g2 - 1) + nn; \
                    const bf16x8 v0 = (bf16x8){va[n][0][0], va[n][0][1], va[n][0][2], va[n][0][3], va[n][1][0], va[n][1][1], va[n][1][2], va[n][1][3]}; \
                    const bf16x8 v1 = (bf16x8){va[n][2][0], va[n][2][1], va[n][2][2], va[n][2][3], va[n][3][0], va[n][3][1], va[n][3][2], va[n][3][3]}; \
                    oT[n] = __builtin_amdgcn_mfma_f32_16x16x32_bf16(v0, pf[0], oT[n], 0, 0, 0); \
                    oT[n] = __builtin_amdgcn_mfma_f32_16x16x32_bf16(v1, pf[1], oT[n], 0, 0, 0); } } } \
    } while (0)
    AT_LOAD(A, j_lo); AT_WRITE(A, 0);
    if (j_lo + 1 < ntiles) AT_LOAD(B, j_lo + 1);
    __syncthreads();
    for (int j = j_lo; j < ntiles; j += 2) {
        {
            if (j + 2 < ntiles) AT_LOAD(A, j + 2);
            AT_COMPUTE(j, 0);
            if (j + 1 < ntiles) AT_WRITE(B, 1);
            __syncthreads();
        }
        if (j + 1 < ntiles) {
            if (j + 3 < ntiles) AT_LOAD(B, j + 3);
            AT_COMPUTE(j + 1, 1);
            if (j + 2 < ntiles) AT_WRITE(A, 0);
            __syncthreads();
        }
    }
#undef AT_LOAD
#undef AT_WRITE
#undef AT_COMPUTE
    const float rl = 1.0f / l;
    float ssq = 0.f;
    bf16_t* orow = WSP(bf16_t, WS_MIXED) + ((size_t)b * S_ + qpos) * 2048 + h * 128 + fq * 4;
#pragma unroll
    for (int n = 0; n < 8; ++n) { const f32x4 o = oT[n] * rl; ssq += o[0] * o[0] + o[1] * o[1] + o[2] * o[2] + o[3] * o[3];
        u32x2 wv; wv.x = cvt_pk_bf16(o[0], o[1]); wv.y = cvt_pk_bf16(o[2], o[3]); *(u32x2*)(orow + n * 16) = wv; }
    ssq += __shfl_xor(ssq, 16); ssq += __shfl_xor(ssq, 32);
    if (fq == 0) WSP(float, WS_SSQ)[((size_t)b * S_ + qpos) * 8 + h] = ssq;
    __syncthreads();
}


__device__ __forceinline__ void knorm_pass(const Frame& F) {
    const int lane = F.lane, r = lane >> 4, c = lane & 15;
    float* KN = WSP(float, WS_KN);
    for (int u = F.bid * 8 + F.wave; u < 2048; u += F.G * 8) { const int bh = u >> 7, j = u & 127, b = bh >> 3, h = bh & 7;
        const bf16_t* kp = WSP(bf16_t, WS_PROJ) + ((size_t)b * S_ + j * 64 + r) * NPROJ + C_FK + h * 128 + c * 8;
        float mx = 0.f;
#pragma unroll
        for (int it = 0; it < 16; ++it) { const u32x4 v = *(const u32x4*)(kp + (size_t)it * 4 * NPROJ);
            float s = bflo(v.x) * bflo(v.x) + bfhi(v.x) * bfhi(v.x) + bflo(v.y) * bflo(v.y) + bfhi(v.y) * bfhi(v.y) + bflo(v.z) * bflo(v.z) + bfhi(v.z) * bfhi(v.z) + bflo(v.w) * bflo(v.w) + bfhi(v.w) * bfhi(v.w);
#pragma unroll
            for (int o = 8; o >= 1; o >>= 1) s += __shfl_xor(s, o);
            mx = fmaxf(mx, s); }
        mx = fmaxf(mx, __shfl_xor(mx, 16)); mx = fmaxf(mx, __shfl_xor(mx, 32));
        if (lane == 0) KN[u] = mx; }
}

__device__ __forceinline__ void hg_load_col(const Frame& F, int bh, int n, int colbase, unsigned short (&r)[16]) {
    const int tid = F.tid, dk = tid & 127, rq = tid >> 7, b = bh >> 3, h = bh & 7;
    const bf16_t* ptr = WSP(bf16_t, WS_PROJ) + ((size_t)b * S_ + n * 64 + rq * 16) * NPROJ + colbase + h * 128 + dk;
#pragma unroll
    for (int i = 0; i < 16; ++i) r[i] = ptr[(size_t)i * NPROJ];
}
__device__ __forceinline__ void hg_gates(const Params& p, const Frame& F, LAS float* qsum, int h, const unsigned short (&hf)[16], float (&fv)[16], float (&bc)[16], float& blast) {
    const int tid = F.tid, dk = tid & 127, rq = tid >> 7;
    const float l0 = p.lb_logits[h * 128 + dk], l1 = p.lb_logits[1024 + h * 128 + dk];
    const float lb = __builtin_amdgcn_rcpf(1.0f + __expf(l1 - l0));
    float run = 0.f;
#pragma unroll
    for (int i = 0; i < 16; ++i) { const float z = bf2f(hf[i]); const float f = lb + (1.0f - lb) * __builtin_amdgcn_rcpf(1.0f + __builtin_amdgcn_exp2f(z * -LOG2E)); fv[i] = f; run += __builtin_amdgcn_logf(f); bc[i] = run; }
    qsum[rq * 128 + dk] = run;
    __syncthreads();
    float off = 0.f, tot = 0.f;
#pragma unroll
    for (int q = 0; q < 4; ++q) { const float v = qsum[q * 128 + dk]; tot += v; if (q < rq) off += v; }
#pragma unroll
    for (int i = 0; i < 16; ++i) bc[i] += off;
    blast = tot;
}

__device__ __forceinline__ void hgu_unit(const Params& p, const Frame& F, int bh, int n, const unsigned short (&hf)[16], const unsigned short (&hi)[16]) {
    const int tid = F.tid, lane = F.lane, w = F.wave, fr = lane & 15, fq = lane >> 4;
    const int h = bh & 7, dk = tid & 127, rq = tid >> 7;
    LAS bf16_t* kT = (LAS bf16_t*)F.lds;
    LAS bf16_t* vT = kT + 128 * 72;
    LAS float* qsum = (LAS float*)(vT + 128 * 72);
    float fv[16], bc[16], blast;
    hg_gates(p, F, qsum, h, hf, fv, bc, blast);
#pragma unroll
    for (int i = 0; i < 16; i += 2) { const float k0 = (1.0f - fv[i]) * __builtin_amdgcn_exp2f(blast - bc[i]), k1 = (1.0f - fv[i + 1]) * __builtin_amdgcn_exp2f(blast - bc[i + 1]);
        *(LAS unsigned*)(kT + dk * 72 + rq * 16 + i) = cvt_pk_bf16(k0, k1); }
    if (rq == 0) WSP(float, WS_HGDEC)[((size_t)bh * 128 + n) * 128 + dk] = __builtin_amdgcn_exp2f(blast);
#pragma unroll
    for (int i = 0; i < 16; i += 2) *(LAS unsigned*)(vT + dk * 72 + rq * 16 + i) = (unsigned)hi[i] | ((unsigned)hi[i + 1] << 16);
    __syncthreads();
    f32x4 acc[8];
#pragma unroll
    for (int nt = 0; nt < 8; ++nt) acc[nt] = (f32x4){0.f, 0.f, 0.f, 0.f};
#pragma unroll
    for (int ks = 0; ks < 2; ++ks) { const bf16x8 a = *(const LAS bf16x8*)(kT + (w * 16 + fr) * 72 + ks * 32 + fq * 8);
#pragma unroll
        for (int nt = 0; nt < 8; ++nt) { const bf16x8 bv = *(const LAS bf16x8*)(vT + (nt * 16 + fr) * 72 + ks * 32 + fq * 8);
            acc[nt] = __builtin_amdgcn_mfma_f32_16x16x32_bf16(a, bv, acc[nt], 0, 0, 0); } }
    bf16_t* U = WSP(bf16_t, WS_HGU) + ((size_t)bh * 128 + n) * 16384;
#pragma unroll
    for (int nt = 0; nt < 8; ++nt) { u32x2 wv; wv.x = cvt_pk_bf16(acc[nt][0], acc[nt][1]); wv.y = cvt_pk_bf16(acc[nt][2], acc[nt][3]); *(u32x2*)(U + (size_t)(nt * 16 + fr) * 128 + w * 16 + fq * 4) = wv; }
    __syncthreads();
}

__device__ __forceinline__ void hg_scan(const Frame& F) {
    const bf16_t* U = WSP(bf16_t, WS_HGU); const float* DEC = WSP(float, WS_HGDEC); bf16_t* SP = WSP(bf16_t, WS_HGSP);
    for (int idx = F.bid * 512 + F.tid; idx < 16 * 8192; idx += F.G * 512) {
        const int bh = idx >> 13, rem = idx & 8191, dv = rem >> 6, dk2 = (rem & 63) * 2;
        const size_t e0 = (size_t)bh * 128 * 16384 + (size_t)dv * 128 + dk2;
        const size_t d0 = (size_t)bh * 128 * 128 + dk2;
        f32x2 s = {0.f, 0.f};
        for (int n0 = 0; n0 < 128; n0 += 8) {
            unsigned u[8]; f32x2 d[8];
#pragma unroll
            for (int k = 0; k < 8; ++k) { u[k] = *(const unsigned*)(U + e0 + (size_t)(n0 + k) * 16384); d[k] = *(const f32x2*)(DEC + d0 + (size_t)(n0 + k) * 128); }
#pragma unroll
            for (int k = 0; k < 8; ++k) { *(unsigned*)(SP + e0 + (size_t)(n0 + k) * 16384) = cvt_pk_bf16(s[0], s[1]); s = d[k] * s + (f32x2){bflo(u[k]), bfhi(u[k])}; }
        }
    }
}

__device__ __forceinline__ void hgo_unit(const Params& p, const Frame& F, int bh, int n, const unsigned short (&hf)[16], const unsigned short (&hq)[16], const unsigned short (&hi)[16], const u32x4 (&spr)[4]) {
    const int tid = F.tid, lane = F.lane, w = F.wave, fr = lane & 15, fq = lane >> 4;
    const int b = bh >> 3, h = bh & 7, dk = tid & 127, rq = tid >> 7;
    LAS bf16_t* qd = (LAS bf16_t*)F.lds;
    LAS bf16_t* ki = qd + 64 * 136;
    LAS bf16_t* vT = ki + 64 * 136;
    LAS bf16_t* at = vT + 128 * 72;
    LAS bf16_t* sp = at + 64 * 72;
    LAS float* qsum = (LAS float*)(sp + 128 * 136);
    LAS float* rs = qsum + 512;
    const size_t trow = (size_t)b * S_ + n * 64;
    bf16_t* fxp = WSP(bf16_t, WS_MIXED) + (trow + (tid >> 3)) * 2048 + h * 128 + (tid & 7) * 16;
    const u32x4 fx0 = *(const u32x4*)fxp, fx1 = *(const u32x4*)(fxp + 8);
    const f32x4 sq0 = *(const f32x4*)(WSP(float, WS_SSQ) + (trow + (tid >> 3)) * 8), sq1 = *(const f32x4*)(WSP(float, WS_SSQ) + (trow + (tid >> 3)) * 8 + 4);
    u32x2 gwv[4];
    { const bf16_t* hg = WSP(bf16_t, WS_PROJ) + (trow + (w & 3) * 16 + fr) * NPROJ + C_HG + h * 128;
#pragma unroll
      for (int q = 0; q < 4; ++q) gwv[q] = *(const u32x2*)(hg + ((w >> 2) * 4 + q) * 16 + fq * 4); }
    float fv[16], bc[16], blast;
    hg_gates(p, F, qsum, h, hf, fv, bc, blast);
#pragma unroll
    for (int i = 0; i < 16; ++i) { const float q = bf2f(hq[i]); const float qq = q * __builtin_amdgcn_rcpf(1.0f + __builtin_amdgcn_exp2f(q * -LOG2E));
        const float qdv = qq * __builtin_amdgcn_exp2f(bc[i]), kiv = (1.0f - fv[i]) * __builtin_amdgcn_exp2f(-bc[i]);
        qd[(rq * 16 + i) * 136 + dk] = (bf16_t)(cvt_pk_bf16(qdv, 0.f) & 0xffffu);
        ki[(rq * 16 + i) * 136 + dk] = (bf16_t)(cvt_pk_bf16(kiv, 0.f) & 0xffffu); }
#pragma unroll
    for (int i = 0; i < 16; i += 2) *(LAS unsigned*)(vT + dk * 72 + rq * 16 + i) = (unsigned)hi[i] | ((unsigned)hi[i + 1] << 16);
#pragma unroll
    for (int r = 0; r < 4; ++r) { const int q = tid + 512 * r, dv = q >> 4, ch = q & 15; *(LAS u32x4*)(sp + dv * 136 + ch * 8) = spr[r]; }
    __syncthreads();
    { const int ct = w & 3;
#pragma unroll
      for (int q = 0; q < 2; ++q) { const int st = (w >> 2) * 2 + q;
          f32x4 a = {0.f, 0.f, 0.f, 0.f};
          if (st <= ct) {
#pragma unroll
              for (int ks = 0; ks < 4; ++ks) { const bf16x8 ka = *(const LAS bf16x8*)(ki + (st * 16 + fr) * 136 + ks * 32 + fq * 8); const bf16x8 qb = *(const LAS bf16x8*)(qd + (ct * 16 + fr) * 136 + ks * 32 + fq * 8);
                  a = __builtin_amdgcn_mfma_f32_16x16x32_bf16(ka, qb, a, 0, 0, 0); } }
          const int c = ct * 16 + fr;
#pragma unroll
          for (int i = 0; i < 4; ++i) if (st * 16 + fq * 4 + i > c) a[i] = 0.f;
          u32x2 wv; wv.x = cvt_pk_bf16(a[0], a[1]); wv.y = cvt_pk_bf16(a[2], a[3]);
          *(LAS u32x2*)(at + c * 72 + st * 16 + fq * 4) = wv; } }
    __syncthreads();
    const int ct = w & 3, dh = w >> 2;
    f32x4 acc[4];
#pragma unroll
    for (int q = 0; q < 4; ++q) acc[q] = (f32x4){0.f, 0.f, 0.f, 0.f};
#pragma unroll
    for (int ks = 0; ks < 2; ++ks) { const bf16x8 bb = *(const LAS bf16x8*)(at + (ct * 16 + fr) * 72 + ks * 32 + fq * 8);
#pragma unroll
        for (int q = 0; q < 4; ++q) { const bf16x8 aa = *(const LAS bf16x8*)(vT + ((dh * 4 + q) * 16 + fr) * 72 + ks * 32 + fq * 8);
            acc[q] = __builtin_amdgcn_mfma_f32_16x16x32_bf16(aa, bb, acc[q], 0, 0, 0); } }
#pragma unroll
    for (int ks = 0; ks < 4; ++ks) { const bf16x8 bb = *(const LAS bf16x8*)(qd + (ct * 16 + fr) * 136 + ks * 32 + fq * 8);
#pragma unroll
        for (int q = 0; q < 4; ++q) { const bf16x8 aa = *(const LAS bf16x8*)(sp + ((dh * 4 + q) * 16 + fr) * 136 + ks * 32 + fq * 8);
            acc[q] = __builtin_amdgcn_mfma_f32_16x16x32_bf16(aa, bb, acc[q], 0, 0, 0); } }
    float ss = 0.f;
#pragma unroll
    for (int q = 0; q < 4; ++q) ss += acc[q][0] * acc[q][0] + acc[q][1] * acc[q][1] + acc[q][2] * acc[q][2] + acc[q][3] * acc[q][3];
    ss += __shfl_xor(ss, 16); ss += __shfl_xor(ss, 32);
    const int c = ct * 16 + fr;
    if (fq == 0) rs[c * 2 + dh] = ss;
    __syncthreads();
    const float rstd = rsqrtf((rs[c * 2] + rs[c * 2 + 1]) * (1.0f / 128.0f) + EPS);
    bf16_t* orow = WSP(bf16_t, OUT_MODE == 2 ? WS_MIXN : WS_MIXED) + (trow + c) * 2048 + 1024 + h * 128;
#pragma unroll
    for (int q = 0; q < 4; ++q) { const int dv = (dh * 4 + q) * 16 + fq * 4;
        const u32x2 gw = gwv[q]; const f32x4 gn = *(const f32x4*)(p.g_hg + h * 128 + dv);
        const float g0 = bflo(gw.x), g1 = bfhi(gw.x), g2 = bflo(gw.y), g3 = bfhi(gw.y);
        const float o0 = acc[q][0] * rstd * gn[0] * (g0 * __builtin_amdgcn_rcpf(1.0f + __expf(-g0))), o1 = acc[q][1] * rstd * gn[1] * (g1 * __builtin_amdgcn_rcpf(1.0f + __expf(-g1)));
        const float o2 = acc[q][2] * rstd * gn[2] * (g2 * __builtin_amdgcn_rcpf(1.0f + __expf(-g2))), o3 = acc[q][3] * rstd * gn[3] * (g3 * __builtin_amdgcn_rcpf(1.0f + __expf(-g3)));
#if OUT_MODE == 1
        *(unsigned*)(F.ws + WS_MIX8 + (trow + c) * 2048 + 1024 + h * 128 + dv) = pack4_fp8(4.0f * o0, 4.0f * o1, 4.0f * o2, 4.0f * o3);
#else
        u32x2 wv; wv.x = cvt_pk_bf16(o0, o1); wv.y = cvt_pk_bf16(o2, o3); *(u32x2*)(orow + dv) = wv;
#endif
    }
    { const float rstdf = rsqrtf(((sq0[0] + sq0[1]) + (sq0[2] + sq0[3]) + (sq1[0] + sq1[1]) + (sq1[2] + sq1[3])) * (1.0f / 1024.0f) + EPS);
      const float* gf = p.g_fox + h * 128 + (tid & 7) * 16;
#if OUT_MODE == 1
      const float rs4 = 4.0f * rstdf;
      const f32x4 ga = *(const f32x4*)gf * rs4, gb = *(const f32x4*)(gf + 4) * rs4, gc = *(const f32x4*)(gf + 8) * rs4, gd = *(const f32x4*)(gf + 12) * rs4;
      u32x4 ov;
      ov.x = pack4_fp8(bflo(fx0.x) * ga[0], bfhi(fx0.x) * ga[1], bflo(fx0.y) * ga[2], bfhi(fx0.y) * ga[3]); ov.y = pack4_fp8(bflo(fx0.z) * gb[0], bfhi(fx0.z) * gb[1], bflo(fx0.w) * gb[2], bfhi(fx0.w) * gb[3]);
      ov.z = pack4_fp8(bflo(fx1.x) * gc[0], bfhi(fx1.x) * gc[1], bflo(fx1.y) * gc[2], bfhi(fx1.y) * gc[3]); ov.w = pack4_fp8(bflo(fx1.z) * gd[0], bfhi(fx1.z) * gd[1], bflo(fx1.w) * gd[2], bfhi(fx1.w) * gd[3]);
      *(u32x4*)(F.ws + WS_MIX8 + (trow + (tid >> 3)) * 2048 + h * 128 + (tid & 7) * 16) = ov; }
#else
      const f32x4 ga = *(const f32x4*)gf * rstdf, gb = *(const f32x4*)(gf + 4) * rstdf, gc = *(const f32x4*)(gf + 8) * rstdf, gd = *(const f32x4*)(gf + 12) * rstdf;
      u32x4 o0v, o1v;
      o0v.x = cvt_pk_bf16(bflo(fx0.x) * ga[0], bfhi(fx0.x) * ga[1]); o0v.y = cvt_pk_bf16(bflo(fx0.y) * ga[2], bfhi(fx0.y) * ga[3]); o0v.z = cvt_pk_bf16(bflo(fx0.z) * gb[0], bfhi(fx0.z) * gb[1]); o0v.w = cvt_pk_bf16(bflo(fx0.w) * gb[2], bfhi(fx0.w) * gb[3]);
      o1v.x = cvt_pk_bf16(bflo(fx1.x) * gc[0], bfhi(fx1.x) * gc[1]); o1v.y = cvt_pk_bf16(bflo(fx1.y) * gc[2], bfhi(fx1.y) * gc[3]); o1v.z = cvt_pk_bf16(bflo(fx1.z) * gd[0], bfhi(fx1.z) * gd[1]); o1v.w = cvt_pk_bf16(bflo(fx1.w) * gd[2], bfhi(fx1.w) * gd[3]);
      bf16_t* fxo = OUT_MODE == 2 ? WSP(bf16_t, WS_MIXN) + (trow + (tid >> 3)) * 2048 + h * 128 + (tid & 7) * 16 : fxp;
      *(u32x4*)fxo = o0v; *(u32x4*)(fxo + 8) = o1v; }
#endif
    __syncthreads();
}

__device__ __forceinline__ void mix_quant(const Frame& F, int b, int n) {
    const int lane = F.lane;
    const size_t trow = (size_t)b * S_ + n * 64 + F.wave * 8;
    const bf16_t* src = WSP(bf16_t, WS_MIXN); unsigned char* dst = F.ws + WS_MIX8; float* rs = WSP(float, WS_RS2);
#pragma unroll 1
    for (int r = 0; r < 8; r += 2) {
        u32x4 v[2][4];
#pragma unroll
        for (int q = 0; q < 2; ++q)
#pragma unroll
            for (int j = 0; j < 4; ++j) v[q][j] = *(const u32x4*)(src + (trow + r + q) * 2048 + j * 512 + lane * 8);
#pragma unroll
        for (int q = 0; q < 2; ++q) {
            float am = 0.f;
#pragma unroll
            for (int j = 0; j < 4; ++j)
#pragma unroll
                for (int e = 0; e < 4; ++e) am = fmaxf(am, fmaxf(fabsf(bflo(v[q][j][e])), fabsf(bfhi(v[q][j][e]))));
#pragma unroll
            for (int o = 32; o > 0; o >>= 1) am = fmaxf(am, __shfl_xor(am, o));
            const float inv = am > 0.f ? 127.0f / am : 0.f;
#pragma unroll
            for (int j = 0; j < 4; ++j) { u32x2 o;
                o.x = pack4_i8(inv * bflo(v[q][j].x), inv * bfhi(v[q][j].x), inv * bflo(v[q][j].y), inv * bfhi(v[q][j].y));
                o.y = pack4_i8(inv * bflo(v[q][j].z), inv * bfhi(v[q][j].z), inv * bflo(v[q][j].w), inv * bfhi(v[q][j].w));
                *(u32x2*)(dst + (trow + r + q) * 2048 + j * 512 + lane * 8) = o; }
            if (lane == 0) rs[trow + r + q] = am * (1.0f / 127.0f); }
    }
}

constexpr int HS_STRIDE = 2052;
__device__ __forceinline__ void phase7(const Params& p, const Frame& F) {
    const int tid = F.tid, lane = F.lane, w = F.wave;
    LAS float* hs = (LAS float*)F.lds;
    LAS float* part = hs + 16 * HS_STRIDE;
    LAS float* lg = part + 8 * 16 * 32;
    LAS int* hist = (LAS int*)(lg + 512);
    const float* mod = WSP(float, WS_MOD); const bf16_t* X1 = WSP(bf16_t, WS_X1);
    unsigned char* H2 = F.ws + WS_H2; int* TOPI = WSP(int, WS_TOPI); float* TOPG = WSP(float, WS_TOPG); int* CNT = WSP(int, WS_CNT);
    float wreg[16][4][2];
    { const int i16 = lane & 15, kq = lane >> 4;
#pragma unroll
      for (int kb = 0; kb < 16; ++kb)
#pragma unroll
          for (int sx = 0; sx < 4; ++sx) { const float* wp = p.w_router + (size_t)(256 * w + 16 * kb + 4 * kq + sx) * 32 + i16; wreg[kb][sx][0] = wp[0]; wreg[kb][sx][1] = wp[16]; } }
    for (int chunk = F.bid; chunk < 256; chunk += F.G) {
        if (tid < 32) hist[tid] = 0;
        __syncthreads();
        for (int gi = 0; gi < 4; ++gi) {
            const int t0 = chunk * 64 + gi * 16;
#pragma unroll
            for (int r = 0; r < 2; ++r) { const int tk = 2 * w + r, t = t0 + tk, b = t >> 13;
                const bf16_t* xr = X1 + (size_t)t * 2048;
                f32x4 v[8]; float ss = 0.f;
#pragma unroll
                for (int i = 0; i < 8; ++i) { const u32x2 xw = *(const u32x2*)(xr + (i * 64 + lane) * 4); v[i] = (f32x4){bflo(xw.x), bfhi(xw.x), bflo(xw.y), bfhi(xw.y)}; ss += v[i][0] * v[i][0] + v[i][1] * v[i][1] + v[i][2] * v[i][2] + v[i][3] * v[i][3]; }
                ss = wave_sum(ss);
                const float rstd = rsqrtf(ss * (1.0f / 2048.0f) + EPS);
#pragma unroll
                for (int i = 0; i < 8; ++i) { const int d = (i * 64 + lane) * 4;
                    const f32x4 sh = *(const f32x4*)(mod + b * 12288 + 6144 + d), sc = *(const f32x4*)(mod + b * 12288 + 8192 + d), g = *(const f32x4*)(p.g2 + d);
                    const f32x4 hv = v[i] * rstd * g * (sc + 1.0f) + sh;
                    *(unsigned*)(H2 + (size_t)t * 2048 + d) = pack4_fp8(hv[0], hv[1], hv[2], hv[3]);
                    *(LAS f32x4*)(hs + tk * HS_STRIDE + d) = hv; } }
            __syncthreads();
            { const int i16 = lane & 15, kq = lane >> 4;
              f32x4 c0 = {0.f, 0.f, 0.f, 0.f}, c1 = {0.f, 0.f, 0.f, 0.f};
#pragma unroll
              for (int kb = 0; kb < 16; ++kb) { const int kbase = 256 * w + 16 * kb + 4 * kq;
                  const f32x4 a4 = *(const LAS f32x4*)(hs + i16 * HS_STRIDE + kbase);
#pragma unroll
                  for (int sx = 0; sx < 4; ++sx) {
                      c0 = __builtin_amdgcn_mfma_f32_16x16x4f32(a4[sx], wreg[kb][sx][0], c0, 0, 0, 0); c1 = __builtin_amdgcn_mfma_f32_16x16x4f32(a4[sx], wreg[kb][sx][1], c1, 0, 0, 0); } }
#pragma unroll
              for (int r = 0; r < 4; ++r) { part[(w * 16 + 4 * kq + r) * 32 + i16] = c0[r]; part[(w * 16 + 4 * kq + r) * 32 + 16 + i16] = c1[r]; } }
            __syncthreads();
            {
                const int tk = tid >> 5, e = tid & 31; float cur = p.b_router[e];
#pragma unroll
                for (int w8 = 0; w8 < 8; ++w8) cur += part[(w8 * 16 + tk) * 32 + e];
                float vals[4]; int ids[4];
#pragma unroll
                for (int k = 0; k < 4; ++k) { float bv = cur; int bi = e;
#pragma unroll
                    for (int o = 16; o >= 1; o >>= 1) { const float ov = __shfl_xor(bv, o); const int oi = __shfl_xor(bi, o); if (ov > bv || (ov == bv && oi < bi)) { bv = ov; bi = oi; } }
                    vals[k] = bv; ids[k] = bi; if (e == bi) cur = -__builtin_inff(); }
                if (e == 0) { const int t = t0 + tk; float ex[4], se = 0.f;
#pragma unroll
                    for (int k = 0; k < 4; ++k) { ex[k] = __expf(vals[k] - vals[0]); se += ex[k]; }
                    const float inv = 1.0f / se;
#pragma unroll
                    for (int k = 0; k < 4; ++k) { TOPI[(size_t)t * 4 + k] = ids[k]; TOPG[(size_t)t * 4 + k] = ex[k] * inv; atomicAdd((int*)(hist + ids[k]), 1); } } }
            __syncthreads();
        }
        if (tid < 32) CNT[chunk * 32 + tid] = hist[tid];
        __syncthreads();
    }
}

__device__ __forceinline__ void phase8(const Frame& F) {
    const int tid = F.tid, lane = F.lane, w = F.wave;
    LAS int* cn = (LAS int*)F.lds;
    LAS int* part = cn + 8192;
    LAS int* tot = part + 512;
    LAS int* base = tot + 32;
    LAS int* pst = base + 32;
    LAS int* wcnt = pst + 40;
    const int* CNT = WSP(int, WS_CNT); const int* TOPI = WSP(int, WS_TOPI);
    int* POS = WSP(int, WS_POS); int* SRC = WSP(int, WS_SRC); int* TILEE = WSP(int, WS_TILEE);
    const int chunk0 = F.bid;
    int e_pre = 0;
    if (tid < 256 && chunk0 < 256) e_pre = TOPI[(size_t)chunk0 * 256 + tid];
    for (int q = tid; q < 8192; q += 512) cn[q] = CNT[q];
    __syncthreads();
    { const int e = tid & 31, g = tid >> 5; int sacc = 0;
#pragma unroll
      for (int c = 0; c < 16; ++c) sacc += cn[(g * 16 + c) * 32 + e];
      part[g * 32 + e] = sacc; }
    __syncthreads();
    if (tid < 32) { int run = 0;
#pragma unroll
        for (int g = 0; g < 16; ++g) run += part[g * 32 + tid];
        tot[tid] = run; }
    __syncthreads();
    if (tid < 32) {
        const int pad = (tot[tid] + 255) / 256 * 256; int incl = pad;
#pragma unroll
        for (int o = 1; o < 32; o <<= 1) { const int v = __shfl_up(incl, o); if (tid >= o) incl += v; }
        pst[tid] = incl - pad; if (tid == 31) pst[32] = incl; }
    __syncthreads();
    for (int chunk = chunk0; chunk < 256; chunk += F.G) {
        if (tid < 32) { const int g = chunk >> 4; int run = 0;
            for (int gg = 0; gg < g; ++gg) run += part[gg * 32 + tid];
            for (int c = g * 16; c < chunk; ++c) run += cn[c * 32 + tid];
            base[tid] = run; }
        int e = e_pre; if (chunk != chunk0 && tid < 256) e = TOPI[(size_t)chunk * 256 + tid];
        int rk = 0;
        if (tid < 256) {
#pragma unroll 8
            for (int k = 0; k < 32; ++k) { const unsigned long long mk = __ballot(e == k);
                if (e == k) rk = __popcll(mk & ((1ull << lane) - 1ull));
                if (lane == k) wcnt[w * 32 + k] = __popcll(mk); } }
        __syncthreads();
        if (tid < 256) { int before = 0;
            for (int ww = 0; ww < w; ++ww) before += wcnt[ww * 32 + e];
            const int pos = pst[e] + base[e] + before + rk; POS[(size_t)chunk * 256 + tid] = pos; SRC[pos] = chunk * 64 + (tid >> 2); }
        if (chunk < 32) { const int ee = chunk; for (int r = pst[ee] + tot[ee] + tid; r < pst[ee + 1]; r += 512) SRC[r] = 0; }
        if (chunk == 0) { const int ntl = pst[32] >> 8; for (int i = tid; i < ntl; i += 512) { int ee = 0;
#pragma unroll
                for (int k = 0; k < 32; ++k) if (pst[k] <= i * 256) ee = k;
                TILEE[i] = ee; }
            if (tid == 0) TILEE[MAXTILES] = ntl; }
        __syncthreads();
    }
}

__device__ __forceinline__ void phase11(const Params& p, const Frame& F) {
    const int lane = F.lane;
    const float* mod = WSP(float, WS_MOD); const bf16_t* X1 = WSP(bf16_t, WS_X1); const unsigned char* Y = F.ws + WS_YBUF;
    const int* POS = WSP(int, WS_POS); const float* TOPG = WSP(float, WS_TOPG);
    for (int t = F.bid * 8 + F.wave; t < T_; t += F.G * 8) {
        const int b = t >> 13;
        int ps[4]; float gk[4];
#pragma unroll
        for (int k = 0; k < 4; ++k) { ps[k] = POS[(size_t)t * 4 + k]; gk[k] = TOPG[(size_t)t * 4 + k] * (1.0f / 16.0f); }
        f32x4 v[8]; float ss = 0.f;
#pragma unroll
        for (int i = 0; i < 8; ++i) { const int d = (i * 64 + lane) * 4;
            f32x4 a = {0.f, 0.f, 0.f, 0.f};
#pragma unroll
            for (int k = 0; k < 4; ++k) { const int yw = *(const int*)(Y + (size_t)ps[k] * 2048 + d);
                const f32x2 ylo = __builtin_amdgcn_cvt_pk_f32_fp8(yw, false), yhi = __builtin_amdgcn_cvt_pk_f32_fp8(yw, true);
                a[0] += gk[k] * ylo[0]; a[1] += gk[k] * ylo[1]; a[2] += gk[k] * yhi[0]; a[3] += gk[k] * yhi[1]; }
            const f32x4 gt = *(const f32x4*)(mod + b * 12288 + 10240 + d);
            const u32x2 xw = *(const u32x2*)(X1 + (size_t)t * 2048 + d);
            v[i] = (f32x4){bflo(xw.x), bfhi(xw.x), bflo(xw.y), bfhi(xw.y)} + gt * a;
            ss += v[i][0] * v[i][0] + v[i][1] * v[i][1] + v[i][2] * v[i][2] + v[i][3] * v[i][3]; }
        ss = wave_sum(ss);
        const float rstd = rsqrtf(ss * (1.0f / 2048.0f) + EPS);
#pragma unroll
        for (int i = 0; i < 8; ++i) { const int d = (i * 64 + lane) * 4; const f32x4 g = *(const f32x4*)(p.g_final + d);
            *(f32x4*)(p.out + (size_t)t * 2048 + d) = v[i] * rstd * g; }
    }
}

__global__ void __launch_bounds__(512, 2) fwd(Params p) {
    extern __shared__ __attribute__((aligned(16))) unsigned char lds_raw[];
    Frame F;
    F.lds = (LAS unsigned char*)lds_raw;
    F.tid = threadIdx.x; F.lane = F.tid & 63; F.wave = __builtin_amdgcn_readfirstlane(F.tid >> 6);
    F.G = gridDim.x; F.bid = blockIdx.x; F.ws = p.ws;
    volatile LAS unsigned* xbw = (volatile LAS unsigned*)(F.lds + LDS_BYTES - 16);
    if (F.tid < 4) xbw[F.tid] = 0u;
    __syncthreads();
    const int lo = p.lo, hi = p.hi;
    const bool multi = (hi - lo) > 1;
    XcdBarrier bar; bar.bar = (unsigned*)(p.ws + WS_CTL); bar.x = 0; bar.st = xbw;
    if (multi) bar = xcd_barrier_post((unsigned*)(p.ws + WS_CTL), xbw);
#define IN(k) (lo <= (k) && (k) < hi)
#define SEAM(k) do { if (IN((k) + 1)) xcd_barrier(bar); } while (0)

    if (IN(0)) { phase0(p, F); SEAM(0); }
    if (IN(1)) { phase1(p, F);
#if IN_MODE == 2
        __syncthreads(); wtile_pass<0>(p, F, 0, OUT_MODE == 2 ? CONV_TILES : 896);
#endif
        SEAM(1); }
    if (IN(2)) {
        cum_scan(F);
        pg8::SplitOrder S; S.init(T_, NPROJ, F.G, F.bid, CONV_NCG, CONV_NA, WGM_IN);
        if ((F.G & 63) != 0) conv8_range(p, F, F.bid, F.G);
        else if (S.conv) conv8_range(p, F, S.conv_rank(CONV_NCG), (F.G >> 3) * CONV_NCG);
        __syncthreads();
#if IN_MODE == 2
        pg8::SrcPlain X{WSP(bf16_t, WS_H1), WSP(bf16_t, WS_WIN), 1024};
        pg8::EpiProjI8 E{WSP(bf16_t, WS_PROJ), NPROJ, WSP(float, WS_RS), WSP(float, WS_CMAX)};
        pg8::gemm_phase<2>(F.lds, 1024, S, X, E);
#elif IN_MODE == 1
        pg8::SrcPlain X{WSP(bf16_t, WS_H1), WSP(bf16_t, WS_WIN), 1024};
        pg8::EpiProj E{WSP(bf16_t, WS_PROJ), NPROJ, 1.0f / 256.0f};
        pg8::gemm_phase<1>(F.lds, 1024, S, X, E);
#else
        pg8::SrcPlain X{WSP(bf16_t, WS_H1), WSP(bf16_t, WS_WIN), 2048};
        pg8::EpiProj E{WSP(bf16_t, WS_PROJ), NPROJ, 1.0f};
        pg8::gemm_phase<0>(F.lds, 2048, S, X, E);
#endif
        SEAM(2);
    }
    if (IN(3)) {
        {   unsigned short fa[16], va[16], fb[16], vb[16];
            int u = F.bid;
            if (u < 2048) { hg_load_col(F, u >> 7, u & 127, C_HF, fa); hg_load_col(F, u >> 7, u & 127, C_HI, va); }
            while (u < 2048) { const int un = u + F.G;
                if (un < 2048) { hg_load_col(F, un >> 7, un & 127, C_HF, fb); hg_load_col(F, un >> 7, un & 127, C_HI, vb); }
                hgu_unit(p, F, u >> 7, u & 127, fa, va);
#pragma unroll
                for (int i = 0; i < 16; ++i) { fa[i] = fb[i]; va[i] = vb[i]; }
                u = un; } }
        knorm_pass(F);
        SEAM(3);
    }
    if (IN(4)) {
        hg_scan(F);
        for (int a = F.bid; a < 512; a += F.G) { const int bh = a >> 5, xq = a & 31; attn_unit(F, bh, xq); attn_unit(F, bh, 63 - xq); }
        SEAM(4);
    }
    if (IN(5)) {
        {   unsigned short fa[16], qa[16], va[16], fb[16], qb[16], vb[16]; u32x4 sa[4], sb[4];
            const bf16_t* SPg = WSP(bf16_t, WS_HGSP);
#define HGO_LOAD(u_, f_, q_, v_, s_) do { hg_load_col(F, (u_) >> 7, (u_) & 127, C_HF, f_); hg_load_col(F, (u_) >> 7, (u_) & 127, C_HQ, q_); hg_load_col(F, (u_) >> 7, (u_) & 127, C_HI, v_); \
                _Pragma("unroll") for (int r = 0; r < 4; ++r) { const int q = F.tid + 512 * r; s_[r] = *(const u32x4*)(SPg + (size_t)(u_) * 16384 + (size_t)(q >> 4) * 128 + (q & 15) * 8); } } while (0)
#if OUT_MODE == 2
#define HGO_UOF(j_) ((F.bid + ((j_) >> 3) * F.G) < 256 ? ((((F.bid + ((j_) >> 3) * F.G) >> 7) * 8 + ((j_) & 7)) * 128 + ((F.bid + ((j_) >> 3) * F.G) & 127)) : 2048)
            int j = 0, u = HGO_UOF(0);
            if (u < 2048) HGO_LOAD(u, fa, qa, va, sa);
            while (u < 2048) { const int un = HGO_UOF(j + 1);
                if (un < 2048) HGO_LOAD(un, fb, qb, vb, sb);
                hgo_unit(p, F, u >> 7, u & 127, fa, qa, va, sa);
                if ((j & 7) == 7) mix_quant(F, u >> 10, u & 127);
#pragma unroll
                for (int i = 0; i < 16; ++i) { fa[i] = fb[i]; qa[i] = qb[i]; va[i] = vb[i]; }
#pragma unroll
                for (int r = 0; r < 4; ++r) sa[r] = sb[r];
                u = un; ++j; }
#undef HGO_UOF
#else
            int u = F.bid;
            if (u < 2048) HGO_LOAD(u, fa, qa, va, sa);
            while (u < 2048) { const int un = u + F.G;
                if (un < 2048) HGO_LOAD(un, fb, qb, vb, sb);
                hgo_unit(p, F, u >> 7, u & 127, fa, qa, va, sa);
#pragma unroll
                for (int i = 0; i < 16; ++i) { fa[i] = fb[i]; qa[i] = qb[i]; va[i] = vb[i]; }
#pragma unroll
                for (int r = 0; r < 4; ++r) sa[r] = sb[r];
                u = un; }
#endif
#undef HGO_LOAD
        }
        SEAM(5);
    }
    if (IN(6)) {
        pg8::StaticOrder S; S.init(T_, 2048, F.G, F.bid, WGM_OUT);
#if OUT_MODE == 2
        pg8::SrcPlain X{WSP(bf16_t, WS_MIX8), WSP(bf16_t, WS_WOUT), 1024};
        pg8::EpiResidI8 E{p.x, WSP(bf16_t, WS_X1), WSP(float, WS_MOD) + 4096, WSP(float, WS_RS2), WSP(float, WS_CMAX) + NPROJ};
        pg8::gemm_phase<2>(F.lds, 1024, S, X, E);
#elif OUT_MODE == 1
        pg8::SrcPlain X{WSP(bf16_t, WS_MIX8), WSP(bf16_t, WS_WOUT), 1024};
        pg8::EpiResid E{p.x, WSP(bf16_t, WS_X1), WSP(float, WS_MOD) + 4096, 1.0f / 256.0f};
        pg8::gemm_phase<1>(F.lds, 1024, S, X, E);
#else
        pg8::SrcPlain X{WSP(bf16_t, WS_MIXED), WSP(bf16_t, WS_WOUT), 2048};
        pg8::EpiResid E{p.x, WSP(bf16_t, WS_X1), WSP(float, WS_MOD) + 4096, 1.0f};
        pg8::gemm_phase<0>(F.lds, 2048, S, X, E);
#endif
        SEAM(6);
    }
    if (IN(7)) { phase7(p, F); SEAM(7); }
    if (IN(8)) { phase8(F); SEAM(8); }
    if (IN(9)) {
        const int ntl = WSP(int, WS_TILEE)[MAXTILES];
        pg8::StaticOrder S; S.init(ntl * 256, 4096, F.G, F.bid, WGM_GU);
        pg8::SrcMoE X{WSP(bf16_t, WS_H2), WSP(bf16_t, WS_WGU), WSP(int, WS_SRC), WSP(int, WS_TILEE), 1024, (size_t)4096 * 1024};
        pg8::EpiGlu E{F.ws + WS_ACT, p.b_gu};
        pg8::gemm_phase<1>(F.lds, 1024, S, X, E);
        SEAM(9);
    }
    if (IN(10)) {
        const int ntl = WSP(int, WS_TILEE)[MAXTILES];
        pg8::StaticOrder S; S.init(ntl * 256, 2048, F.G, F.bid, WGM_DN);
        pg8::SrcMoE X{WSP(bf16_t, WS_ACT), WSP(bf16_t, WS_WDN), nullptr, WSP(int, WS_TILEE), 1024, (size_t)2048 * 1024};
        pg8::EpiDown E{F.ws + WS_YBUF, p.b_down};
        pg8::gemm_phase<1>(F.lds, 1024, S, X, E);
        SEAM(10);
    }
    if (IN(11)) { phase11(p, F); }
#undef IN
#undef SEAM
}

#ifndef N_LAUNCH_MODE
#define N_LAUNCH_MODE 1
#endif
extern "C" void kernel_launch(void* const* d_in, const int* in_sizes, int n_in, void* d_out, int out_size, void* d_ws, size_t ws_size, hipStream_t stream) {
    static int grid = 0;
    if (grid == 0) {
        if (n_in != 19 || out_size != T_ * D_ || ws_size < WS_END) { fprintf(stderr, "kernel_launch: unexpected shapes (n_in %d out %d ws %zu need %zu)\n", n_in, out_size, ws_size, (size_t)WS_END); grid = -1; return; }
        int dev = 0, cus = 0, per_cu = 0;
        if (hipGetDevice(&dev) != hipSuccess || hipDeviceGetAttribute(&cus, hipDeviceAttributeMultiprocessorCount, dev) != hipSuccess) { grid = -1; return; }
        if (hipFuncSetAttribute((const void*)fwd, hipFuncAttributeMaxDynamicSharedMemorySize, LDS_BYTES) != hipSuccess) { fprintf(stderr, "kernel_launch: hipFuncSetAttribute failed\n"); grid = -1; return; }
        if (hipOccupancyMaxActiveBlocksPerMultiprocessor(&per_cu, (const void*)fwd, 512, LDS_BYTES) != hipSuccess || per_cu < 1) fprintf(stderr, "kernel_launch: occupancy query reports %d\n", per_cu);
        (void)hipGetLastError();
        grid = cus;
    }
    if (grid < 0) return;
    (void)in_sizes;
    hipMemsetAsync((char*)d_ws + WS_CTL, 0, 65536, stream);
    Params p{};
    p.x = (const float*)d_in[0]; p.c = (const float*)d_in[1]; p.w_ada = (const float*)d_in[2]; p.b_ada = (const float*)d_in[3];
    p.g1 = (const float*)d_in[4]; p.g2 = (const float*)d_in[5]; p.w_in = (const float*)d_in[6]; p.b_fgate = (const float*)d_in[7];
    p.g_fox = (const float*)d_in[8]; p.lb_logits = (const float*)d_in[9]; p.g_hg = (const float*)d_in[10]; p.w_out = (const float*)d_in[11];
    p.w_router = (const float*)d_in[12]; p.b_router = (const float*)d_in[13]; p.w_gu = (const float*)d_in[14]; p.b_gu = (const float*)d_in[15];
    p.w_down = (const float*)d_in[16]; p.b_down = (const float*)d_in[17]; p.g_final = (const float*)d_in[18];
    p.out = (float*)d_out; p.ws = (unsigned char*)d_ws;
#if N_LAUNCH_MODE == 1
    p.lo = 0; p.hi = NPHASE;
    hipLaunchKernelGGL(fwd, dim3(grid), dim3(512), LDS_BYTES, stream, p);
#else
    for (int k = 0; k < NPHASE; ++k) { p.lo = k; p.hi = k + 1; hipLaunchKernelGGL(fwd, dim3(grid), dim3(512), LDS_BYTES, stream, p); }
#endif
}
```

```cpp
#include <hip/hip_runtime.h>
#include <cstdio>
#include <cstdint>

#define LAS __attribute__((address_space(3)))
typedef unsigned short bf16_t;
typedef short bf16x8 __attribute__((ext_vector_type(8)));
typedef short s16x4 __attribute__((ext_vector_type(4)));
typedef float f32x4 __attribute__((ext_vector_type(4)));
typedef float f32x2 __attribute__((ext_vector_type(2)));
typedef unsigned u32x4 __attribute__((ext_vector_type(4)));
typedef unsigned u32x2 __attribute__((ext_vector_type(2)));
typedef int i32x4 __attribute__((ext_vector_type(4)));
typedef int i32x8 __attribute__((ext_vector_type(8)));

constexpr int T_ = 16384, D_ = 2048, S_ = 8192;
constexpr int NPROJ = 7168;
constexpr int C_FQ = 0, C_FK = 1024, C_FV = 2048, C_HQ = 3072, C_HF = 4096, C_HI = 5120, C_HG = 6144;
constexpr int NE = 32;
constexpr int MAXTILES = 288, MAXROWS = MAXTILES * 256;
constexpr int LDS_BYTES = 155648;
constexpr int NPHASE = 12;
#ifndef WGM_IN
#define WGM_IN 2
#endif
#ifndef WGM_OUT
#define WGM_OUT 2
#endif
#ifndef WGM_GU
#define WGM_GU 2
#endif
#ifndef WGM_DN
#define WGM_DN 2
#endif
#ifndef CONV_NCG
#define IN_MODE 2
#define OUT_MODE 2
#define CONV_NCG 4
#endif
#ifndef CONV_NA
#define CONV_NA 0
#endif
constexpr float EPS = 1e-6f;
constexpr float LOG2E = 1.4426950408889634f;

constexpr size_t al256(size_t x) { return (x + 255) & ~(size_t)255; }
constexpr size_t WS_CTL   = 0;
constexpr size_t WS_MODP  = 65536;
constexpr size_t WS_MOD   = WS_MODP + al256(8 * 2 * 12288 * 4);
constexpr size_t WS_WIN   = WS_MOD + al256(2 * 12288 * 4);
constexpr size_t WS_WOUT  = WS_WIN + (size_t)NPROJ * 2048 * 2;
constexpr size_t WS_WGU   = WS_WOUT + (size_t)2048 * 2048 * 2;
constexpr size_t WS_WDN   = WS_WGU + (size_t)32 * 4096 * 2048 * 2;
constexpr size_t WS_H1    = WS_WDN + (size_t)32 * 2048 * 2048 * 2;
constexpr size_t WS_PROJ  = WS_H1 + (size_t)T_ * 2048 * 2;
constexpr size_t WS_LOGF  = WS_PROJ + (size_t)T_ * NPROJ * 2;
constexpr size_t WS_CUM   = WS_LOGF + (size_t)T_ * 8 * 4;
constexpr size_t WS_HGU   = WS_CUM + (size_t)T_ * 8 * 4;
constexpr size_t WS_HGSP  = WS_HGU + (size_t)16 * 128 * 128 * 128 * 4;
constexpr size_t WS_HGDEC = WS_HGSP + (size_t)16 * 128 * 128 * 128 * 2;
constexpr size_t WS_MIXED = WS_HGDEC + (size_t)16 * 128 * 128 * 4;
constexpr size_t WS_SSQ   = WS_MIXED + (size_t)T_ * 2048 * 2;
constexpr size_t WS_X1    = WS_SSQ + (size_t)T_ * 8 * 4;
constexpr size_t WS_H2    = WS_X1 + (size_t)T_ * 2048 * 4;
constexpr size_t WS_TOPI  = WS_H2 + (size_t)T_ * 2048 * 2;
constexpr size_t WS_TOPG  = WS_TOPI + (size_t)T_ * 16;
constexpr size_t WS_POS   = WS_TOPG + (size_t)T_ * 16;
constexpr size_t WS_CNT   = WS_POS + (size_t)T_ * 16;
constexpr size_t WS_SRC   = WS_CNT + 256 * 32 * 4;
constexpr size_t WS_TILEE = WS_SRC + (size_t)MAXROWS * 4;
constexpr size_t WS_ACT   = WS_TILEE + 4096;
constexpr size_t WS_YBUF  = WS_ACT + (size_t)MAXROWS * 2048 * 2;
constexpr size_t WS_KN    = WS_YBUF + (size_t)MAXROWS * 2048 * 2;
constexpr size_t WS_MIX8  = WS_KN + 16 * 128 * 4;
constexpr size_t WS_RS    = WS_MIX8 + (size_t)T_ * 2048;
constexpr size_t WS_MIXN  = WS_RS + (size_t)T_ * 4;
constexpr size_t WS_RS2   = WS_MIXN + (size_t)T_ * 2048 * 2;
constexpr size_t WS_END   = WS_RS2 + (size_t)T_ * 4;
constexpr size_t WS_CMAX  = 16384;

struct Params {
    const float* x; const float* c; const float* w_ada; const float* b_ada; const float* g1; const float* g2;
    const float* w_in; const float* b_fgate; const float* g_fox; const float* lb_logits; const float* g_hg;
    const float* w_out; const float* w_router; const float* b_router; const float* w_gu; const float* b_gu;
    const float* w_down; const float* b_down; const float* g_final;
    float* out; unsigned char* ws; int lo, hi;
};

__device__ __forceinline__ unsigned cvt_pk_bf16(float lo, float hi) { unsigned r; asm volatile("v_cvt_pk_bf16_f32 %0, %1, %2" : "=v"(r) : "v"(lo), "v"(hi)); return r; }
__device__ __forceinline__ unsigned pack4_fp8(float a, float b, float c, float d) { int w = 0; w = __builtin_amdgcn_cvt_pk_fp8_f32(a, b, w, false); w = __builtin_amdgcn_cvt_pk_fp8_f32(c, d, w, true); return (unsigned)w; }
__device__ __forceinline__ unsigned pack4_i8(float a, float b, float c, float d) {
    const int ia = __float2int_rn(a), ib = __float2int_rn(b), ic = __float2int_rn(c), id = __float2int_rn(d);
    return (unsigned)(ia & 255) | ((unsigned)(ib & 255) << 8) | ((unsigned)(ic & 255) << 16) | ((unsigned)id << 24);
}
__device__ __forceinline__ i32x8 cat8(bf16x8 a, bf16x8 b) { const i32x4 x = __builtin_bit_cast(i32x4, a), y = __builtin_bit_cast(i32x4, b); return __builtin_shufflevector(x, y, 0, 1, 2, 3, 4, 5, 6, 7); }
__device__ __forceinline__ float bf2f(bf16_t b) { return __uint_as_float(((unsigned)b) << 16); }
__device__ __forceinline__ float bflo(unsigned w) { return __uint_as_float(w << 16); }
__device__ __forceinline__ float bfhi(unsigned w) { return __uint_as_float(w & 0xffff0000u); }
__device__ __forceinline__ float wave_sum(float v) {
#pragma unroll
    for (int o = 32; o >= 1; o >>= 1) v += __shfl_xor(v, o);
    return v;
}

#define XB_TMO      128
#define XB_XCNT(j)  (256  + 64 * (j))
#define XB_XSUB(j)  (1280 + 64 * (j))
#define XB_XGEN(j)  (2304 + 64 * (j))
#define XB_TOP      3328
#define XB_TOPGEN   3392
#define XCD_BAR_WORDS 3456
#define XB_SPIN_CAP (1u << 18)

__device__ __forceinline__ unsigned xb_ld(unsigned* p)              { return __hip_atomic_load(p, __ATOMIC_RELAXED, __HIP_MEMORY_SCOPE_AGENT); }
__device__ __forceinline__ unsigned xb_add(unsigned* p, unsigned v) { return __hip_atomic_fetch_add(p, v, __ATOMIC_RELAXED, __HIP_MEMORY_SCOPE_AGENT); }
__device__ __forceinline__ unsigned xb_xcc_id() { return (unsigned)__builtin_amdgcn_s_getreg((3 << 11) | 20) & 0xFu; }
#define XB_SPIN(cond, bar) do { unsigned _sp = 0; while (cond) { __builtin_amdgcn_s_sleep(1); \
    if ((++_sp & 255u) == 0u) { if (xb_ld(&(bar)[XB_TMO])) break; if (_sp > XB_SPIN_CAP) { atomicAdd(&(bar)[XB_TMO], 1u); break; } } } } while (0)

struct XcdBarrier { unsigned* bar; unsigned x; volatile LAS unsigned* st; };

__device__ __forceinline__ XcdBarrier xcd_barrier_post(unsigned* bar, volatile LAS unsigned* st) {
    XcdBarrier b; b.bar = bar; b.x = xb_xcc_id(); b.st = st;
    if (threadIdx.x == 0) (void)xb_add(&bar[XB_XCNT(b.x)], 1u);
    return b;
}
__device__ __forceinline__ void xcd_barrier_complete(unsigned* bar, unsigned x, unsigned& nloc, unsigned& nx) {
    const unsigned G = gridDim.x * gridDim.y * gridDim.z;
    unsigned sum, cnt, mine, sp = 0u;
    for (;;) {
        sum = 0u; cnt = 0u; mine = 0u;
#pragma unroll
        for (unsigned j = 0; j < 16; ++j) { const unsigned c = xb_ld(&bar[XB_XCNT(j)]); sum += c; cnt += (c > 0u) ? 1u : 0u; mine = (j == x) ? c : mine; }
        if (sum == G) break;
        __builtin_amdgcn_s_sleep(1);
        if ((++sp & 255u) == 0u) { if (xb_ld(&bar[XB_TMO])) break; if (sp > XB_SPIN_CAP) { atomicAdd(&bar[XB_TMO], 1u); break; } }
    }
    nloc = mine > 0u ? mine : 1u; nx = cnt > 0u ? cnt : 1u;
}
__device__ __forceinline__ void xcd_barrier(const XcdBarrier& b) {
    asm volatile("s_waitcnt vmcnt(0)" ::: "memory");
    __syncthreads();
    if (threadIdx.x == 0) {
        unsigned* bar = b.bar;
        __builtin_amdgcn_s_waitcnt(0);
        unsigned nloc = b.st[0], nx = b.st[1];
        if (nloc == 0u) { xcd_barrier_complete(bar, b.x, nloc, nx); b.st[0] = nloc; b.st[1] = nx; }
        const unsigned old = xb_add(&bar[XB_XSUB(b.x)], 1u);
        const unsigned gen = old / nloc;
        if (old + 1u == (gen + 1u) * nloc) {
            __builtin_amdgcn_fence(__ATOMIC_RELEASE, "agent");
            asm volatile("s_waitcnt vmcnt(0)" ::: "memory");
            const unsigned og = xb_add(&bar[XB_TOP], 1u);
            const unsigned tg = og / nx;
            if (og + 1u == (tg + 1u) * nx) xb_add(&bar[XB_TOPGEN], 1u);
            else XB_SPIN(xb_ld(&bar[XB_TOPGEN]) == tg, bar);
            __builtin_amdgcn_fence(__ATOMIC_ACQUIRE, "agent");
            xb_add(&bar[XB_XGEN(b.x)], 1u);
            asm volatile("s_waitcnt vmcnt(0)" ::: "memory");
        } else {
            XB_SPIN(xb_ld(&bar[XB_XGEN(b.x)]) == gen, bar);
            __builtin_amdgcn_fence(__ATOMIC_ACQUIRE, "agent");
            asm volatile("s_waitcnt vmcnt(0)" ::: "memory");
        }
    }
    __syncthreads();
}

namespace pg8 {
constexpr int BM = 256, BK = 64, HALF = 128, HTB = HALF * BK * 2, STAGE_BYTES = 8 * HTB, NXCD = 8;
__device__ __forceinline__ int lds_byte(int r, int c) { const int st = (r >> 4) * 2 + (c >> 5), rr = r & 15, cc = c & 31, ob = rr * 64 + cc * 2; return st * 1024 + (ob ^ (((ob >> 9) & 1) << 5)); }
__device__ __forceinline__ void stage_rc(int b, int& R, int& C) { const int st = b / 1024, sb = b % 1024, swz = sb ^ (((sb >> 9) & 1) << 5); R = (st >> 1) * 16 + swz / 64; C = (st & 1) * 32 + (swz % 64) / 2; }
__device__ __forceinline__ int perm32(int rho) { const int n = rho >> 4, i = rho & 15; return 8 * (i >> 2) + 4 * n + (i & 3); }
struct Unit { int pm, pn; };
struct StaticOrder {
    int nM, nN, nwg, G, c, WGM;
    __device__ void init(int M, int N, int G_, int c_, int wgm) { nM = M / BM; nN = N / BM; nwg = nM * nN; G = G_; c = c_; WGM = wgm; }
    __device__ bool next(int i, Unit& u) const {
        const long L = (long)i * G + c; if (L >= nwg) return false;
        int wgid = (int)L; { const int q = nwg / NXCD, r = nwg % NXCD, xcd = wgid % NXCD, off = wgid / NXCD; wgid = (xcd < r ? xcd * (q + 1) : r * (q + 1) + (xcd - r) * q) + off; }
        const int nig = WGM * nN, gid = wgid / nig, fm = gid * WGM, gsz = (nM - fm) < WGM ? (nM - fm) : WGM;
        u.pm = fm + ((wgid % nig) % gsz); u.pn = (wgid % nig) / gsz; return true;
    }
};

struct SplitOrder {
    int nM, nN, nwg, G, c, na, nb, n_nc, rank_nc, WGM; bool conv;
    __device__ void init(int M, int N, int G_, int c_, int ncg, int na_, int wgm) {
        nM = M / BM; nN = N / BM; nwg = nM * nN; G = G_; c = c_; WGM = wgm;
        if ((G & 63) != 0) ncg = 0;
        const int g = c >> 3, oct = g >> 3, gi = g & 7;
        conv = gi < ncg;
        n_nc = G - (G >> 3) * ncg;
        rank_nc = 8 * (oct * (8 - ncg) + (gi > ncg ? gi - ncg : 0)) + (c & 7);
        na = ncg ? na_ : 0x3fffffff;
        const int rem = nwg - na * G;
        nb = ncg ? na + (rem > 0 ? (rem + n_nc - 1) / n_nc : 0) : 0x3fffffff;
    }
    __device__ int conv_rank(int ncg) const { const int g = c >> 3; return 8 * ((g >> 3) * ncg + ((g & 7) < ncg ? (g & 7) : ncg)) + (c & 7); }
    __device__ bool next(int i, Unit& u) const {
        long L;
        if (i < na) L = (long)i * G + c;
        else { if (conv || i >= nb) return false; L = (long)na * G + (long)(i - na) * n_nc + rank_nc; }
        if (L >= nwg) return false;
        int wgid = (int)L; { const int q = nwg / NXCD, r = nwg % NXCD, xcd = wgid % NXCD, off = wgid / NXCD; wgid = (xcd < r ? xcd * (q + 1) : r * (q + 1) + (xcd - r) * q) + off; }
        const int nig = WGM * nN, gid = wgid / nig, fm = gid * WGM, gsz = (nM - fm) < WGM ? (nM - fm) : WGM;
        u.pm = fm + ((wgid % nig) % gsz); u.pn = (wgid % nig) / gsz; return true;
    }
};
struct SrcPlain {
    static constexpr bool SIDE = false;
    const bf16_t* A; const bf16_t* Bt; int K;
    __device__ __forceinline__ void load_map(LAS int*, int) const {}
    __device__ __forceinline__ const char* a_base(const Unit& u) const { return (const char*)A + (size_t)u.pm * BM * K * 2; }
    __device__ __forceinline__ const char* b_base(const Unit& u, const LAS int*) const { return (const char*)Bt + (size_t)u.pn * BM * K * 2; }
    __device__ __forceinline__ void a_voff(const Unit&, const int (&R)[2], const int (&C)[2], unsigned (&v)[2][2]) const {
#pragma unroll
        for (int h = 0; h < 2; ++h)
#pragma unroll
            for (int i = 0; i < 2; ++i) v[h][i] = (unsigned)((h * HALF + R[i]) * K + C[i]) * 2u;
    }
    __device__ __forceinline__ void side_issue(const Unit&, LAS int*, int, int) const {}
    __device__ __forceinline__ void a_voff_side(const Unit& u, const LAS int*, const int (&R)[2], const int (&C)[2], unsigned (&v)[2][2]) const { a_voff(u, R, C, v); }
};
struct SrcMoE {
    static constexpr bool SIDE = true;
    const bf16_t* A; const bf16_t* Bt; const int* src; const int* tile_e; int K; size_t estride;
    __device__ __forceinline__ void load_map(LAS int* lte, int nM) const { for (int i = threadIdx.x; i < nM; i += 512) lte[i] = tile_e[i]; }
    __device__ __forceinline__ const char* a_base(const Unit& u) const { return src ? (const char*)A : (const char*)A + (size_t)u.pm * BM * K * 2; }
    __device__ __forceinline__ const char* b_base(const Unit& u, const LAS int* lte) const { const int e = lte[u.pm]; return (const char*)Bt + ((size_t)e * estride + (size_t)u.pn * BM * K) * 2; }
    __device__ __forceinline__ void a_voff(const Unit& u, const int (&R)[2], const int (&C)[2], unsigned (&v)[2][2]) const {
#pragma unroll
        for (int h = 0; h < 2; ++h)
#pragma unroll
            for (int i = 0; i < 2; ++i) {
                const int r = src ? src[u.pm * BM + h * HALF + R[i]] : (h * HALF + R[i]);
                v[h][i] = (unsigned)(r * K + C[i]) * 2u; }
    }
    __device__ __forceinline__ void side_issue(const Unit& u, LAS int* tbl, int wid, int lane) const {
        if (src && wid < 4) __builtin_amdgcn_global_load_lds((const unsigned*)(src + u.pm * BM + wid * 64 + lane), (LAS unsigned*)(tbl + wid * 64), 4, 0, 0);
    }
    __device__ __forceinline__ void a_voff_side(const Unit& u, const LAS int* tbl, const int (&R)[2], const int (&C)[2], unsigned (&v)[2][2]) const {
#pragma unroll
        for (int h = 0; h < 2; ++h)
#pragma unroll
            for (int i = 0; i < 2; ++i) {
                const int r = src ? tbl[h * HALF + R[i]] : (h * HALF + R[i]);
                v[h][i] = (unsigned)(r * K + C[i]) * 2u; }
    }
};

template <int MODE, class Epi, class Sched, class Src>
__device__ __forceinline__ void gemm_phase(LAS unsigned char* lds, const int K, const Sched& S, const Src& X, const Epi& E) {
    const int tid = threadIdx.x, wid = __builtin_amdgcn_readfirstlane(tid >> 6), lane = tid & 63, wr = wid >> 2, wc = wid & 3, fr = lane & 15, fq = lane >> 4;
    const int nt = K / BK;
    int Rr[2], Cc[2]; unsigned voffB[2];
#pragma unroll
    for (int i = 0; i < 2; ++i) { int R, C; stage_rc(tid * 16 + i * 8192, R, C); Rr[i] = R; Cc[i] = C; const int Rb = Epi::PERM ? ((R & ~31) + perm32(R & 31)) : R; voffB[i] = (unsigned)(Rb * K + C) * 2u; }
    const size_t kstep = (size_t)(BK * 2);
    const size_t hstep = (size_t)HALF * K * 2;
    const unsigned ldsw = (unsigned)wid * 1024u;
    const int aoff = lds_byte(wr * 64 + fr, fq * 8), boff = lds_byte(wc * 32 + fr, fq * 8);
#define PG8_SA(b, h) (((b) * 2 + (h)) * HTB)
#define PG8_SB(b, h) ((4 + (b) * 2 + (h)) * HTB)
#define PG8_STAGE(bufoff, gbase, voff) do { _Pragma("unroll") for (int _i = 0; _i < 2; ++_i) \
        __builtin_amdgcn_global_load_lds((const unsigned*)((const char*)(gbase) + (voff)[_i]), (LAS unsigned*)(lds + (bufoff) + ldsw + _i * 8192), 16, 0, 0); } while (0)
#define PG8_LDA(dst, b, h) do { _Pragma("unroll") for (int m = 0; m < 4; ++m) _Pragma("unroll") for (int k = 0; k < 2; ++k) dst[m][k] = *(const LAS bf16x8*)(lds + PG8_SA(b, h) + aoff + m * 2048 + k * 1024); } while (0)
#define PG8_LDB(dst, b, h) do { _Pragma("unroll") for (int n = 0; n < 2; ++n) _Pragma("unroll") for (int k = 0; k < 2; ++k) dst[n][k] = *(const LAS bf16x8*)(lds + PG8_SB(b, h) + boff + n * 2048 + k * 1024); } while (0)
#define PG8_MMA(ai, bj, At, Bt) do { __builtin_amdgcn_s_setprio(1); if constexpr (MODE == 2) { \
        _Pragma("unroll") for (int m = 0; m < 4; ++m) _Pragma("unroll") for (int n = 0; n < 2; ++n) _Pragma("unroll") for (int k = 0; k < 2; ++k) \
        acc[ai][bj][m][n] = __builtin_bit_cast(f32x4, __builtin_amdgcn_mfma_i32_16x16x64_i8(__builtin_bit_cast(i32x4, Bt[n][k]), __builtin_bit_cast(i32x4, At[m][k]), __builtin_bit_cast(i32x4, acc[ai][bj][m][n]), 0, 0, 0)); \
        } else if constexpr (MODE == 1) { _Pragma("unroll") for (int m = 0; m < 4; ++m) _Pragma("unroll") for (int n = 0; n < 2; ++n) \
        asm volatile("v_mfma_f32_16x16x128_f8f6f4 %0, %1, %2, %0" : "+v"(acc[ai][bj][m][n]) : "v"(cat8(Bt[n][0], Bt[n][1])), "v"(cat8(At[m][0], At[m][1]))); } else { \
        _Pragma("unroll") for (int m = 0; m < 4; ++m) _Pragma("unroll") for (int n = 0; n < 2; ++n) _Pragma("unroll") for (int k = 0; k < 2; ++k) \
        acc[ai][bj][m][n] = __builtin_amdgcn_mfma_f32_16x16x32_bf16(Bt[n][k], At[m][k], acc[ai][bj][m][n], 0, 0, 0); } __builtin_amdgcn_s_setprio(0); } while (0)
#define PG8_WAIT_V(n) asm volatile("s_waitcnt vmcnt(" #n ")" ::: "memory")
#define PG8_WAIT_L(n) asm volatile("s_waitcnt lgkmcnt(" #n ")" ::: "memory")
#define PG8_BAR __builtin_amdgcn_s_barrier()
#define PG8_SCHED __builtin_amdgcn_sched_barrier(0)
    Unit cur, nxt; int ui = 0;
    if (!S.next(0, cur)) return;
    f32x4 acc[2][2][4][2];
#pragma unroll
    for (int a = 0; a < 2; ++a)
#pragma unroll
        for (int b = 0; b < 2; ++b)
#pragma unroll
            for (int m = 0; m < 4; ++m)
#pragma unroll
                for (int n = 0; n < 2; ++n) acc[a][b][m][n] = (f32x4){0.f, 0.f, 0.f, 0.f};
    bf16x8 At[4][2], B0[2][2], B1[2][2];
    unsigned vA[2][2], nvA[2][2];
    LAS unsigned char* side = lds + STAGE_BYTES;
    LAS int* lte = (LAS int*)(side + 5120);
#define PG8_TSRC(sl) ((LAS int*)(side + (sl) * 1024))
#define PG8_TBIAS(sl) ((LAS float*)(side + 2048 + (sl) * 1024))
    if constexpr (Src::SIDE) { X.load_map(lte, S.nM); __syncthreads(); }
    X.a_voff(cur, Rr, Cc, vA);
    E.side_issue(cur, PG8_TBIAS(0), lte, wid, lane);
    const char* cA = X.a_base(cur); const char* cB = X.b_base(cur, lte);
    PG8_STAGE(PG8_SB(0, 0), cB, voffB); PG8_STAGE(PG8_SB(0, 1), cB + hstep, voffB); PG8_STAGE(PG8_SA(0, 0), cA, vA[0]); PG8_STAGE(PG8_SA(0, 1), cA, vA[1]);
    if (wr == 1) PG8_BAR;
    PG8_WAIT_V(2); PG8_BAR;
    PG8_STAGE(PG8_SB(1, 0), cB + kstep, voffB); PG8_STAGE(PG8_SA(1, 0), cA + kstep, vA[0]); PG8_STAGE(PG8_SB(1, 1), cB + hstep + kstep, voffB);
    PG8_WAIT_V(6); PG8_BAR;
    for (;;) {
        const bool has_next = S.next(ui + 1, nxt);
        const char* nA = cA; const char* nB = cB;
#pragma unroll
        for (int h = 0; h < 2; ++h)
#pragma unroll
            for (int i = 0; i < 2; ++i) nvA[h][i] = vA[h][i];
        const int tsl = (ui + 1) & 1, bsl = (ui + 1) % 3;
        if (has_next) { nA = X.a_base(nxt); nB = X.b_base(nxt, lte); X.side_issue(nxt, PG8_TSRC(tsl), wid, lane); E.side_issue(nxt, PG8_TBIAS(bsl), lte, wid, lane); }
        for (int t = 0; t < nt; t += 2) {
            const bool last = (t == nt - 2);
            const char* a1 = cA + (size_t)(t + 1) * kstep;
            const char* a2 = last ? nA : cA + (size_t)(t + 2) * kstep; const char* b2 = last ? nB : cB + (size_t)(t + 2) * kstep;
            const char* a3 = a2 + kstep; const char* b3 = b2 + kstep;
            unsigned w0[2], w1[2];
            if (last && has_next) X.a_voff_side(nxt, PG8_TSRC(tsl), Rr, Cc, nvA);
            w0[0] = last ? nvA[0][0] : vA[0][0]; w0[1] = last ? nvA[0][1] : vA[0][1];
            w1[0] = last ? nvA[1][0] : vA[1][0]; w1[1] = last ? nvA[1][1] : vA[1][1];
            PG8_LDB(B0, 0, 0); PG8_LDB(B1, 0, 1); PG8_SCHED; PG8_LDA(At, 0, 0); PG8_STAGE(PG8_SA(1, 1), a1, vA[1]);
            PG8_WAIT_V(8); PG8_WAIT_L(0); PG8_BAR; PG8_MMA(0, 0, At, B0); PG8_MMA(0, 1, At, B1); PG8_BAR; PG8_SCHED;
            PG8_LDA(At, 0, 1); PG8_STAGE(PG8_SB(0, 0), b2, voffB); PG8_STAGE(PG8_SB(0, 1), b2 + hstep, voffB); PG8_STAGE(PG8_SA(0, 0), a2, w0);
            PG8_WAIT_V(8); PG8_WAIT_L(0); PG8_BAR; PG8_MMA(1, 0, At, B0); PG8_MMA(1, 1, At, B1); PG8_BAR; PG8_SCHED;
            PG8_LDB(B0, 1, 0); PG8_LDB(B1, 1, 1); PG8_SCHED; PG8_LDA(At, 1, 0); PG8_STAGE(PG8_SA(0, 1), a2, w1);
            PG8_WAIT_V(8); PG8_WAIT_L(0); PG8_BAR; PG8_MMA(0, 0, At, B0); PG8_MMA(0, 1, At, B1); PG8_BAR; PG8_SCHED;
            PG8_LDA(At, 1, 1); PG8_STAGE(PG8_SB(1, 0), b3, voffB); PG8_STAGE(PG8_SB(1, 1), b3 + hstep, voffB); PG8_STAGE(PG8_SA(1, 0), a3, w0);
            PG8_WAIT_V(8); PG8_WAIT_L(0); PG8_BAR; PG8_MMA(1, 0, At, B0); PG8_MMA(1, 1, At, B1); PG8_BAR; PG8_SCHED;
        }
        if (wr == 0) PG8_BAR;
        if constexpr (MODE == 1) asm volatile("s_nop 15\n\ts_nop 15\n\ts_nop 15" ::: "memory");
        E(acc, cur, wr, wc, fr, fq, PG8_TBIAS(ui % 3), lte);
        if (!has_next) break;
#pragma unroll
        for (int a = 0; a < 2; ++a)
#pragma unroll
            for (int b = 0; b < 2; ++b)
#pragma unroll
                for (int m = 0; m < 4; ++m)
#pragma unroll
                    for (int n = 0; n < 2; ++n) acc[a][b][m][n] = (f32x4){0.f, 0.f, 0.f, 0.f};
        cur = nxt; cA = nA; cB = nB; ++ui;
#pragma unroll
        for (int h = 0; h < 2; ++h)
#pragma unroll
            for (int i = 0; i < 2; ++i) vA[h][i] = nvA[h][i];
        if (wr == 1) PG8_BAR;
    }
    PG8_WAIT_V(0);
    PG8_BAR;
#undef PG8_TSRC
#undef PG8_TBIAS
#undef PG8_SA
#undef PG8_SB
#undef PG8_STAGE
#undef PG8_LDA
#undef PG8_LDB
#undef PG8_MMA
#undef PG8_WAIT_V
#undef PG8_WAIT_L
#undef PG8_BAR
#undef PG8_SCHED
}

struct EpiProj {
    static constexpr bool PERM = true;
    bf16_t* O; int ldc; float sc;
    __device__ __forceinline__ void side_issue(const Unit&, LAS float*, const LAS int*, int, int) const {}
    __device__ __forceinline__ void operator()(const f32x4 (&acc)[2][2][4][2], const Unit& u, int wr, int wc, int fr, int fq, const LAS float*, const LAS int*) const {
        const int row0 = u.pm * BM + wr * 64 + fr, col0 = u.pn * BM + wc * 32 + 8 * fq;
#pragma unroll
        for (int ai = 0; ai < 2; ++ai)
#pragma unroll
            for (int m = 0; m < 4; ++m) { bf16_t* rowp = O + (size_t)(row0 + ai * HALF + m * 16) * ldc + col0;
#pragma unroll
                for (int bj = 0; bj < 2; ++bj) { const f32x4 v0 = acc[ai][bj][m][0] * sc, v1 = acc[ai][bj][m][1] * sc;
                    u32x4 w; w.x = cvt_pk_bf16(v0[0], v0[1]); w.y = cvt_pk_bf16(v0[2], v0[3]); w.z = cvt_pk_bf16(v1[0], v1[1]); w.w = cvt_pk_bf16(v1[2], v1[3]);
                    *(u32x4*)(rowp + bj * HALF) = w; } }
    }
};
struct EpiProjI8 {
    static constexpr bool PERM = true;
    bf16_t* O; int ldc; const float* rs; const float* cmax;
    __device__ __forceinline__ void side_issue(const Unit&, LAS float*, const LAS int*, int, int) const {}
    __device__ __forceinline__ void operator()(const f32x4 (&acc)[2][2][4][2], const Unit& u, int wr, int wc, int fr, int fq, const LAS float*, const LAS int*) const {
        const int row0 = u.pm * BM + wr * 64 + fr, col0 = u.pn * BM + wc * 32 + 8 * fq;
        f32x4 cs[2][2];
#pragma unroll
        for (int bj = 0; bj < 2; ++bj)
#pragma unroll
            for (int n = 0; n < 2; ++n) cs[bj][n] = *(const f32x4*)(cmax + col0 + bj * HALF + n * 4) * (1.0f / 127.0f);
#pragma unroll
        for (int ai = 0; ai < 2; ++ai)
#pragma unroll
            for (int m = 0; m < 4; ++m) { const int row = row0 + ai * HALF + m * 16; bf16_t* rowp = O + (size_t)row * ldc + col0; const float r = rs[row];
#pragma unroll
                for (int bj = 0; bj < 2; ++bj) { const i32x4 a0 = __builtin_bit_cast(i32x4, acc[ai][bj][m][0]), a1 = __builtin_bit_cast(i32x4, acc[ai][bj][m][1]);
                    const f32x4 c0 = cs[bj][0] * r, c1 = cs[bj][1] * r;
                    u32x4 w; w.x = cvt_pk_bf16((float)a0[0] * c0[0], (float)a0[1] * c0[1]); w.y = cvt_pk_bf16((float)a0[2] * c0[2], (float)a0[3] * c0[3]);
                    w.z = cvt_pk_bf16((float)a1[0] * c1[0], (float)a1[1] * c1[1]); w.w = cvt_pk_bf16((float)a1[2] * c1[2], (float)a1[3] * c1[3]);
                    *(u32x4*)(rowp + bj * HALF) = w; } }
    }
};
struct EpiResid {
    static constexpr bool PERM = false;
    const float* x; bf16_t* x1; const float* gate; float sc;
    __device__ __forceinline__ void side_issue(const Unit&, LAS float*, const LAS int*, int, int) const {}
    __device__ __forceinline__ void operator()(const f32x4 (&acc)[2][2][4][2], const Unit& u, int wr, int wc, int fr, int fq, const LAS float*, const LAS int*) const {
        const int row0 = u.pm * BM + wr * 64 + fr, col0 = u.pn * BM + wc * 32 + 4 * fq;
        const float* gp = gate + ((u.pm * BM) >> 13) * 12288 + col0;
        f32x4 gv[2][2];
#pragma unroll
        for (int bj = 0; bj < 2; ++bj)
#pragma unroll
            for (int n = 0; n < 2; ++n) gv[bj][n] = *(const f32x4*)(gp + bj * HALF + n * 16) * sc;
#pragma unroll
        for (int ai = 0; ai < 2; ++ai) {
            f32x4 xs[4][2][2];
#pragma unroll
            for (int m = 0; m < 4; ++m) { const size_t off = (size_t)(row0 + ai * HALF + m * 16) * 2048 + col0;
#pragma unroll
                for (int bj = 0; bj < 2; ++bj)
#pragma unroll
                    for (int n = 0; n < 2; ++n) xs[m][bj][n] = *(const f32x4*)(x + off + bj * HALF + n * 16); }
#pragma unroll
            for (int m = 0; m < 4; ++m) { const size_t off = (size_t)(row0 + ai * HALF + m * 16) * 2048 + col0;
#pragma unroll
                for (int bj = 0; bj < 2; ++bj)
#pragma unroll
                    for (int n = 0; n < 2; ++n) { const f32x4 r = xs[m][bj][n] + gv[bj][n] * acc[ai][bj][m][n];
                        u32x2 w; w.x = cvt_pk_bf16(r[0], r[1]); w.y = cvt_pk_bf16(r[2], r[3]); *(u32x2*)(x1 + off + bj * HALF + n * 16) = w; } }
            asm volatile("" ::: "memory"); }
    }
};
struct EpiResidI8 {
    static constexpr bool PERM = false;
    const float* x; bf16_t* x1; const float* gate; const float* rs; const float* cmax;
    __device__ __forceinline__ void side_issue(const Unit&, LAS float*, const LAS int*, int, int) const {}
    __device__ __forceinline__ void operator()(const f32x4 (&acc)[2][2][4][2], const Unit& u, int wr, int wc, int fr, int fq, const LAS float*, const LAS int*) const {
        const int row0 = u.pm * BM + wr * 64 + fr, col0 = u.pn * BM + wc * 32 + 4 * fq;
        const float* gp = gate + ((u.pm * BM) >> 13) * 12288 + col0;
        f32x4 gv[2][2];
#pragma unroll
        for (int bj = 0; bj < 2; ++bj)
#pragma unroll
            for (int n = 0; n < 2; ++n) gv[bj][n] = *(const f32x4*)(gp + bj * HALF + n * 16) * *(const f32x4*)(cmax + col0 + bj * HALF + n * 16) * (1.0f / 127.0f);
#pragma unroll
        for (int ai = 0; ai < 2; ++ai) {
            f32x4 xs[4][2][2]; float rr[4];
#pragma unroll
            for (int m = 0; m < 4; ++m) { const size_t off = (size_t)(row0 + ai * HALF + m * 16) * 2048 + col0; rr[m] = rs[row0 + ai * HALF + m * 16];
#pragma unroll
                for (int bj = 0; bj < 2; ++bj)
#pragma unroll
                    for (int n = 0; n < 2; ++n) xs[m][bj][n] = *(const f32x4*)(x + off + bj * HALF + n * 16); }
#pragma unroll
            for (int m = 0; m < 4; ++m) { const size_t off = (size_t)(row0 + ai * HALF + m * 16) * 2048 + col0;
#pragma unroll
                for (int bj = 0; bj < 2; ++bj)
#pragma unroll
                    for (int n = 0; n < 2; ++n) { const i32x4 a = __builtin_bit_cast(i32x4, acc[ai][bj][m][n]); const f32x4 g = gv[bj][n] * rr[m];
                        const f32x4 r = xs[m][bj][n] + g * (f32x4){(float)a[0], (float)a[1], (float)a[2], (float)a[3]};
                        u32x2 w; w.x = cvt_pk_bf16(r[0], r[1]); w.y = cvt_pk_bf16(r[2], r[3]); *(u32x2*)(x1 + off + bj * HALF + n * 16) = w; } }
            asm volatile("" ::: "memory"); }
    }
};
struct EpiGlu {
    static constexpr bool PERM = true;
    unsigned char* O; const float* b_gu;
    __device__ __forceinline__ void side_issue(const Unit& u, LAS float* bt, const LAS int* lte, int wid, int lane) const {
        if (wid >= 4) { const int w4 = wid - 4, e = lte[u.pm];
            __builtin_amdgcn_global_load_lds((const unsigned*)(b_gu + (size_t)e * 4096 + (w4 >> 1) * 2048 + u.pn * HALF + (w4 & 1) * 64 + lane), (LAS unsigned*)(bt + w4 * 64), 4, 0, 0); }
    }
    __device__ __forceinline__ void operator()(const f32x4 (&acc)[2][2][4][2], const Unit& u, int wr, int wc, int fr, int fq, const LAS float* bt, const LAS int*) const {
        const int row0 = u.pm * BM + wr * 64 + fr, col0 = u.pn * HALF + wc * 32 + 8 * fq;
        f32x2 bg4[2][2], bl1[2][2];
#pragma unroll
        for (int n = 0; n < 2; ++n) { const f32x4 g = *(const LAS f32x4*)(bt + wc * 32 + 8 * fq + 4 * n), l = *(const LAS f32x4*)(bt + HALF + wc * 32 + 8 * fq + 4 * n);
            bg4[n][0] = (f32x2){4.0f * g[0], 4.0f * g[1]}; bg4[n][1] = (f32x2){4.0f * g[2], 4.0f * g[3]}; bl1[n][0] = (f32x2){l[0] + 1.0f, l[1] + 1.0f}; bl1[n][1] = (f32x2){l[2] + 1.0f, l[3] + 1.0f}; }
#pragma unroll
        for (int ai = 0; ai < 2; ++ai)
#pragma unroll
            for (int m = 0; m < 4; ++m) { unsigned char* rowp = O + (size_t)(row0 + ai * HALF + m * 16) * 2048 + col0;
                f32x2 r[4];
#pragma unroll
                for (int n = 0; n < 2; ++n)
#pragma unroll
                    for (int hp = 0; hp < 2; ++hp) {
                        const f32x2 ga = (f32x2){acc[ai][0][m][n][2 * hp], acc[ai][0][m][n][2 * hp + 1]}, la = (f32x2){acc[ai][1][m][n][2 * hp], acc[ai][1][m][n][2 * hp + 1]};
                        f32x2 g4 = ga * (4.0f / 64.0f) + bg4[n][hp]; g4[0] = fminf(g4[0], 28.0f); g4[1] = fminf(g4[1], 28.0f);
                        f32x2 l1 = la * (1.0f / 64.0f) + bl1[n][hp]; l1[0] = __builtin_amdgcn_fmed3f(l1[0], -6.0f, 8.0f); l1[1] = __builtin_amdgcn_fmed3f(l1[1], -6.0f, 8.0f);
                        const f32x2 z = g4 * (-1.702f * LOG2E * 0.25f);
                        f32x2 d = (f32x2){__builtin_amdgcn_exp2f(z[0]), __builtin_amdgcn_exp2f(z[1])} + 1.0f;
                        const f32x2 sg = (f32x2){__builtin_amdgcn_rcpf(d[0]), __builtin_amdgcn_rcpf(d[1])};
                        r[n * 2 + hp] = (g4 * sg) * l1; }
                u32x2 w; w.x = pack4_fp8(r[0][0], r[0][1], r[1][0], r[1][1]); w.y = pack4_fp8(r[2][0], r[2][1], r[3][0], r[3][1]);
                *(u32x2*)rowp = w; }
    }
};
struct EpiDown {
    static constexpr bool PERM = true;
    unsigned char* O; const float* b_down;
    __device__ __forceinline__ void side_issue(const Unit& u, LAS float* bt, const LAS int* lte, int wid, int lane) const {
        if (wid >= 4) { const int w4 = wid - 4, e = lte[u.pm];
            __builtin_amdgcn_global_load_lds((const unsigned*)(b_down + (size_t)e * 2048 + u.pn * BM + w4 * 64 + lane), (LAS unsigned*)(bt + w4 * 64), 4, 0, 0); }
    }
    __device__ __forceinline__ void operator()(const f32x4 (&acc)[2][2][4][2], const Unit& u, int wr, int wc, int fr, int fq, const LAS float* bt, const LAS int*) const {
        const int row0 = u.pm * BM + wr * 64 + fr, col0 = u.pn * BM + wc * 32 + 8 * fq;
        f32x4 bv[2][2];
#pragma unroll
        for (int bj = 0; bj < 2; ++bj)
#pragma unroll
            for (int n = 0; n < 2; ++n) bv[bj][n] = *(const LAS f32x4*)(bt + bj * HALF + wc * 32 + 8 * fq + 4 * n) * 16.0f;
#pragma unroll
        for (int ai = 0; ai < 2; ++ai)
#pragma unroll
            for (int m = 0; m < 4; ++m) { unsigned char* rowp = O + (size_t)(row0 + ai * HALF + m * 16) * 2048 + col0;
#pragma unroll
                for (int bj = 0; bj < 2; ++bj) { const f32x4 v0 = acc[ai][bj][m][0] * (16.0f / 256.0f) + bv[bj][0], v1 = acc[ai][bj][m][1] * (16.0f / 256.0f) + bv[bj][1];
                    u32x2 w; w.x = pack4_fp8(v0[0], v0[1], v0[2], v0[3]); w.y = pack4_fp8(v1[0], v1[1], v1[2], v1[3]);
                    *(u32x2*)(rowp + bj * HALF) = w; } }
    }
};
}

struct Frame {
    LAS unsigned char* lds; int tid, lane, wave, G, bid;
    unsigned char* ws;
};
#define WSP(T, off) ((T*)(F.ws + (off)))

struct TileInfo { const float* src; unsigned char* dst; int ld, colA, colB, f8, n0, pad_; };
__device__ __forceinline__ TileInfo conv_decode(const Params& p, const Frame& F, int i) {
    TileInfo t;
    if (i < 896) { const int kt = i / 28, nt = i % 28, r0 = nt * 256; t.colA = r0 < 3072 ? r0 : r0 + 8; t.colB = t.colA + 128; t.ld = 7176;
        t.src = p.w_in + (size_t)kt * 64 * 7176; t.f8 = IN_MODE; t.n0 = r0; t.pad_ = 0; t.dst = F.ws + WS_WIN + (IN_MODE ? (size_t)r0 * 2048 + kt * 64 : ((size_t)r0 * 2048 + kt * 64) * 2); }
    else { const int j = i - 896, kt = j / 8, nt = j % 8; t.colA = nt * 256; t.colB = t.colA + 128; t.ld = 2048;
        t.src = p.w_out + (size_t)kt * 64 * 2048; t.f8 = OUT_MODE; t.n0 = NPROJ + nt * 256; t.pad_ = 0; t.dst = F.ws + WS_WOUT + (OUT_MODE ? (size_t)nt * 256 * 2048 + kt * 64 : ((size_t)nt * 256 * 2048 + kt * 64) * 2); }
    return t;
}
constexpr int CONV_TILES = 1152;
constexpr int CONV8_TILES = 16384 + 8192;
struct Tile8 { const float* src; unsigned char* dst; int ld; };
__device__ __forceinline__ Tile8 conv8_decode(const Params& p, const Frame& F, int i) {
    Tile8 t;
    if (i < 16384) { const int e = i / 512, r = i % 512, kt = r / 32, nt = r % 32, pn = nt >> 1, half = nt & 1; t.ld = 4096;
        t.src = p.w_gu + (size_t)e * 2048 * 4096 + (size_t)kt * 128 * 4096 + half * 2048 + pn * 128; t.dst = F.ws + WS_WGU + ((size_t)e * 4096 + nt * 128) * 2048 + kt * 128; }
    else { const int j = i - 16384, e = j / 256, r = j % 256, kt = r / 16, nt = r % 16; t.ld = 2048;
        t.src = p.w_down + (size_t)e * 2048 * 2048 + (size_t)kt * 128 * 2048 + nt * 128; t.dst = F.ws + WS_WDN + ((size_t)e * 2048 + nt * 128) * 2048 + kt * 128; }
    return t;
}
__device__ __forceinline__ void conv8_load(const Tile8& t, int g, int kq, f32x4 (&L)[2][4]) {
#pragma unroll
    for (int i = 0; i < 2; ++i)
#pragma unroll
        for (int r = 0; r < 4; ++r) L[i][r] = __builtin_nontemporal_load((const f32x4*)(t.src + (size_t)(4 * (kq + 16 * i) + r) * t.ld + 4 * g));
}
__device__ __forceinline__ void conv_load(const TileInfo& t, int g, int kq, f32x4 (&L)[4][2]) {
    const int col = g < 32 ? t.colA + 4 * g : t.colB + 4 * (g - 32);
#pragma unroll
    for (int i = 0; i < 4; ++i) { const int k0 = t.f8 ? 4 * (kq + 8 * (i >> 1)) + 2 * (i & 1) : 2 * (kq + 8 * i);
        L[i][0] = *(const f32x4*)(t.src + (size_t)k0 * t.ld + col);
        L[i][1] = *(const f32x4*)(t.src + (size_t)(k0 + 1) * t.ld + col); }
}
template <int KIND>
__device__ __forceinline__ void wtile_pass(const Params& p, const Frame& F, int lo, int hi) {
    const int tid = F.tid;
    LAS unsigned* tt = (LAS unsigned*)F.lds;
    const int g = tid & 63, kq = tid >> 6;
    f32x4 cur[4][2], nxt[4][2];
    int i = lo + F.bid;
    TileInfo ti;
    if (i < hi) { ti = conv_decode(p, F, i); conv_load(ti, g, kq, cur); }
    while (i < hi) {
        const int inext = i + F.G;
        TileInfo tn = ti;
        if (inext < hi) { tn = conv_decode(p, F, inext); conv_load(tn, g, kq, nxt); }
        if constexpr (KIND == 1) {
            f32x4 m = __builtin_elementwise_max(__builtin_elementwise_abs(cur[0][0]), __builtin_elementwise_abs(cur[0][1]));
#pragma unroll
            for (int q = 1; q < 4; ++q) m = __builtin_elementwise_max(m, __builtin_elementwise_max(__builtin_elementwise_abs(cur[q][0]), __builtin_elementwise_abs(cur[q][1])));
            *(LAS f32x4*)((LAS float*)tt + kq * 256 + 4 * g) = m;
            __syncthreads();
            if (tid < 256) { float v = ((LAS float*)tt)[tid];
#pragma unroll
                for (int w = 1; w < 8; ++w) v = fmaxf(v, ((LAS float*)tt)[w * 256 + tid]);
                __hip_atomic_fetch_max((unsigned*)(F.ws + WS_CMAX) + ti.n0 + tid, __float_as_uint(v), __ATOMIC_RELAXED, __HIP_MEMORY_SCOPE_AGENT); }
        } else if (ti.f8 == 2) {
            const f32x4 cm = *(const f32x4*)((const float*)(F.ws + WS_CMAX) + ti.n0 + 4 * g);
            f32x4 inv;
#pragma unroll
            for (int j = 0; j < 4; ++j) inv[j] = cm[j] > 0.f ? 127.0f / cm[j] : 0.f;
#pragma unroll
            for (int q = 0; q < 2; ++q)
#pragma unroll
                for (int j = 0; j < 4; ++j) tt[(4 * g + j) * 17 + kq + 8 * q] = pack4_i8(inv[j] * cur[2 * q][0][j], inv[j] * cur[2 * q][1][j], inv[j] * cur[2 * q + 1][0][j], inv[j] * cur[2 * q + 1][1][j]);
            __syncthreads();
#pragma unroll
            for (int r = 0; r < 2; ++r) { const int q = tid + 512 * r, n = q >> 2, ch = q & 3;
                u32x4 v; v.x = tt[n * 17 + ch * 4 + 0]; v.y = tt[n * 17 + ch * 4 + 1]; v.z = tt[n * 17 + ch * 4 + 2]; v.w = tt[n * 17 + ch * 4 + 3];
                *(u32x4*)(ti.dst + (size_t)n * 2048 + ch * 16) = v; }
        } else if (ti.f8) {
#pragma unroll
            for (int q = 0; q < 2; ++q)
#pragma unroll
                for (int j = 0; j < 4; ++j) tt[(4 * g + j) * 17 + kq + 8 * q] = pack4_fp8(64.0f * cur[2 * q][0][j], 64.0f * cur[2 * q][1][j], 64.0f * cur[2 * q + 1][0][j], 64.0f * cur[2 * q + 1][1][j]);
            __syncthreads();
#pragma unroll
            for (int r = 0; r < 2; ++r) { const int q = tid + 512 * r, n = q >> 2, ch = q & 3;
                u32x4 v; v.x = tt[n * 17 + ch * 4 + 0]; v.y = tt[n * 17 + ch * 4 + 1]; v.z = tt[n * 17 + ch * 4 + 2]; v.w = tt[n * 17 + ch * 4 + 3];
                *(u32x4*)(ti.dst + (size_t)n * 2048 + ch * 16) = v; }
        } else {
#pragma unroll
            for (int q = 0; q < 4; ++q)
#pragma unroll
                for (int j = 0; j < 4; ++j) tt[(4 * g + j) * 33 + kq + 8 * q] = cvt_pk_bf16(cur[q][0][j], cur[q][1][j]);
            __syncthreads();
#pragma unroll
            for (int r = 0; r < 4; ++r) { const int q = tid + 512 * r, n = q >> 3, ch = q & 7;
                u32x4 v; v.x = tt[n * 33 + ch * 4 + 0]; v.y = tt[n * 33 + ch * 4 + 1]; v.z = tt[n * 33 + ch * 4 + 2]; v.w = tt[n * 33 + ch * 4 + 3];
                *(u32x4*)(ti.dst + (size_t)n * 4096 + ch * 16) = v; }
        }
        __syncthreads();
#pragma unroll
        for (int q = 0; q < 4; ++q) { cur[q][0] = nxt[q][0]; cur[q][1] = nxt[q][1]; }
        ti = tn; i = inext;
    }
}


__device__ __forceinline__ void phase0(const Params& p, const Frame& F) {
    const int tid = F.tid;
    LAS float* cs = (LAS float*)F.lds;
    LAS float* red = cs + 4096;
    for (int i = tid; i < 4096; i += 512) { const float v = p.c[i]; cs[i] = v / (1.0f + expf(-v)); }
    __syncthreads();
    float* modp = WSP(float, WS_MODP);
    for (int u = F.bid; u < 384; u += F.G) {
        const int cc = u % 48, dc = u / 48, w = F.wave, lane = F.lane;
        const int d0 = dc * 256 + w * 32;
        const float* wp = p.w_ada + (size_t)d0 * 12288 + cc * 256 + lane * 4;
        f32x4 a0 = {0.f, 0.f, 0.f, 0.f}, a1 = {0.f, 0.f, 0.f, 0.f};
#pragma unroll 8
        for (int i = 0; i < 32; ++i) { const f32x4 v = *(const f32x4*)(wp + (size_t)i * 12288); const float c0 = cs[d0 + i], c1 = cs[2048 + d0 + i]; a0 += v * c0; a1 += v * c1; }
        *(LAS f32x4*)(red + (w * 2 + 0) * 256 + lane * 4) = a0;
        *(LAS f32x4*)(red + (w * 2 + 1) * 256 + lane * 4) = a1;
        __syncthreads();
        { const int b = tid >> 8, col = tid & 255; float s = 0.f;
#pragma unroll
          for (int w8 = 0; w8 < 8; ++w8) s += red[(w8 * 2 + b) * 256 + col];
          modp[(dc * 2 + b) * 12288 + cc * 256 + col] = s; }
        __syncthreads();
    }
#if IN_MODE == 2 && OUT_MODE == 2
    wtile_pass<1>(p, F, 0, CONV_TILES);
#elif IN_MODE == 2
    wtile_pass<1>(p, F, 0, 896);
    wtile_pass<0>(p, F, 896, CONV_TILES);
#else
    wtile_pass<0>(p, F, 0, CONV_TILES);
#endif
}

__device__ __forceinline__ void conv8_range(const Params& p, const Frame& F, int first, int stride) {
    const int tid = F.tid;
    LAS unsigned* tt = (LAS unsigned*)F.lds;
    const int g8 = tid & 31, kq8 = tid >> 5;
    f32x4 r0[2][4], r1[2][4], r2[2][4], r3[2][4], r4[2][4]; Tile8 t0, t1, t2, t3, t4;
#define C8_PROCESS(R, T) do { \
        _Pragma("unroll") for (int q = 0; q < 2; ++q) _Pragma("unroll") for (int j = 0; j < 4; ++j) \
            tt[(4 * g8 + j) * 33 + kq8 + 16 * q] = pack4_fp8(64.0f * R[q][0][j], 64.0f * R[q][1][j], 64.0f * R[q][2][j], 64.0f * R[q][3][j]); \
        __syncthreads(); \
        _Pragma("unroll") for (int r = 0; r < 2; ++r) { const int q = tid + 512 * r, n = q >> 3, ch = q & 7; \
            u32x4 v; v.x = tt[n * 33 + ch * 4 + 0]; v.y = tt[n * 33 + ch * 4 + 1]; v.z = tt[n * 33 + ch * 4 + 2]; v.w = tt[n * 33 + ch * 4 + 3]; \
            __builtin_nontemporal_store(v, (u32x4*)(T.dst + (size_t)n * 2048 + ch * 16)); } \
        __syncthreads(); } while (0)
#define C8_FETCH(R, T, idx) do { if ((idx) < CONV8_TILES) { T = conv8_decode(p, F, (idx)); conv8_load(T, g8, kq8, R); } } while (0)
    int i = first;
    C8_FETCH(r0, t0, i); C8_FETCH(r1, t1, i + stride); C8_FETCH(r2, t2, i + 2 * stride); C8_FETCH(r3, t3, i + 3 * stride);
    for (;;) {
        if (i >= CONV8_TILES) break;
        C8_FETCH(r4, t4, i + 4 * stride); C8_PROCESS(r0, t0); i += stride;
        if (i >= CONV8_TILES) break;
        C8_FETCH(r0, t0, i + 4 * stride); C8_PROCESS(r1, t1); i += stride;
        if (i >= CONV8_TILES) break;
        C8_FETCH(r1, t1, i + 4 * stride); C8_PROCESS(r2, t2); i += stride;
        if (i >= CONV8_TILES) break;
        C8_FETCH(r2, t2, i + 4 * stride); C8_PROCESS(r3, t3); i += stride;
        if (i >= CONV8_TILES) break;
        C8_FETCH(r3, t3, i + 4 * stride); C8_PROCESS(r4, t4); i += stride;
    }
#undef C8_FETCH
#undef C8_PROCESS
}

__device__ __forceinline__ void phase1(const Params& p, const Frame& F) {
    const int tid = F.tid, lane = F.lane;
    LAS float* wfT = (LAS float*)F.lds;
    LAS float* a1 = wfT + 8 * 2048;
    LAS float* s1 = a1 + 4096;
    const float* modp = WSP(float, WS_MODP);
    for (int q = tid; q < 4096; q += 512) { const int d = q >> 1, hf = q & 1; const f32x4 v = *(const f32x4*)(p.w_in + (size_t)d * 7176 + 3072 + hf * 4);
#pragma unroll
        for (int j = 0; j < 4; ++j) wfT[(hf * 4 + j) * 2048 + d] = v[j]; }
    for (int q = tid; q < 8192; q += 512) { const int b = q >> 12, r = q & 4095; float s = p.b_ada[r];
#pragma unroll
        for (int dc = 0; dc < 8; ++dc) s += modp[(dc * 2 + b) * 12288 + r];
        if (r < 2048) s1[b * 2048 + r] = s; else a1[b * 2048 + (r - 2048)] = p.g1[r - 2048] * (1.0f + s); }
    float* mod = WSP(float, WS_MOD);
    for (int q = F.bid * 512 + tid; q < 24576; q += F.G * 512) { const int b = q / 12288, r = q % 12288; float s = p.b_ada[r];
#pragma unroll
        for (int dc = 0; dc < 8; ++dc) s += modp[(dc * 2 + b) * 12288 + r];
        mod[q] = s; }
    __syncthreads();
    bf16_t* H1 = WSP(bf16_t, WS_H1); float* LOGF = WSP(float, WS_LOGF);
    for (int t = F.bid * 8 + F.wave; t < T_; t += F.G * 8) {
        asm volatile("" ::: "memory");
        const int b = t >> 13;
        const float* xr = p.x + (size_t)t * 2048;
        f32x4 v[8]; float ss = 0.f;
#pragma unroll
        for (int i = 0; i < 8; ++i) { v[i] = *(const f32x4*)(xr + (i * 64 + lane) * 4); ss += v[i][0] * v[i][0] + v[i][1] * v[i][1] + v[i][2] * v[i][2] + v[i][3] * v[i][3]; }
        ss = wave_sum(ss);
        const float rstd = rsqrtf(ss * (1.0f / 2048.0f) + EPS);
        float acc[8];
#pragma unroll
        for (int j = 0; j < 8; ++j) acc[j] = 0.f;
#if IN_MODE == 2
        float amax = 0.f;
#pragma unroll
        for (int i = 0; i < 8; ++i) { const int d = (i * 64 + lane) * 4;
            const f32x4 a = *(const LAS f32x4*)(a1 + b * 2048 + d), s = *(const LAS f32x4*)(s1 + b * 2048 + d);
            const f32x4 h = v[i] * rstd * a + s;
            amax = fmaxf(fmaxf(amax, fmaxf(fabsf(h[0]), fabsf(h[1]))), fmaxf(fabsf(h[2]), fabsf(h[3]))); }
#pragma unroll
        for (int o = 32; o > 0; o >>= 1) amax = fmaxf(amax, __shfl_xor(amax, o));
        const float qinv = amax > 0.f ? 127.0f / amax : 0.f;
        if (lane == 0) WSP(float, WS_RS)[t] = amax * (1.0f / 127.0f);
        asm volatile("" ::: "memory");
#pragma unroll
        for (int i = 0; i < 8; ++i) { const int d = (i * 64 + lane) * 4;
            const f32x4 a = *(const LAS f32x4*)(a1 + b * 2048 + d), s = *(const LAS f32x4*)(s1 + b * 2048 + d);
            const f32x4 h = v[i] * rstd * a + s;
            *(unsigned*)((unsigned char*)H1 + (size_t)t * 2048 + d) = pack4_i8(qinv * h[0], qinv * h[1], qinv * h[2], qinv * h[3]);
#pragma unroll
            for (int j = 0; j < 8; ++j) { const f32x4 wv = *(const LAS f32x4*)(wfT + j * 2048 + d); acc[j] += h[0] * wv[0] + h[1] * wv[1] + h[2] * wv[2] + h[3] * wv[3]; } }
#else
#pragma unroll
        for (int i = 0; i < 8; ++i) { const int d = (i * 64 + lane) * 4;
            const f32x4 a = *(const LAS f32x4*)(a1 + b * 2048 + d), s = *(const LAS f32x4*)(s1 + b * 2048 + d);
            const f32x4 h = v[i] * rstd * a + s;
#if IN_MODE == 1
            *(unsigned*)((unsigned char*)H1 + (size_t)t * 2048 + d) = pack4_fp8(4.0f * h[0], 4.0f * h[1], 4.0f * h[2], 4.0f * h[3]);
#else
            u32x2 w; w.x = cvt_pk_bf16(h[0], h[1]); w.y = cvt_pk_bf16(h[2], h[3]);
            *(u32x2*)(H1 + (size_t)t * 2048 + d) = w;
#endif
#pragma unroll
            for (int j = 0; j < 8; ++j) { const f32x4 wv = *(const LAS f32x4*)(wfT + j * 2048 + d); acc[j] += h[0] * wv[0] + h[1] * wv[1] + h[2] * wv[2] + h[3] * wv[3]; } }
#endif
        float z = 0.f;
#pragma unroll
        for (int j = 0; j < 8; ++j) { const float r = wave_sum(acc[j]); if (lane == j) z = r; }
        if (lane < 8) { z += p.b_fgate[lane]; LOGF[(size_t)t * 8 + lane] = fminf(z, 0.f) - log1pf(expf(-fabsf(z))); }
    }
}

__device__ __forceinline__ void cum_scan(const Frame& F) {
    const int tid = F.tid;
    LAS float* sc = (LAS float*)F.lds;
    const float* LOGF = WSP(float, WS_LOGF); float* CUM = WSP(float, WS_CUM);
    for (int seq = F.bid; seq < 16; seq += F.G) { const int b = seq >> 3, h = seq & 7;
        float v[16]; float run = 0.f; const size_t base = (size_t)b * S_ + tid * 16;
#pragma unroll
        for (int i = 0; i < 16; ++i) { run += LOGF[(base + i) * 8 + h]; v[i] = run; }
        sc[tid] = run; __syncthreads();
        for (int off = 1; off < 512; off <<= 1) { const float tv = tid >= off ? sc[tid - off] : 0.f; __syncthreads(); sc[tid] += tv; __syncthreads(); }
        const float excl = tid ? sc[tid - 1] : 0.f;
#pragma unroll
        for (int i = 0; i < 16; ++i) CUM[(size_t)seq * S_ + tid * 16 + i] = excl + v[i];
        __syncthreads();
    }
}

constexpr int AT_KS = 288;
__device__ __forceinline__ void attn_unit(const Frame& F, int bh, int qb) {
    const int tid = F.tid, lane = F.lane, w = F.wave, fr = lane & 15, fq = lane >> 4;
    const int b = bh >> 3, h = bh & 7;
    const bf16_t* proj = WSP(bf16_t, WS_PROJ) + (size_t)b * S_ * NPROJ + h * 128;
    const bf16_t* Qp = proj + C_FQ; const bf16_t* Kp = proj + C_FK; const bf16_t* Vp = proj + C_FV;
    const float* cum = WSP(float, WS_CUM) + (size_t)bh * S_;
    LAS unsigned char* Kt = F.lds;
    LAS unsigned char* Vt = F.lds + 2 * 64 * AT_KS;
    LAS float* cs = (LAS float*)(F.lds + 4 * 64 * AT_KS);
    const int r0 = qb * 128 + w * 16;
    const int qpos = r0 + fr;
    bf16x8 qf[4];
#pragma unroll
    for (int ks = 0; ks < 4; ++ks) qf[ks] = *(const bf16x8*)(Qp + (size_t)qpos * NPROJ + ks * 32 + fq * 8);
    const float cq = cum[qpos] * LOG2E;
    const int ntiles = 2 * qb + 2;
    const float SC2 = 0.08838834764831845f * LOG2E;
    LAS float* wmax = cs + 128;
    LAS int* shi = (LAS int*)(cs + 136);
    float qn = 0.f, sdiag = 0.f;
    {
#pragma unroll
      for (int ks = 0; ks < 4; ++ks) { const u32x4 v = __builtin_bit_cast(u32x4, qf[ks]); const u32x4 kk = *(const u32x4*)(Kp + (size_t)qpos * NPROJ + ks * 32 + fq * 8);
          const float q0 = bflo(v.x), q1 = bfhi(v.x), q2 = bflo(v.y), q3 = bfhi(v.y), q4 = bflo(v.z), q5 = bfhi(v.z), q6 = bflo(v.w), q7 = bfhi(v.w);
          qn += q0 * q0 + q1 * q1 + q2 * q2 + q3 * q3 + q4 * q4 + q5 * q5 + q6 * q6 + q7 * q7;
          sdiag += q0 * bflo(kk.x) + q1 * bfhi(kk.x) + q2 * bflo(kk.y) + q3 * bfhi(kk.y) + q4 * bflo(kk.z) + q5 * bfhi(kk.z) + q6 * bflo(kk.w) + q7 * bfhi(kk.w); }
      qn += __shfl_xor(qn, 16); qn += __shfl_xor(qn, 32); sdiag += __shfl_xor(sdiag, 16); sdiag += __shfl_xor(sdiag, 32);
      if (tid < 2) shi[tid] = 0; }
    __syncthreads();
    float ce = 0.f;
    if (tid < ntiles) { const float kv = WSP(float, WS_KN)[bh * 128 + tid]; ce = cum[(tid + 1) * 64 - 1] * LOG2E; atomicMax((int*)(shi + 0), __float_as_int(kv)); }
    __syncthreads();
    { float rt = SC2 * sqrtf(qn) * sqrtf(__int_as_float(shi[0])) * 1.001f + cq - SC2 * sdiag;
#pragma unroll
      for (int o = 8; o >= 1; o >>= 1) rt = fmaxf(rt, __shfl_xor(rt, o));
      if (lane == 0) wmax[w] = rt; }
    __syncthreads();
    { float rmax = wmax[0];
#pragma unroll
      for (int i = 1; i < 8; ++i) rmax = fmaxf(rmax, wmax[i]);
      const float bound = rmax - ce + 0.02f;
      if (tid < 2 * qb && bound < -40.0f) atomicMax((int*)(shi + 1), tid + 1); }
    __syncthreads();
    const int j_lo = shi[1];
    float m = -1e30f, l = 0.f;
    f32x4 oT[8];
#pragma unroll
    for (int n = 0; n < 8; ++n) oT[n] = (f32x4){0.f, 0.f, 0.f, 0.f};
    const int skey = tid >> 3, sc16 = (tid & 7) * 16;
    u32x4 kA0, kA1, vA0, vA1, kB0, kB1, vB0, vB1; float cA = 0.f, cB = 0.f;
#define AT_LOAD(S_, j) do { const size_t ro = (size_t)((j) * 64 + skey) * NPROJ + sc16; \
        k##S_##0 = *(const u32x4*)(Kp + ro); k##S_##1 = *(const u32x4*)(Kp + ro + 8); v##S_##0 = *(const u32x4*)(Vp + ro); v##S_##1 = *(const u32x4*)(Vp + ro + 8); \
        if (tid < 64) c##S_ = cum[(j) * 64 + tid]; } while (0)
#define AT_WRITE(S_, buf) do { LAS unsigned char* kd = Kt + (buf) * 64 * AT_KS + skey * AT_KS + sc16 * 2; LAS unsigned char* vd = Vt + (buf) * 64 * AT_KS + skey * AT_KS + sc16 * 2; \
        *(LAS u32x4*)kd = k##S_##0; *(LAS u32x4*)(kd + 16) = k##S_##1; *(LAS u32x4*)vd = v##S_##0; *(LAS u32x4*)(vd + 16) = v##S_##1; if (tid < 64) cs[(buf) * 64 + tid] = c##S_ * LOG2E; } while (0)
#define AT_COMPUTE(j, buf) do { \
        const LAS unsigned char* kb = Kt + (buf) * 64 * AT_KS; \
        f32x4 st[4]; \
        _Pragma("unroll") for (int kt = 0; kt < 4; ++kt) { st[kt] = (f32x4){0.f, 0.f, 0.f, 0.f}; \
            _Pragma("unroll") for (int ks = 0; ks < 4; ++ks) { const bf16x8 a = *(const LAS bf16x8*)(kb + (kt * 16 + fr) * AT_KS + (ks * 32 + fq * 8) * 2); \
                st[kt] = __builtin_amdgcn_mfma_f32_16x16x32_bf16(a, qf[ks], st[kt], 0, 0, 0); } } \
        const int kbase = (j) * 64; \
        const bool diag = (kbase + 63 > r0); \
        float mx = -1e30f; \
        if (diag) {     \
            _Pragma("unroll") for (int kt = 0; kt < 4; ++kt) { const f32x4 ck = *(const LAS f32x4*)(cs + (buf) * 64 + kt * 16 + fq * 4); \
                _Pragma("unroll") for (int i = 0; i < 4; ++i) { float s2 = st[kt][i] * SC2 + (cq - ck[i]); \
                    if (kbase + kt * 16 + fq * 4 + i > qpos) s2 = -__builtin_inff(); \
                    st[kt][i] = s2; mx = fmaxf(mx, s2); } } \
        } else { \
            _Pragma("unroll") for (int kt = 0; kt < 4; ++kt) { const f32x4 ck = *(const LAS f32x4*)(cs + (buf) * 64 + kt * 16 + fq * 4); \
                _Pragma("unroll") for (int i = 0; i < 4; ++i) { const float s2 = st[kt][i] * SC2 + (cq - ck[i]); st[kt][i] = s2; mx = fmaxf(mx, s2); } } \
        } \
        mx = fmaxf(mx, __shfl_xor(mx, 16)); mx = fmaxf(mx, __shfl_xor(mx, 32)); \
        const float mn = fmaxf(m, mx); \
        const float alpha = __builtin_amdgcn_exp2f(m - mn); \
        m = mn; \
        float ps = 0.f; \
        _Pragma("unroll") for (int kt = 0; kt < 4; ++kt) \
            _Pragma("unroll") for (int i = 0; i < 4; ++i) { const float pv = __builtin_amdgcn_exp2f(st[kt][i] - mn); st[kt][i] = pv; ps += pv; } \
        ps += __shfl_xor(ps, 16); ps += __shfl_xor(ps, 32); \
        l = l * alpha + ps; \
        _Pragma("unroll") for (int n = 0; n < 8; ++n) oT[n] *= alpha; \
        bf16x8 pf[2]; \
        _Pragma("unroll") for (int kk = 0; kk < 2; ++kk) { u32x4 pw; pw.x = cvt_pk_bf16(st[2 * kk][0], st[2 * kk][1]); pw.y = cvt_pk_bf16(st[2 * kk][2], st[2 * kk][3]); \
            pw.z = cvt_pk_bf16(st[2 * kk + 1][0], st[2 * kk + 1][1]); pw.w = cvt_pk_bf16(st[2 * kk + 1][2], st[2 * kk + 1][3]); pf[kk] = __builtin_bit_cast(bf16x8, pw); } \
        const unsigned vaddr = (unsigned)(uintptr_t)(Vt + (buf) * 64 * AT_KS) + (unsigned)((fq * 4 + (fr >> 2)) * AT_KS + (fr & 3) * 8); \
        s16x4 va[8][4]; \
          \
        _Pragma("unroll") for (int g2 = 0; g2 < 5; ++g2) { \
            if (g2 < 4) asm volatile("ds_read_b64_tr_b16 %0, %8 offset:%9\n\tds_read_b64_tr_b16 %1, %8 offset:%10\n\tds_read_b64_tr_b16 %2, %8 offset:%11\n\tds_read_b64_tr_b16 %3, %8 offset:%12\n\t" \
                         "ds_read_b64_tr_b16 %4, %8 offset:%13\n\tds_read_b64_tr_b16 %5, %8 offset:%14\n\tds_read_b64_tr_b16 %6, %8 offset:%15\n\tds_read_b64_tr_b16 %7, %8 offset:%16" \
                         : "=&v"(va[2 * (g2 & 3) + 0][0]), "=&v"(va[2 * (g2 & 3) + 0][1]), "=&v"(va[2 * (g2 & 3) + 0][2]), "=&v"(va[2 * (g2 & 3) + 0][3]), \
                           "=&v"(va[2 * (g2 & 3) + 1][0]), "=&v"(va[2 * (g2 & 3) + 1][1]), "=&v"(va[2 * (g2 & 3) + 1][2]), "=&v"(va[2 * (g2 & 3) + 1][3]) \
                         : "v"(vaddr), \
                           "i"((2 * (g2 & 3) + 0) * 32), "i"(16 * AT_KS + (2 * (g2 & 3) + 0) * 32), "i"(32 * AT_KS + (2 * (g2 & 3) + 0) * 32), "i"(48 * AT_KS + (2 * (g2 & 3) + 0) * 32), \
                           "i"((2 * (g2 & 3) + 1) * 32), "i"(16 * AT_KS + (2 * (g2 & 3) + 1) * 32), "i"(32 * AT_KS + (2 * (g2 & 3) + 1) * 32), "i"(48 * AT_KS + (2 * (g2 & 3) + 1) * 32) : "memory"); \
            if (g2 >= 1) { \
                if (g2 < 4) asm volatile("s_waitcnt lgkmcnt(8)" ::: "memory"); else asm volatile("s_waitcnt lgkmcnt(0)" ::: "memory"); \
                __builtin_amdgcn_sched_barrier(0);     \
                _Pragma("unroll") for (int nn = 0; nn < 2; ++nn) { const int n = 2 * (g2 - 1) + nn; \
                    const bf16x8 v0 = (bf16x8){va[n][0][0], va[n][0][1], va[n][0][2], va[n][0][3], va[n][1][0], va[n][1][1], va[n][1][2], va[n][1][3]}; \
                    const bf16x8 v1 = (bf16x8){va[n][2][0], va[n][2][1], va[n][2][2], va[n][2][3], va[n][3][0], va[n][3][1], va[n][3][2], va[n][3][3]}; \
                    oT[n] = __builtin_amdgcn_mfma_f32_16x16x32_bf16(v0, pf[0], oT[n], 0, 0, 0); \
                    oT[n] = __builtin_amdgcn_mfma_f32_16x16x32_bf16(v1, pf[1], oT[n], 0, 0, 0); } } } \
    } while (0)
    AT_LOAD(A, j_lo); AT_WRITE(A, 0);
    if (j_lo + 1 < ntiles) AT_LOAD(B, j_lo + 1);
    __syncthreads();
    for (int j = j_lo; j < ntiles; j += 2) {
        {
            if (j + 2 < ntiles) AT_LOAD(A, j + 2);
            AT_COMPUTE(j, 0);
            if (j + 1 < ntiles) AT_WRITE(B, 1);
            __syncthreads();
        }
        if (j + 1 < ntiles) {
            if (j + 3 < ntiles) AT_LOAD(B, j + 3);
            AT_COMPUTE(j + 1, 1);
            if (j + 2 < ntiles) AT_WRITE(A, 0);
            __syncthreads();
        }
    }
#undef AT_LOAD
#undef AT_WRITE
#undef AT_COMPUTE
    const float rl = 1.0f / l;
    float ssq = 0.f;
    bf16_t* orow = WSP(bf16_t, WS_MIXED) + ((size_t)b * S_ + qpos) * 2048 + h * 128 + fq * 4;
#pragma unroll
    for (int n = 0; n < 8; ++n) { const f32x4 o = oT[n] * rl; ssq += o[0] * o[0] + o[1] * o[1] + o[2] * o[2] + o[3] * o[3];
        u32x2 wv; wv.x = cvt_pk_bf16(o[0], o[1]); wv.y = cvt_pk_bf16(o[2], o[3]); *(u32x2*)(orow + n * 16) = wv; }
    ssq += __shfl_xor(ssq, 16); ssq += __shfl_xor(ssq, 32);
    if (fq == 0) WSP(float, WS_SSQ)[((size_t)b * S_ + qpos) * 8 + h] = ssq;
    __syncthreads();
}


__device__ __forceinline__ void knorm_pass(const Frame& F) {
    const int lane = F.lane, r = lane >> 4, c = lane & 15;
    float* KN = WSP(float, WS_KN);
    for (int u = F.bid * 8 + F.wave; u < 2048; u += F.G * 8) { const int bh = u >> 7, j = u & 127, b = bh >> 3, h = bh & 7;
        const bf16_t* kp = WSP(bf16_t, WS_PROJ) + ((size_t)b * S_ + j * 64 + r) * NPROJ + C_FK + h * 128 + c * 8;
        float mx = 0.f;
#pragma unroll
        for (int it = 0; it < 16; ++it) { const u32x4 v = *(const u32x4*)(kp + (size_t)it * 4 * NPROJ);
            float s = bflo(v.x) * bflo(v.x) + bfhi(v.x) * bfhi(v.x) + bflo(v.y) * bflo(v.y) + bfhi(v.y) * bfhi(v.y) + bflo(v.z) * bflo(v.z) + bfhi(v.z) * bfhi(v.z) + bflo(v.w) * bflo(v.w) + bfhi(v.w) * bfhi(v.w);
#pragma unroll
            for (int o = 8; o >= 1; o >>= 1) s += __shfl_xor(s, o);
            mx = fmaxf(mx, s); }
        mx = fmaxf(mx, __shfl_xor(mx, 16)); mx = fmaxf(mx, __shfl_xor(mx, 32));
        if (lane == 0) KN[u] = mx; }
}

__device__ __forceinline__ void hg_load_col(const Frame& F, int bh, int n, int colbase, unsigned short (&r)[16]) {
    const int tid = F.tid, dk = tid & 127, rq = tid >> 7, b = bh >> 3, h = bh & 7;
    const bf16_t* ptr = WSP(bf16_t, WS_PROJ) + ((size_t)b * S_ + n * 64 + rq * 16) * NPROJ + colbase + h * 128 + dk;
#pragma unroll
    for (int i = 0; i < 16; ++i) r[i] = ptr[(size_t)i * NPROJ];
}
__device__ __forceinline__ void hg_gates(const Params& p, const Frame& F, LAS float* qsum, int h, const unsigned short (&hf)[16], float (&fv)[16], float (&bc)[16], float& blast) {
    const int tid = F.tid, dk = tid & 127, rq = tid >> 7;
    const float l0 = p.lb_logits[h * 128 + dk], l1 = p.lb_logits[1024 + h * 128 + dk];
    const float lb = __builtin_amdgcn_rcpf(1.0f + __expf(l1 - l0));
    float run = 0.f;
#pragma unroll
    for (int i = 0; i < 16; ++i) { const float z = bf2f(hf[i]); const float f = lb + (1.0f - lb) * __builtin_amdgcn_rcpf(1.0f + __builtin_amdgcn_exp2f(z * -LOG2E)); fv[i] = f; run += __builtin_amdgcn_logf(f); bc[i] = run; }
    qsum[rq * 128 + dk] = run;
    __syncthreads();
    float off = 0.f, tot = 0.f;
#pragma unroll
    for (int q = 0; q < 4; ++q) { const float v = qsum[q * 128 + dk]; tot += v; if (q < rq) off += v; }
#pragma unroll
    for (int i = 0; i < 16; ++i) bc[i] += off;
    blast = tot;
}

__device__ __forceinline__ void hgu_unit(const Params& p, const Frame& F, int bh, int n, const unsigned short (&hf)[16], const unsigned short (&hi)[16]) {
    const int tid = F.tid, lane = F.lane, w = F.wave, fr = lane & 15, fq = lane >> 4;
    const int h = bh & 7, dk = tid & 127, rq = tid >> 7;
    LAS bf16_t* kT = (LAS bf16_t*)F.lds;
    LAS bf16_t* vT = kT + 128 * 72;
    LAS float* qsum = (LAS float*)(vT + 128 * 72);
    float fv[16], bc[16], blast;
    hg_gates(p, F, qsum, h, hf, fv, bc, blast);
#pragma unroll
    for (int i = 0; i < 16; i += 2) { const float k0 = (1.0f - fv[i]) * __builtin_amdgcn_exp2f(blast - bc[i]), k1 = (1.0f - fv[i + 1]) * __builtin_amdgcn_exp2f(blast - bc[i + 1]);
        *(LAS unsigned*)(kT + dk * 72 + rq * 16 + i) = cvt_pk_bf16(k0, k1); }
    if (rq == 0) WSP(float, WS_HGDEC)[((size_t)bh * 128 + n) * 128 + dk] = __builtin_amdgcn_exp2f(blast);
#pragma unroll
    for (int i = 0; i < 16; i += 2) *(LAS unsigned*)(vT + dk * 72 + rq * 16 + i) = (unsigned)hi[i] | ((unsigned)hi[i + 1] << 16);
    __syncthreads();
    f32x4 acc[8];
#pragma unroll
    for (int nt = 0; nt < 8; ++nt) acc[nt] = (f32x4){0.f, 0.f, 0.f, 0.f};
#pragma unroll
    for (int ks = 0; ks < 2; ++ks) { const bf16x8 a = *(const LAS bf16x8*)(kT + (w * 16 + fr) * 72 + ks * 32 + fq * 8);
#pragma unroll
        for (int nt = 0; nt < 8; ++nt) { const bf16x8 bv = *(const LAS bf16x8*)(vT + (nt * 16 + fr) * 72 + ks * 32 + fq * 8);
            acc[nt] = __builtin_amdgcn_mfma_f32_16x16x32_bf16(a, bv, acc[nt], 0, 0, 0); } }
    bf16_t* U = WSP(bf16_t, WS_HGU) + ((size_t)bh * 128 + n) * 16384;
#pragma unroll
    for (int nt = 0; nt < 8; ++nt) { u32x2 wv; wv.x = cvt_pk_bf16(acc[nt][0], acc[nt][1]); wv.y = cvt_pk_bf16(acc[nt][2], acc[nt][3]); *(u32x2*)(U + (size_t)(nt * 16 + fr) * 128 + w * 16 + fq * 4) = wv; }
    __syncthreads();
}

__device__ __forceinline__ void hg_scan(const Frame& F) {
    const bf16_t* U = WSP(bf16_t, WS_HGU); const float* DEC = WSP(float, WS_HGDEC); bf16_t* SP = WSP(bf16_t, WS_HGSP);
    for (int idx = F.bid * 512 + F.tid; idx < 16 * 8192; idx += F.G * 512) {
        const int bh = idx >> 13, rem = idx & 8191, dv = rem >> 6, dk2 = (rem & 63) * 2;
        const size_t e0 = (size_t)bh * 128 * 16384 + (size_t)dv * 128 + dk2;
        const size_t d0 = (size_t)bh * 128 * 128 + dk2;
        f32x2 s = {0.f, 0.f};
        for (int n0 = 0; n0 < 128; n0 += 8) {
            unsigned u[8]; f32x2 d[8];
#pragma unroll
            for (int k = 0; k < 8; ++k) { u[k] = *(const unsigned*)(U + e0 + (size_t)(n0 + k) * 16384); d[k] = *(const f32x2*)(DEC + d0 + (size_t)(n0 + k) * 128); }
#pragma unroll
            for (int k = 0; k < 8; ++k) { *(unsigned*)(SP + e0 + (size_t)(n0 + k) * 16384) = cvt_pk_bf16(s[0], s[1]); s = d[k] * s + (f32x2){bflo(u[k]), bfhi(u[k])}; }
        }
    }
}

__device__ __forceinline__ void hgo_unit(const Params& p, const Frame& F, int bh, int n, const unsigned short (&hf)[16], const unsigned short (&hq)[16], const unsigned short (&hi)[16], const u32x4 (&spr)[4]) {
    const int tid = F.tid, lane = F.lane, w = F.wave, fr = lane & 15, fq = lane >> 4;
    const int b = bh >> 3, h = bh & 7, dk = tid & 127, rq = tid >> 7;
    LAS bf16_t* qd = (LAS bf16_t*)F.lds;
    LAS bf16_t* ki = qd + 64 * 136;
    LAS bf16_t* vT = ki + 64 * 136;
    LAS bf16_t* at = vT + 128 * 72;
    LAS bf16_t* sp = at + 64 * 72;
    LAS float* qsum = (LAS float*)(sp + 128 * 136);
    LAS float* rs = qsum + 512;
    const size_t trow = (size_t)b * S_ + n * 64;
    bf16_t* fxp = WSP(bf16_t, WS_MIXED) + (trow + (tid >> 3)) * 2048 + h * 128 + (tid & 7) * 16;
    const u32x4 fx0 = *(const u32x4*)fxp, fx1 = *(const u32x4*)(fxp + 8);
    const f32x4 sq0 = *(const f32x4*)(WSP(float, WS_SSQ) + (trow + (tid >> 3)) * 8), sq1 = *(const f32x4*)(WSP(float, WS_SSQ) + (trow + (tid >> 3)) * 8 + 4);
    u32x2 gwv[4];
    { const bf16_t* hg = WSP(bf16_t, WS_PROJ) + (trow + (w & 3) * 16 + fr) * NPROJ + C_HG + h * 128;
#pragma unroll
      for (int q = 0; q < 4; ++q) gwv[q] = *(const u32x2*)(hg + ((w >> 2) * 4 + q) * 16 + fq * 4); }
    float fv[16], bc[16], blast;
    hg_gates(p, F, qsum, h, hf, fv, bc, blast);
#pragma unroll
    for (int i = 0; i < 16; ++i) { const float q = bf2f(hq[i]); const float qq = q * __builtin_amdgcn_rcpf(1.0f + __builtin_amdgcn_exp2f(q * -LOG2E));
        const float qdv = qq * __builtin_amdgcn_exp2f(bc[i]), kiv = (1.0f - fv[i]) * __builtin_amdgcn_exp2f(-bc[i]);
        qd[(rq * 16 + i) * 136 + dk] = (bf16_t)(cvt_pk_bf16(qdv, 0.f) & 0xffffu);
        ki[(rq * 16 + i) * 136 + dk] = (bf16_t)(cvt_pk_bf16(kiv, 0.f) & 0xffffu); }
#pragma unroll
    for (int i = 0; i < 16; i += 2) *(LAS unsigned*)(vT + dk * 72 + rq * 16 + i) = (unsigned)hi[i] | ((unsigned)hi[i + 1] << 16);
#pragma unroll
    for (int r = 0; r < 4; ++r) { const int q = tid + 512 * r, dv = q >> 4, ch = q & 15; *(LAS u32x4*)(sp + dv * 136 + ch * 8) = spr[r]; }
    __syncthreads();
    { const int ct = w & 3;
#pragma unroll
      for (int q = 0; q < 2; ++q) { const int st = (w >> 2) * 2 + q;
          f32x4 a = {0.f, 0.f, 0.f, 0.f};
          if (st <= ct) {
#pragma unroll
              for (int ks = 0; ks < 4; ++ks) { const bf16x8 ka = *(const LAS bf16x8*)(ki + (st * 16 + fr) * 136 + ks * 32 + fq * 8); const bf16x8 qb = *(const LAS bf16x8*)(qd + (ct * 16 + fr) * 136 + ks * 32 + fq * 8);
                  a = __builtin_amdgcn_mfma_f32_16x16x32_bf16(ka, qb, a, 0, 0, 0); } }
          const int c = ct * 16 + fr;
#pragma unroll
          for (int i = 0; i < 4; ++i) if (st * 16 + fq * 4 + i > c) a[i] = 0.f;
          u32x2 wv; wv.x = cvt_pk_bf16(a[0], a[1]); wv.y = cvt_pk_bf16(a[2], a[3]);
          *(LAS u32x2*)(at + c * 72 + st * 16 + fq * 4) = wv; } }
    __syncthreads();
    const int ct = w & 3, dh = w >> 2;
    f32x4 acc[4];
#pragma unroll
    for (int q = 0; q < 4; ++q) acc[q] = (f32x4){0.f, 0.f, 0.f, 0.f};
#pragma unroll
    for (int ks = 0; ks < 2; ++ks) { const bf16x8 bb = *(const LAS bf16x8*)(at + (ct * 16 + fr) * 72 + ks * 32 + fq * 8);
#pragma unroll
        for (int q = 0; q < 4; ++q) { const bf16x8 aa = *(const LAS bf16x8*)(vT + ((dh * 4 + q) * 16 + fr) * 72 + ks * 32 + fq * 8);
            acc[q] = __builtin_amdgcn_mfma_f32_16x16x32_bf16(aa, bb, acc[q], 0, 0, 0); } }
#pragma unroll
    for (int ks = 0; ks < 4; ++ks) { const bf16x8 bb = *(const LAS bf16x8*)(qd + (ct * 16 + fr) * 136 + ks * 32 + fq * 8);
#pragma unroll
        for (int q = 0; q < 4; ++q) { const bf16x8 aa = *(const LAS bf16x8*)(sp + ((dh * 4 + q) * 16 + fr) * 136 + ks * 32 + fq * 8);
            acc[q] = __builtin_amdgcn_mfma_f32_16x16x32_bf16(aa, bb, acc[q], 0, 0, 0); } }
    float ss = 0.f;
#pragma unroll
    for (int q = 0; q < 4; ++q) ss += acc[q][0] * acc[q][0] + acc[q][1] * acc[q][1] + acc[q][2] * acc[q][2] + acc[q][3] * acc[q][3];
    ss += __shfl_xor(ss, 16); ss += __shfl_xor(ss, 32);
    const int c = ct * 16 + fr;
    if (fq == 0) rs[c * 2 + dh] = ss;
    __syncthreads();
    const float rstd = rsqrtf((rs[c * 2] + rs[c * 2 + 1]) * (1.0f / 128.0f) + EPS);
    bf16_t* orow = WSP(bf16_t, OUT_MODE == 2 ? WS_MIXN : WS_MIXED) + (trow + c) * 2048 + 1024 + h * 128;
#pragma unroll
    for (int q = 0; q < 4; ++q) { const int dv = (dh * 4 + q) * 16 + fq * 4;
        const u32x2 gw = gwv[q]; const f32x4 gn = *(const f32x4*)(p.g_hg + h * 128 + dv);
        const float g0 = bflo(gw.x), g1 = bfhi(gw.x), g2 = bflo(gw.y), g3 = bfhi(gw.y);
        const float o0 = acc[q][0] * rstd * gn[0] * (g0 * __builtin_amdgcn_rcpf(1.0f + __expf(-g0))), o1 = acc[q][1] * rstd * gn[1] * (g1 * __builtin_amdgcn_rcpf(1.0f + __expf(-g1)));
        const float o2 = acc[q][2] * rstd * gn[2] * (g2 * __builtin_amdgcn_rcpf(1.0f + __expf(-g2))), o3 = acc[q][3] * rstd * gn[3] * (g3 * __builtin_amdgcn_rcpf(1.0f + __expf(-g3)));
#if OUT_MODE == 1
        *(unsigned*)(F.ws + WS_MIX8 + (trow + c) * 2048 + 1024 + h * 128 + dv) = pack4_fp8(4.0f * o0, 4.0f * o1, 4.0f * o2, 4.0f * o3);
#else
        u32x2 wv; wv.x = cvt_pk_bf16(o0, o1); wv.y = cvt_pk_bf16(o2, o3); *(u32x2*)(orow + dv) = wv;
#endif
    }
    { const float rstdf = rsqrtf(((sq0[0] + sq0[1]) + (sq0[2] + sq0[3]) + (sq1[0] + sq1[1]) + (sq1[2] + sq1[3])) * (1.0f / 1024.0f) + EPS);
      const float* gf = p.g_fox + h * 128 + (tid & 7) * 16;
#if OUT_MODE == 1
      const float rs4 = 4.0f * rstdf;
      const f32x4 ga = *(const f32x4*)gf * rs4, gb = *(const f32x4*)(gf + 4) * rs4, gc = *(const f32x4*)(gf + 8) * rs4, gd = *(const f32x4*)(gf + 12) * rs4;
      u32x4 ov;
      ov.x = pack4_fp8(bflo(fx0.x) * ga[0], bfhi(fx0.x) * ga[1], bflo(fx0.y) * ga[2], bfhi(fx0.y) * ga[3]); ov.y = pack4_fp8(bflo(fx0.z) * gb[0], bfhi(fx0.z) * gb[1], bflo(fx0.w) * gb[2], bfhi(fx0.w) * gb[3]);
      ov.z = pack4_fp8(bflo(fx1.x) * gc[0], bfhi(fx1.x) * gc[1], bflo(fx1.y) * gc[2], bfhi(fx1.y) * gc[3]); ov.w = pack4_fp8(bflo(fx1.z) * gd[0], bfhi(fx1.z) * gd[1], bflo(fx1.w) * gd[2], bfhi(fx1.w) * gd[3]);
      *(u32x4*)(F.ws + WS_MIX8 + (trow + (tid >> 3)) * 2048 + h * 128 + (tid & 7) * 16) = ov; }
#else
      const f32x4 ga = *(const f32x4*)gf * rstdf, gb = *(const f32x4*)(gf + 4) * rstdf, gc = *(const f32x4*)(gf + 8) * rstdf, gd = *(const f32x4*)(gf + 12) * rstdf;
      u32x4 o0v, o1v;
      o0v.x = cvt_pk_bf16(bflo(fx0.x) * ga[0], bfhi(fx0.x) * ga[1]); o0v.y = cvt_pk_bf16(bflo(fx0.y) * ga[2], bfhi(fx0.y) * ga[3]); o0v.z = cvt_pk_bf16(bflo(fx0.z) * gb[0], bfhi(fx0.z) * gb[1]); o0v.w = cvt_pk_bf16(bflo(fx0.w) * gb[2], bfhi(fx0.w) * gb[3]);
      o1v.x = cvt_pk_bf16(bflo(fx1.x) * gc[0], bfhi(fx1.x) * gc[1]); o1v.y = cvt_pk_bf16(bflo(fx1.y) * gc[2], bfhi(fx1.y) * gc[3]); o1v.z = cvt_pk_bf16(bflo(fx1.z) * gd[0], bfhi(fx1.z) * gd[1]); o1v.w = cvt_pk_bf16(bflo(fx1.w) * gd[2], bfhi(fx1.w) * gd[3]);
      bf16_t* fxo = OUT_MODE == 2 ? WSP(bf16_t, WS_MIXN) + (trow + (tid >> 3)) * 2048 + h * 128 + (tid & 7) * 16 : fxp;
      *(u32x4*)fxo = o0v; *(u32x4*)(fxo + 8) = o1v; }
#endif
    __syncthreads();
}

__device__ __forceinline__ void mix_quant(const Frame& F, int b, int n) {
    const int lane = F.lane;
    const size_t trow = (size_t)b * S_ + n * 64 + F.wave * 8;
    const bf16_t* src = WSP(bf16_t, WS_MIXN); unsigned char* dst = F.ws + WS_MIX8; float* rs = WSP(float, WS_RS2);
#pragma unroll 1
    for (int r = 0; r < 8; r += 2) {
        u32x4 v[2][4];
#pragma unroll
        for (int q = 0; q < 2; ++q)
#pragma unroll
            for (int j = 0; j < 4; ++j) v[q][j] = *(const u32x4*)(src + (trow + r + q) * 2048 + j * 512 + lane * 8);
#pragma unroll
        for (int q = 0; q < 2; ++q) {
            float am = 0.f;
#pragma unroll
            for (int j = 0; j < 4; ++j)
#pragma unroll
                for (int e = 0; e < 4; ++e) am = fmaxf(am, fmaxf(fabsf(bflo(v[q][j][e])), fabsf(bfhi(v[q][j][e]))));
#pragma unroll
            for (int o = 32; o > 0; o >>= 1) am = fmaxf(am, __shfl_xor(am, o));
            const float inv = am > 0.f ? 127.0f / am : 0.f;
#pragma unroll
            for (int j = 0; j < 4; ++j) { u32x2 o;
                o.x = pack4_i8(inv * bflo(v[q][j].x), inv * bfhi(v[q][j].x), inv * bflo(v[q][j].y), inv * bfhi(v[q][j].y));
                o.y = pack4_i8(inv * bflo(v[q][j].z), inv * bfhi(v[q][j].z), inv * bflo(v[q][j].w), inv * bfhi(v[q][j].w));
                *(u32x2*)(dst + (trow + r + q) * 2048 + j * 512 + lane * 8) = o; }
            if (lane == 0) rs[trow + r + q] = am * (1.0f / 127.0f); }
    }
}

constexpr int HS_STRIDE = 2052;
__device__ __forceinline__ void phase7(const Params& p, const Frame& F) {
    const int tid = F.tid, lane = F.lane, w = F.wave;
    LAS float* hs = (LAS float*)F.lds;
    LAS float* part = hs + 16 * HS_STRIDE;
    LAS float* lg = part + 8 * 16 * 32;
    LAS int* hist = (LAS int*)(lg + 512);
    const float* mod = WSP(float, WS_MOD); const bf16_t* X1 = WSP(bf16_t, WS_X1);
    unsigned char* H2 = F.ws + WS_H2; int* TOPI = WSP(int, WS_TOPI); float* TOPG = WSP(float, WS_TOPG); int* CNT = WSP(int, WS_CNT);
    float wreg[16][4][2];
    { const int i16 = lane & 15, kq = lane >> 4;
#pragma unroll
      for (int kb = 0; kb < 16; ++kb)
#pragma unroll
          for (int sx = 0; sx < 4; ++sx) { const float* wp = p.w_router + (size_t)(256 * w + 16 * kb + 4 * kq + sx) * 32 + i16; wreg[kb][sx][0] = wp[0]; wreg[kb][sx][1] = wp[16]; } }
    for (int chunk = F.bid; chunk < 256; chunk += F.G) {
        if (tid < 32) hist[tid] = 0;
        __syncthreads();
        for (int gi = 0; gi < 4; ++gi) {
            const int t0 = chunk * 64 + gi * 16;
#pragma unroll
            for (int r = 0; r < 2; ++r) { const int tk = 2 * w + r, t = t0 + tk, b = t >> 13;
                const bf16_t* xr = X1 + (size_t)t * 2048;
                f32x4 v[8]; float ss = 0.f;
#pragma unroll
                for (int i = 0; i < 8; ++i) { const u32x2 xw = *(const u32x2*)(xr + (i * 64 + lane) * 4); v[i] = (f32x4){bflo(xw.x), bfhi(xw.x), bflo(xw.y), bfhi(xw.y)}; ss += v[i][0] * v[i][0] + v[i][1] * v[i][1] + v[i][2] * v[i][2] + v[i][3] * v[i][3]; }
                ss = wave_sum(ss);
                const float rstd = rsqrtf(ss * (1.0f / 2048.0f) + EPS);
#pragma unroll
                for (int i = 0; i < 8; ++i) { const int d = (i * 64 + lane) * 4;
                    const f32x4 sh = *(const f32x4*)(mod + b * 12288 + 6144 + d), sc = *(const f32x4*)(mod + b * 12288 + 8192 + d), g = *(const f32x4*)(p.g2 + d);
                    const f32x4 hv = v[i] * rstd * g * (sc + 1.0f) + sh;
                    *(unsigned*)(H2 + (size_t)t * 2048 + d) = pack4_fp8(hv[0], hv[1], hv[2], hv[3]);
                    *(LAS f32x4*)(hs + tk * HS_STRIDE + d) = hv; } }
            __syncthreads();
            { const int i16 = lane & 15, kq = lane >> 4;
              f32x4 c0 = {0.f, 0.f, 0.f, 0.f}, c1 = {0.f, 0.f, 0.f, 0.f};
#pragma unroll
              for (int kb = 0; kb < 16; ++kb) { const int kbase = 256 * w + 16 * kb + 4 * kq;
                  const f32x4 a4 = *(const LAS f32x4*)(hs + i16 * HS_STRIDE + kbase);
#pragma unroll
                  for (int sx = 0; sx < 4; ++sx) {
                      c0 = __builtin_amdgcn_mfma_f32_16x16x4f32(a4[sx], wreg[kb][sx][0], c0, 0, 0, 0); c1 = __builtin_amdgcn_mfma_f32_16x16x4f32(a4[sx], wreg[kb][sx][1], c1, 0, 0, 0); } }
#pragma unroll
              for (int r = 0; r < 4; ++r) { part[(w * 16 + 4 * kq + r) * 32 + i16] = c0[r]; part[(w * 16 + 4 * kq + r) * 32 + 16 + i16] = c1[r]; } }
            __syncthreads();
            {
                const int tk = tid >> 5, e = tid & 31; float cur = p.b_router[e];
#pragma unroll
                for (int w8 = 0; w8 < 8; ++w8) cur += part[(w8 * 16 + tk) * 32 + e];
                float vals[4]; int ids[4];
#pragma unroll
                for (int k = 0; k < 4; ++k) { float bv = cur; int bi = e;
#pragma unroll
                    for (int o = 16; o >= 1; o >>= 1) { const float ov = __shfl_xor(bv, o); const int oi = __shfl_xor(bi, o); if (ov > bv || (ov == bv && oi < bi)) { bv = ov; bi = oi; } }
                    vals[k] = bv; ids[k] = bi; if (e == bi) cur = -__builtin_inff(); }
                if (e == 0) { const int t = t0 + tk; float ex[4], se = 0.f;
#pragma unroll
                    for (int k = 0; k < 4; ++k) { ex[k] = __expf(vals[k] - vals[0]); se += ex[k]; }
                    const float inv = 1.0f / se;
#pragma unroll
                    for (int k = 0; k < 4; ++k) { TOPI[(size_t)t * 4 + k] = ids[k]; TOPG[(size_t)t * 4 + k] = ex[k] * inv; atomicAdd((int*)(hist + ids[k]), 1); } } }
            __syncthreads();
        }
        if (tid < 32) CNT[chunk * 32 + tid] = hist[tid];
        __syncthreads();
    }
}

__device__ __forceinline__ void phase8(const Frame& F) {
    const int tid = F.tid, lane = F.lane, w = F.wave;
    LAS int* cn = (LAS int*)F.lds;
    LAS int* part = cn + 8192;
    LAS int* tot = part + 512;
    LAS int* base = tot + 32;
    LAS int* pst = base + 32;
    LAS int* wcnt = pst + 40;
    const int* CNT = WSP(int, WS_CNT); const int* TOPI = WSP(int, WS_TOPI);
    int* POS = WSP(int, WS_POS); int* SRC = WSP(int, WS_SRC); int* TILEE = WSP(int, WS_TILEE);
    const int chunk0 = F.bid;
    int e_pre = 0;
    if (tid < 256 && chunk0 < 256) e_pre = TOPI[(size_t)chunk0 * 256 + tid];
    for (int q = tid; q < 8192; q += 512) cn[q] = CNT[q];
    __syncthreads();
    { const int e = tid & 31, g = tid >> 5; int sacc = 0;
#pragma unroll
      for (int c = 0; c < 16; ++c) sacc += cn[(g * 16 + c) * 32 + e];
      part[g * 32 + e] = sacc; }
    __syncthreads();
    if (tid < 32) { int run = 0;
#pragma unroll
        for (int g = 0; g < 16; ++g) run += part[g * 32 + tid];
        tot[tid] = run; }
    __syncthreads();
    if (tid < 32) {
        const int pad = (tot[tid] + 255) / 256 * 256; int incl = pad;
#pragma unroll
        for (int o = 1; o < 32; o <<= 1) { const int v = __shfl_up(incl, o); if (tid >= o) incl += v; }
        pst[tid] = incl - pad; if (tid == 31) pst[32] = incl; }
    __syncthreads();
    for (int chunk = chunk0; chunk < 256; chunk += F.G) {
        if (tid < 32) { const int g = chunk >> 4; int run = 0;
            for (int gg = 0; gg < g; ++gg) run += part[gg * 32 + tid];
            for (int c = g * 16; c < chunk; ++c) run += cn[c * 32 + tid];
            base[tid] = run; }
        int e = e_pre; if (chunk != chunk0 && tid < 256) e = TOPI[(size_t)chunk * 256 + tid];
        int rk = 0;
        if (tid < 256) {
#pragma unroll 8
            for (int k = 0; k < 32; ++k) { const unsigned long long mk = __ballot(e == k);
                if (e == k) rk = __popcll(mk & ((1ull << lane) - 1ull));
                if (lane == k) wcnt[w * 32 + k] = __popcll(mk); } }
        __syncthreads();
        if (tid < 256) { int before = 0;
            for (int ww = 0; ww < w; ++ww) before += wcnt[ww * 32 + e];
            const int pos = pst[e] + base[e] + before + rk; POS[(size_t)chunk * 256 + tid] = pos; SRC[pos] = chunk * 64 + (tid >> 2); }
        if (chunk < 32) { const int ee = chunk; for (int r = pst[ee] + tot[ee] + tid; r < pst[ee + 1]; r += 512) SRC[r] = 0; }
        if (chunk == 0) { const int ntl = pst[32] >> 8; for (int i = tid; i < ntl; i += 512) { int ee = 0;
#pragma unroll
                for (int k = 0; k < 32; ++k) if (pst[k] <= i * 256) ee = k;
                TILEE[i] = ee; }
            if (tid == 0) TILEE[MAXTILES] = ntl; }
        __syncthreads();
    }
}

__device__ __forceinline__ void phase11(const Params& p, const Frame& F) {
    const int lane = F.lane;
    const float* mod = WSP(float, WS_MOD); const bf16_t* X1 = WSP(bf16_t, WS_X1); const unsigned char* Y = F.ws + WS_YBUF;
    const int* POS = WSP(int, WS_POS); const float* TOPG = WSP(float, WS_TOPG);
    for (int t = F.bid * 8 + F.wave; t < T_; t += F.G * 8) {
        const int b = t >> 13;
        int ps[4]; float gk[4];
#pragma unroll
        for (int k = 0; k < 4; ++k) { ps[k] = POS[(size_t)t * 4 + k]; gk[k] = TOPG[(size_t)t * 4 + k] * (1.0f / 16.0f); }
        f32x4 v[8]; float ss = 0.f;
#pragma unroll
        for (int i = 0; i < 8; ++i) { const int d = (i * 64 + lane) * 4;
            f32x4 a = {0.f, 0.f, 0.f, 0.f};
#pragma unroll
            for (int k = 0; k < 4; ++k) { const int yw = *(const int*)(Y + (size_t)ps[k] * 2048 + d);
                const f32x2 ylo = __builtin_amdgcn_cvt_pk_f32_fp8(yw, false), yhi = __builtin_amdgcn_cvt_pk_f32_fp8(yw, true);
                a[0] += gk[k] * ylo[0]; a[1] += gk[k] * ylo[1]; a[2] += gk[k] * yhi[0]; a[3] += gk[k] * yhi[1]; }
            const f32x4 gt = *(const f32x4*)(mod + b * 12288 + 10240 + d);
            const u32x2 xw = *(const u32x2*)(X1 + (size_t)t * 2048 + d);
            v[i] = (f32x4){bflo(xw.x), bfhi(xw.x), bflo(xw.y), bfhi(xw.y)} + gt * a;
            ss += v[i][0] * v[i][0] + v[i][1] * v[i][1] + v[i][2] * v[i][2] + v[i][3] * v[i][3]; }
        ss = wave_sum(ss);
        const float rstd = rsqrtf(ss * (1.0f / 2048.0f) + EPS);
#pragma unroll
        for (int i = 0; i < 8; ++i) { const int d = (i * 64 + lane) * 4; const f32x4 g = *(const f32x4*)(p.g_final + d);
            *(f32x4*)(p.out + (size_t)t * 2048 + d) = v[i] * rstd * g; }
    }
}

__global__ void __launch_bounds__(512, 2) fwd(Params p) {
    extern __shared__ __attribute__((aligned(16))) unsigned char lds_raw[];
    Frame F;
    F.lds = (LAS unsigned char*)lds_raw;
    F.tid = threadIdx.x; F.lane = F.tid & 63; F.wave = __builtin_amdgcn_readfirstlane(F.tid >> 6);
    F.G = gridDim.x; F.bid = blockIdx.x; F.ws = p.ws;
    volatile LAS unsigned* xbw = (volatile LAS unsigned*)(F.lds + LDS_BYTES - 16);
    if (F.tid < 4) xbw[F.tid] = 0u;
    __syncthreads();
    const int lo = p.lo, hi = p.hi;
    const bool multi = (hi - lo) > 1;
    XcdBarrier bar; bar.bar = (unsigned*)(p.ws + WS_CTL); bar.x = 0; bar.st = xbw;
    if (multi) bar = xcd_barrier_post((unsigned*)(p.ws + WS_CTL), xbw);
#define IN(k) (lo <= (k) && (k) < hi)
#define SEAM(k) do { if (IN((k) + 1)) xcd_barrier(bar); } while (0)

    if (IN(0)) { phase0(p, F); SEAM(0); }
    if (IN(1)) { phase1(p, F);
#if IN_MODE == 2
        __syncthreads(); wtile_pass<0>(p, F, 0, OUT_MODE == 2 ? CONV_TILES : 896);
#endif
        SEAM(1); }
    if (IN(2)) {
        cum_scan(F);
        pg8::SplitOrder S; S.init(T_, NPROJ, F.G, F.bid, CONV_NCG, CONV_NA, WGM_IN);
        if ((F.G & 63) != 0) conv8_range(p, F, F.bid, F.G);
        else if (S.conv) conv8_range(p, F, S.conv_rank(CONV_NCG), (F.G >> 3) * CONV_NCG);
        __syncthreads();
#if IN_MODE == 2
        pg8::SrcPlain X{WSP(bf16_t, WS_H1), WSP(bf16_t, WS_WIN), 1024};
        pg8::EpiProjI8 E{WSP(bf16_t, WS_PROJ), NPROJ, WSP(float, WS_RS), WSP(float, WS_CMAX)};
        pg8::gemm_phase<2>(F.lds, 1024, S, X, E);
#elif IN_MODE == 1
        pg8::SrcPlain X{WSP(bf16_t, WS_H1), WSP(bf16_t, WS_WIN), 1024};
        pg8::EpiProj E{WSP(bf16_t, WS_PROJ), NPROJ, 1.0f / 256.0f};
        pg8::gemm_phase<1>(F.lds, 1024, S, X, E);
#else
        pg8::SrcPlain X{WSP(bf16_t, WS_H1), WSP(bf16_t, WS_WIN), 2048};
        pg8::EpiProj E{WSP(bf16_t, WS_PROJ), NPROJ, 1.0f};
        pg8::gemm_phase<0>(F.lds, 2048, S, X, E);
#endif
        SEAM(2);
    }
    if (IN(3)) {
        {   unsigned short fa[16], va[16], fb[16], vb[16];
            int u = F.bid;
            if (u < 2048) { hg_load_col(F, u >> 7, u & 127, C_HF, fa); hg_load_col(F, u >> 7, u & 127, C_HI, va); }
            while (u < 2048) { const int un = u + F.G;
                if (un < 2048) { hg_load_col(F, un >> 7, un & 127, C_HF, fb); hg_load_col(F, un >> 7, un & 127, C_HI, vb); }
                hgu_unit(p, F, u >> 7, u & 127, fa, va);
#pragma unroll
                for (int i = 0; i < 16; ++i) { fa[i] = fb[i]; va[i] = vb[i]; }
                u = un; } }
        knorm_pass(F);
        SEAM(3);
    }
    if (IN(4)) {
        hg_scan(F);
        for (int a = F.bid; a < 512; a += F.G) { const int bh = a >> 5, xq = a & 31; attn_unit(F, bh, xq); attn_unit(F, bh, 63 - xq); }
        SEAM(4);
    }
    if (IN(5)) {
        {   unsigned short fa[16], qa[16], va[16], fb[16], qb[16], vb[16]; u32x4 sa[4], sb[4];
            const bf16_t* SPg = WSP(bf16_t, WS_HGSP);
#define HGO_LOAD(u_, f_, q_, v_, s_) do { hg_load_col(F, (u_) >> 7, (u_) & 127, C_HF, f_); hg_load_col(F, (u_) >> 7, (u_) & 127, C_HQ, q_); hg_load_col(F, (u_) >> 7, (u_) & 127, C_HI, v_); \
                _Pragma("unroll") for (int r = 0; r < 4; ++r) { const int q = F.tid + 512 * r; s_[r] = *(const u32x4*)(SPg + (size_t)(u_) * 16384 + (size_t)(q >> 4) * 128 + (q & 15) * 8); } } while (0)
#if OUT_MODE == 2
#define HGO_UOF(j_) ((F.bid + ((j_) >> 3) * F.G) < 256 ? ((((F.bid + ((j_) >> 3) * F.G) >> 7) * 8 + ((j_) & 7)) * 128 + ((F.bid + ((j_) >> 3) * F.G) & 127)) : 2048)
            int j = 0, u = HGO_UOF(0);
            if (u < 2048) HGO_LOAD(u, fa, qa, va, sa);
            while (u < 2048) { const int un = HGO_UOF(j + 1);
                if (un < 2048) HGO_LOAD(un, fb, qb, vb, sb);
                hgo_unit(p, F, u >> 7, u & 127, fa, qa, va, sa);
                if ((j & 7) == 7) mix_quant(F, u >> 10, u & 127);
#pragma unroll
                for (int i = 0; i < 16; ++i) { fa[i] = fb[i]; qa[i] = qb[i]; va[i] = vb[i]; }
#pragma unroll
                for (int r = 0; r < 4; ++r) sa[r] = sb[r];
                u = un; ++j; }
#undef HGO_UOF
#else
            int u = F.bid;
            if (u < 2048) HGO_LOAD(u, fa, qa, va, sa);
            while (u < 2048) { const int un = u + F.G;
                if (un < 2048) HGO_LOAD(un, fb, qb, vb, sb);
                hgo_unit(p, F, u >> 7, u & 127, fa, qa, va, sa);
#pragma unroll
                for (int i = 0; i < 16; ++i) { fa[i] = fb[i]; qa[i] = qb[i]; va[i] = vb[i]; }
#pragma unroll
                for (int r = 0; r < 4; ++r) sa[r] = sb[r];
                u = un; }
#endif
#undef HGO_LOAD
        }
        SEAM(5);
    }
    if (IN(6)) {
        pg8::StaticOrder S; S.init(T_, 2048, F.G, F.bid, WGM_OUT);
#if OUT_MODE == 2
        pg8::SrcPlain X{WSP(bf16_t, WS_MIX8), WSP(bf16_t, WS_WOUT), 1024};
        pg8::EpiResidI8 E{p.x, WSP(bf16_t, WS_X1), WSP(float, WS_MOD) + 4096, WSP(float, WS_RS2), WSP(float, WS_CMAX) + NPROJ};
        pg8::gemm_phase<2>(F.lds, 1024, S, X, E);
#elif OUT_MODE == 1
        pg8::SrcPlain X{WSP(bf16_t, WS_MIX8), WSP(bf16_t, WS_WOUT), 1024};
        pg8::EpiResid E{p.x, WSP(bf16_t, WS_X1), WSP(float, WS_MOD) + 4096, 1.0f / 256.0f};
        pg8::gemm_phase<1>(F.lds, 1024, S, X, E);
#else
        pg8::SrcPlain X{WSP(bf16_t, WS_MIXED), WSP(bf16_t, WS_WOUT), 2048};
        pg8::EpiResid E{p.x, WSP(bf16_t, WS_X1), WSP(float, WS_MOD) + 4096, 1.0f};
        pg8::gemm_phase<0>(F.lds, 2048, S, X, E);
#endif
        SEAM(6);
    }
    if (IN(7)) { phase7(p, F); SEAM(7); }
    if (IN(8)) { phase8(F); SEAM(8); }
    if (IN(9)) {
        const int ntl = WSP(int, WS_TILEE)[MAXTILES];
        pg8::StaticOrder S; S.init(ntl * 256, 4096, F.G, F.bid, WGM_GU);
        pg8::SrcMoE X{WSP(bf16_t, WS_H2), WSP(bf16_t, WS_WGU), WSP(int, WS_SRC), WSP(int, WS_TILEE), 1024, (size_t)4096 * 1024};
        pg8::EpiGlu E{F.ws + WS_ACT, p.b_gu};
        pg8::gemm_phase<1>(F.lds, 1024, S, X, E);
        SEAM(9);
    }
    if (IN(10)) {
        const int ntl = WSP(int, WS_TILEE)[MAXTILES];
        pg8::StaticOrder S; S.init(ntl * 256, 2048, F.G, F.bid, WGM_DN);
        pg8::SrcMoE X{WSP(bf16_t, WS_ACT), WSP(bf16_t, WS_WDN), nullptr, WSP(int, WS_TILEE), 1024, (size_t)2048 * 1024};
        pg8::EpiDown E{F.ws + WS_YBUF, p.b_down};
        pg8::gemm_phase<1>(F.lds, 1024, S, X, E);
        SEAM(10);
    }
    if (IN(11)) { phase11(p, F); }
#undef IN
#undef SEAM
}

#ifndef N_LAUNCH_MODE
#define N_LAUNCH_MODE 1
#endif
extern "C" void kernel_launch(void* const* d_in, const int* in_sizes, int n_in, void* d_out, int out_size, void* d_ws, size_t ws_size, hipStream_t stream) {
    static int grid = 0;
    if (grid == 0) {
        if (n_in != 19 || out_size != T_ * D_ || ws_size < WS_END) { fprintf(stderr, "kernel_launch: unexpected shapes (n_in %d out %d ws %zu need %zu)\n", n_in, out_size, ws_size, (size_t)WS_END); grid = -1; return; }
        int dev = 0, cus = 0, per_cu = 0;
        if (hipGetDevice(&dev) != hipSuccess || hipDeviceGetAttribute(&cus, hipDeviceAttributeMultiprocessorCount, dev) != hipSuccess) { grid = -1; return; }
        if (hipFuncSetAttribute((const void*)fwd, hipFuncAttributeMaxDynamicSharedMemorySize, LDS_BYTES) != hipSuccess) { fprintf(stderr, "kernel_launch: hipFuncSetAttribute failed\n"); grid = -1; return; }
        if (hipOccupancyMaxActiveBlocksPerMultiprocessor(&per_cu, (const void*)fwd, 512, LDS_BYTES) != hipSuccess || per_cu < 1) fprintf(stderr, "kernel_launch: occupancy query reports %d\n", per_cu);
        (void)hipGetLastError();
        grid = cus;
    }
    if (grid < 0) return;
    (void)in_sizes;
    hipMemsetAsync((char*)d_ws + WS_CTL, 0, 65536, stream);
    Params p{};
    p.x = (const float*)d_in[0]; p.c = (const float*)d_in[1]; p.w_ada = (const float*)d_in[2]; p.b_ada = (const float*)d_in[3];
    p.g1 = (const float*)d_in[4]; p.g2 = (const float*)d_in[5]; p.w_in = (const float*)d_in[6]; p.b_fgate = (const float*)d_in[7];
    p.g_fox = (const float*)d_in[8]; p.lb_logits = (const float*)d_in[9]; p.g_hg = (const float*)d_in[10]; p.w_out = (const float*)d_in[11];
    p.w_router = (const float*)d_in[12]; p.b_router = (const float*)d_in[13]; p.w_gu = (const float*)d_in[14]; p.b_gu = (const float*)d_in[15];
    p.w_down = (const float*)d_in[16]; p.b_down = (const float*)d_in[17]; p.g_final = (const float*)d_in[18];
    p.out = (float*)d_out; p.ws = (unsigned char*)d_ws;
#if N_LAUNCH_MODE == 1
    p.lo = 0; p.hi = NPHASE;
    hipLaunchKernelGGL(fwd, dim3(grid), dim3(512), LDS_BYTES, stream, p);
#else
    for (int k = 0; k < NPHASE; ++k) { p.lo = k; p.hi = k + 1; hipLaunchKernelGGL(fwd, dim3(grid), dim3(512), LDS_BYTES, stream, p); }
#endif
}
```

```cpp
#include <hip/hip_runtime.h>
#include <cstdio>
#include <cstdint>

#define LAS __attribute__((address_space(3)))
typedef unsigned short bf16_t;
typedef short bf16x8 __attribute__((ext_vector_type(8)));
typedef short s16x4 __attribute__((ext_vector_type(4)));
typedef float f32x4 __attribute__((ext_vector_type(4)));
typedef float f32x2 __attribute__((ext_vector_type(2)));
typedef unsigned u32x4 __attribute__((ext_vector_type(4)));
typedef unsigned u32x2 __attribute__((ext_vector_type(2)));
typedef int i32x4 __attribute__((ext_vector_type(4)));
typedef int i32x8 __attribute__((ext_vector_type(8)));

constexpr int T_ = 16384, D_ = 2048, S_ = 8192;
constexpr int NPROJ = 7168;
constexpr int C_FQ = 0, C_FK = 1024, C_FV = 2048, C_HQ = 3072, C_HF = 4096, C_HI = 5120, C_HG = 6144;
constexpr int NE = 32;
constexpr int MAXTILES = 288, MAXROWS = MAXTILES * 256;
constexpr int LDS_BYTES = 155648;
constexpr int NPHASE = 12;
#ifndef WGM_IN
#define WGM_IN 2
#endif
#ifndef WGM_OUT
#define WGM_OUT 4
#endif
#ifndef WGM_GU
#define WGM_GU 2
#endif
#ifndef WGM_DN
#define WGM_DN 4
#endif
#ifndef CONV_NCG
#define IN_MODE 2
#define OUT_MODE 2
#define BG_CONV 96
#define CONV_NCG 4
#endif
#ifndef CONV_NA
#define CONV_NA 0
#endif
constexpr float EPS = 1e-6f;
constexpr float LOG2E = 1.4426950408889634f;

constexpr size_t al256(size_t x) { return (x + 255) & ~(size_t)255; }
constexpr int XCD_BAR_WORDS_C = 3456;
constexpr size_t WS_CTL   = 0;
constexpr size_t WS_MODP  = 65536;
constexpr size_t WS_MOD   = WS_MODP + al256(8 * 2 * 12288 * 4);
constexpr size_t WS_WIN   = WS_MOD + al256(2 * 12288 * 4);
constexpr size_t WS_WOUT  = WS_WIN + (size_t)NPROJ * 2048 * 2;
constexpr size_t WS_WGU   = WS_WOUT + (size_t)2048 * 2048 * 2;
constexpr size_t WS_WDN   = WS_WGU + (size_t)32 * 4096 * 2048 * 2;
constexpr size_t WS_H1    = WS_WDN + (size_t)32 * 2048 * 2048 * 2;
constexpr size_t WS_PROJ  = WS_H1 + (size_t)T_ * 2048 * 2;
constexpr size_t WS_LOGF  = WS_PROJ + (size_t)T_ * NPROJ * 2;
constexpr size_t WS_CUM   = WS_LOGF + (size_t)T_ * 8 * 4;
constexpr size_t WS_HGU   = WS_CUM + (size_t)T_ * 8 * 4;
constexpr size_t WS_HGSP  = WS_HGU + (size_t)16 * 128 * 128 * 128 * 4;
constexpr size_t WS_HGDEC = WS_HGSP + (size_t)16 * 128 * 128 * 128 * 2;
constexpr size_t WS_MIXED = WS_HGDEC + (size_t)16 * 128 * 128 * 4;
constexpr size_t WS_SSQ   = WS_MIXED + (size_t)T_ * 2048 * 2;
constexpr size_t WS_X1    = WS_SSQ + (size_t)T_ * 8 * 4;
constexpr size_t WS_H2    = WS_X1 + (size_t)T_ * 2048 * 4;
constexpr size_t WS_TOPI  = WS_H2 + (size_t)T_ * 2048 * 2;
constexpr size_t WS_TOPG  = WS_TOPI + (size_t)T_ * 16;
constexpr size_t WS_POS   = WS_TOPG + (size_t)T_ * 16;
constexpr size_t WS_CNT   = WS_POS + (size_t)T_ * 16;
constexpr size_t WS_SRC   = WS_CNT + 256 * 32 * 4;
constexpr size_t WS_TILEE = WS_SRC + (size_t)MAXROWS * 4;
constexpr size_t WS_ACT   = WS_TILEE + 4096;
constexpr size_t WS_YBUF  = WS_ACT + (size_t)MAXROWS * 2048 * 2;
constexpr size_t WS_KN    = WS_YBUF + (size_t)MAXROWS * 2048 * 2;
constexpr size_t WS_MIX8  = WS_KN + 16 * 128 * 4;
constexpr size_t WS_RS    = WS_MIX8 + (size_t)T_ * 2048;
constexpr size_t WS_MIXN  = WS_RS + (size_t)T_ * 4;
constexpr size_t WS_RS2   = WS_MIXN + (size_t)T_ * 2048 * 2;
constexpr size_t WS_END   = WS_RS2 + (size_t)T_ * 4;
constexpr size_t WS_BARW  = XCD_BAR_WORDS_C * 4;
constexpr size_t WS_CMAX  = 2 * XCD_BAR_WORDS_C * 4;

struct Params {
    const float* x; const float* c; const float* w_ada; const float* b_ada; const float* g1; const float* g2;
    const float* w_in; const float* b_fgate; const float* g_fox; const float* lb_logits; const float* g_hg;
    const float* w_out; const float* w_router; const float* b_router; const float* w_gu; const float* b_gu;
    const float* w_down; const float* b_down; const float* g_final;
    float* out; unsigned char* ws; int lo, hi;
};

__device__ __forceinline__ unsigned cvt_pk_bf16(float lo, float hi) { unsigned r; asm volatile("v_cvt_pk_bf16_f32 %0, %1, %2" : "=v"(r) : "v"(lo), "v"(hi)); return r; }
__device__ __forceinline__ unsigned pack4_fp8(float a, float b, float c, float d) { int w = 0; w = __builtin_amdgcn_cvt_pk_fp8_f32(a, b, w, false); w = __builtin_amdgcn_cvt_pk_fp8_f32(c, d, w, true); return (unsigned)w; }
__device__ __forceinline__ unsigned pack4_i8(float a, float b, float c, float d) {
    const int ia = __float2int_rn(a), ib = __float2int_rn(b), ic = __float2int_rn(c), id = __float2int_rn(d);
    return (unsigned)(ia & 255) | ((unsigned)(ib & 255) << 8) | ((unsigned)(ic & 255) << 16) | ((unsigned)id << 24);
}
__device__ __forceinline__ i32x8 cat8(bf16x8 a, bf16x8 b) { const i32x4 x = __builtin_bit_cast(i32x4, a), y = __builtin_bit_cast(i32x4, b); return __builtin_shufflevector(x, y, 0, 1, 2, 3, 4, 5, 6, 7); }
__device__ __forceinline__ float bf2f(bf16_t b) { return __uint_as_float(((unsigned)b) << 16); }
__device__ __forceinline__ float bflo(unsigned w) { return __uint_as_float(w << 16); }
__device__ __forceinline__ float bfhi(unsigned w) { return __uint_as_float(w & 0xffff0000u); }
__device__ __forceinline__ float xmax16(float x) { const auto r = __builtin_amdgcn_permlane16_swap(__float_as_uint(x), __float_as_uint(x), false, false); return fmaxf(__uint_as_float(r[0]), __uint_as_float(r[1])); }
__device__ __forceinline__ float xmax32(float x) { const auto r = __builtin_amdgcn_permlane32_swap(__float_as_uint(x), __float_as_uint(x), false, false); return fmaxf(__uint_as_float(r[0]), __uint_as_float(r[1])); }
__device__ __forceinline__ float wave_sum(float v) {
#pragma unroll
    for (int o = 32; o >= 1; o >>= 1) v += __shfl_xor(v, o);
    return v;
}

#define XB_TMO      128
#define XB_XCNT(j)  (256  + 64 * (j))
#define XB_XSUB(j)  (1280 + 64 * (j))
#define XB_XGEN(j)  (2304 + 64 * (j))
#define XB_TOP      3328
#define XB_TOPGEN   3392
#define XCD_BAR_WORDS 3456
#define XB_SPIN_CAP (1u << 18)

__device__ __forceinline__ unsigned xb_ld(unsigned* p)              { return __hip_atomic_load(p, __ATOMIC_RELAXED, __HIP_MEMORY_SCOPE_AGENT); }
__device__ __forceinline__ unsigned xb_add(unsigned* p, unsigned v) { return __hip_atomic_fetch_add(p, v, __ATOMIC_RELAXED, __HIP_MEMORY_SCOPE_AGENT); }
__device__ __forceinline__ unsigned xb_xcc_id() { return (unsigned)__builtin_amdgcn_s_getreg((3 << 11) | 20) & 0xFu; }
#define XB_SPIN(cond, bar) do { unsigned _sp = 0; while (cond) { __builtin_amdgcn_s_sleep(1); \
    if ((++_sp & 255u) == 0u) { if (xb_ld(&(bar)[XB_TMO])) break; if (_sp > XB_SPIN_CAP) { atomicAdd(&(bar)[XB_TMO], 1u); break; } } } } while (0)

struct XcdBarrier { unsigned* bar; unsigned x; volatile LAS unsigned* st; unsigned total; };

__device__ __forceinline__ XcdBarrier xcd_barrier_post(unsigned* bar, volatile LAS unsigned* st, unsigned total) {
    XcdBarrier b; b.bar = bar; b.x = xb_xcc_id(); b.st = st; b.total = total;
    if (threadIdx.x == 0) (void)xb_add(&bar[XB_XCNT(b.x)], 1u);
    return b;
}
__device__ __forceinline__ void xcd_barrier_complete(unsigned* bar, unsigned x, unsigned G, unsigned& nloc, unsigned& nx) {
    unsigned sum, cnt, mine, sp = 0u;
    for (;;) {
        sum = 0u; cnt = 0u; mine = 0u;
#pragma unroll
        for (unsigned j = 0; j < 16; ++j) { const unsigned c = xb_ld(&bar[XB_XCNT(j)]); sum += c; cnt += (c > 0u) ? 1u : 0u; mine = (j == x) ? c : mine; }
        if (sum == G) break;
        __builtin_amdgcn_s_sleep(1);
        if ((++sp & 255u) == 0u) { if (xb_ld(&bar[XB_TMO])) break; if (sp > XB_SPIN_CAP) { atomicAdd(&bar[XB_TMO], 1u); break; } }
    }
    nloc = mine > 0u ? mine : 1u; nx = cnt > 0u ? cnt : 1u;
}
__device__ __forceinline__ void xcd_barrier(const XcdBarrier& b) {
    asm volatile("s_waitcnt vmcnt(0)" ::: "memory");
    __syncthreads();
    if (threadIdx.x == 0) {
        unsigned* bar = b.bar;
        __builtin_amdgcn_s_waitcnt(0);
        unsigned nloc = b.st[0], nx = b.st[1];
        if (nloc == 0u) { xcd_barrier_complete(bar, b.x, b.total, nloc, nx); b.st[0] = nloc; b.st[1] = nx; }
        const unsigned old = xb_add(&bar[XB_XSUB(b.x)], 1u);
        const unsigned gen = old / nloc;
        if (old + 1u == (gen + 1u) * nloc) {
            __builtin_amdgcn_fence(__ATOMIC_RELEASE, "agent");
            asm volatile("s_waitcnt vmcnt(0)" ::: "memory");
            const unsigned og = xb_add(&bar[XB_TOP], 1u);
            const unsigned tg = og / nx;
            if (og + 1u == (tg + 1u) * nx) xb_add(&bar[XB_TOPGEN], 1u);
            else XB_SPIN(xb_ld(&bar[XB_TOPGEN]) == tg, bar);
            __builtin_amdgcn_fence(__ATOMIC_ACQUIRE, "agent");
            xb_add(&bar[XB_XGEN(b.x)], 1u);
            asm volatile("s_waitcnt vmcnt(0)" ::: "memory");
        } else {
            XB_SPIN(xb_ld(&bar[XB_XGEN(b.x)]) == gen, bar);
            __builtin_amdgcn_fence(__ATOMIC_ACQUIRE, "agent");
            asm volatile("s_waitcnt vmcnt(0)" ::: "memory");
        }
    }
    __syncthreads();
}

namespace pg8 {
constexpr int BM = 256, BK = 64, HALF = 128, HTB = HALF * BK * 2, STAGE_BYTES = 8 * HTB, NXCD = 8;
__device__ __forceinline__ int lds_byte(int r, int c) { const int st = (r >> 4) * 2 + (c >> 5), rr = r & 15, cc = c & 31, ob = rr * 64 + cc * 2; return st * 1024 + (ob ^ (((ob >> 9) & 1) << 5)); }
__device__ __forceinline__ void stage_rc(int b, int& R, int& C) { const int st = b / 1024, sb = b % 1024, swz = sb ^ (((sb >> 9) & 1) << 5); R = (st >> 1) * 16 + swz / 64; C = (st & 1) * 32 + (swz % 64) / 2; }
__device__ __forceinline__ int perm32(int rho) { const int n = rho >> 4, i = rho & 15; return 8 * (i >> 2) + 4 * n + (i & 3); }
struct Unit { int pm, pn; };
struct StaticOrder {
    int nM, nN, nwg, G, c, WGM;
    __device__ void init(int M, int N, int G_, int c_, int wgm) { nM = M / BM; nN = N / BM; nwg = nM * nN; G = G_; c = c_; WGM = wgm; }
    __device__ bool next(int i, Unit& u) const {
        const long L = (long)i * G + c; if (L >= nwg) return false;
        int wgid = (int)L; { const int q = nwg / NXCD, r = nwg % NXCD, xcd = wgid % NXCD, off = wgid / NXCD; wgid = (xcd < r ? xcd * (q + 1) : r * (q + 1) + (xcd - r) * q) + off; }
        const int nig = WGM * nN, gid = wgid / nig, fm = gid * WGM, gsz = (nM - fm) < WGM ? (nM - fm) : WGM;
        u.pm = fm + ((wgid % nig) % gsz); u.pn = (wgid % nig) / gsz; return true;
    }
};

struct SplitOrder {
    int nM, nN, nwg, G, c, na, nb, n_nc, rank_nc, WGM; bool conv;
    __device__ void init(int M, int N, int G_, int c_, int ncg, int na_, int wgm) {
        nM = M / BM; nN = N / BM; nwg = nM * nN; G = G_; c = c_; WGM = wgm;
        if ((G & 63) != 0) ncg = 0;
        const int g = c >> 3, oct = g >> 3, gi = g & 7;
        conv = gi < ncg;
        n_nc = G - (G >> 3) * ncg;
        rank_nc = 8 * (oct * (8 - ncg) + (gi > ncg ? gi - ncg : 0)) + (c & 7);
        na = ncg ? na_ : 0x3fffffff;
        const int rem = nwg - na * G;
        nb = ncg ? na + (rem > 0 ? (rem + n_nc - 1) / n_nc : 0) : 0x3fffffff;
    }
    __device__ int conv_rank(int ncg) const { const int g = c >> 3; return 8 * ((g >> 3) * ncg + ((g & 7) < ncg ? (g & 7) : ncg)) + (c & 7); }
    __device__ bool next(int i, Unit& u) const {
        long L;
        if (i < na) L = (long)i * G + c;
        else { if (conv || i >= nb) return false; L = (long)na * G + (long)(i - na) * n_nc + rank_nc; }
        if (L >= nwg) return false;
        int wgid = (int)L; { const int q = nwg / NXCD, r = nwg % NXCD, xcd = wgid % NXCD, off = wgid / NXCD; wgid = (xcd < r ? xcd * (q + 1) : r * (q + 1) + (xcd - r) * q) + off; }
        const int nig = WGM * nN, gid = wgid / nig, fm = gid * WGM, gsz = (nM - fm) < WGM ? (nM - fm) : WGM;
        u.pm = fm + ((wgid % nig) % gsz); u.pn = (wgid % nig) / gsz; return true;
    }
};
struct SrcPlain {
    static constexpr bool SIDE = false;
    const bf16_t* A; const bf16_t* Bt; int K;
    __device__ __forceinline__ void load_map(LAS int*, int) const {}
    __device__ __forceinline__ const char* a_base(const Unit& u) const { return (const char*)A + (size_t)u.pm * BM * K * 2; }
    __device__ __forceinline__ const char* b_base(const Unit& u, const LAS int*) const { return (const char*)Bt + (size_t)u.pn * BM * K * 2; }
    __device__ __forceinline__ void a_voff(const Unit&, const int (&R)[2], const int (&C)[2], unsigned (&v)[2][2]) const {
#pragma unroll
        for (int h = 0; h < 2; ++h)
#pragma unroll
            for (int i = 0; i < 2; ++i) v[h][i] = (unsigned)((h * HALF + R[i]) * K + C[i]) * 2u;
    }
    __device__ __forceinline__ void side_issue(const Unit&, LAS int*, int, int) const {}
    __device__ __forceinline__ void a_voff_side(const Unit& u, const LAS int*, const int (&R)[2], const int (&C)[2], unsigned (&v)[2][2]) const { a_voff(u, R, C, v); }
};
struct SrcMoE {
    static constexpr bool SIDE = true;
    const bf16_t* A; const bf16_t* Bt; const int* src; const int* tile_e; int K; size_t estride;
    __device__ __forceinline__ void load_map(LAS int* lte, int nM) const { for (int i = threadIdx.x; i < nM; i += 512) lte[i] = tile_e[i]; }
    __device__ __forceinline__ const char* a_base(const Unit& u) const { return src ? (const char*)A : (const char*)A + (size_t)u.pm * BM * K * 2; }
    __device__ __forceinline__ const char* b_base(const Unit& u, const LAS int* lte) const { const int e = lte[u.pm]; return (const char*)Bt + ((size_t)e * estride + (size_t)u.pn * BM * K) * 2; }
    __device__ __forceinline__ void a_voff(const Unit& u, const int (&R)[2], const int (&C)[2], unsigned (&v)[2][2]) const {
#pragma unroll
        for (int h = 0; h < 2; ++h)
#pragma unroll
            for (int i = 0; i < 2; ++i) {
                const int r = src ? src[u.pm * BM + h * HALF + R[i]] : (h * HALF + R[i]);
                v[h][i] = (unsigned)(r * K + C[i]) * 2u; }
    }
    __device__ __forceinline__ void side_issue(const Unit& u, LAS int* tbl, int wid, int lane) const {
        if (src && wid < 4) __builtin_amdgcn_global_load_lds((const unsigned*)(src + u.pm * BM + wid * 64 + lane), (LAS unsigned*)(tbl + wid * 64), 4, 0, 0);
    }
    __device__ __forceinline__ void a_voff_side(const Unit& u, const LAS int* tbl, const int (&R)[2], const int (&C)[2], unsigned (&v)[2][2]) const {
#pragma unroll
        for (int h = 0; h < 2; ++h)
#pragma unroll
            for (int i = 0; i < 2; ++i) {
                const int r = src ? tbl[h * HALF + R[i]] : (h * HALF + R[i]);
                v[h][i] = (unsigned)(r * K + C[i]) * 2u; }
    }
};

template <int MODE, class Epi, class Sched, class Src>
__device__ __forceinline__ void gemm_phase(LAS unsigned char* lds, const int K, const Sched& S, const Src& X, const Epi& E) {
    const int tid = threadIdx.x, wid = __builtin_amdgcn_readfirstlane(tid >> 6), lane = tid & 63, wr = wid >> 2, wc = wid & 3, fr = lane & 15, fq = lane >> 4;
    const int nt = K / BK;
    int Rr[2], Cc[2]; unsigned voffB[2];
#pragma unroll
    for (int i = 0; i < 2; ++i) { int R, C; stage_rc(tid * 16 + i * 8192, R, C); Rr[i] = R; Cc[i] = C; const int Rb = Epi::PERM ? ((R & ~31) + perm32(R & 31)) : R; voffB[i] = (unsigned)(Rb * K + C) * 2u; }
    const size_t kstep = (size_t)(BK * 2);
    const size_t hstep = (size_t)HALF * K * 2;
    const unsigned ldsw = (unsigned)wid * 1024u;
    const int aoff = lds_byte(wr * 64 + fr, fq * 8), boff = lds_byte(wc * 32 + fr, fq * 8);
#define PG8_SA(b, h) (((b) * 2 + (h)) * HTB)
#define PG8_SB(b, h) ((4 + (b) * 2 + (h)) * HTB)
#define PG8_STAGE(bufoff, gbase, voff) do { _Pragma("unroll") for (int _i = 0; _i < 2; ++_i) \
        __builtin_amdgcn_global_load_lds((const unsigned*)((const char*)(gbase) + (voff)[_i]), (LAS unsigned*)(lds + (bufoff) + ldsw + _i * 8192), 16, 0, 0); } while (0)
#define PG8_LDA(dst, b, h) do { _Pragma("unroll") for (int m = 0; m < 4; ++m) _Pragma("unroll") for (int k = 0; k < 2; ++k) dst[m][k] = *(const LAS bf16x8*)(lds + PG8_SA(b, h) + aoff + m * 2048 + k * 1024); } while (0)
#define PG8_LDB(dst, b, h) do { _Pragma("unroll") for (int n = 0; n < 2; ++n) _Pragma("unroll") for (int k = 0; k < 2; ++k) dst[n][k] = *(const LAS bf16x8*)(lds + PG8_SB(b, h) + boff + n * 2048 + k * 1024); } while (0)
#define PG8_MMA(ai, bj, At, Bt) do { __builtin_amdgcn_s_setprio(1); if constexpr (MODE == 2) { \
        _Pragma("unroll") for (int m = 0; m < 4; ++m) _Pragma("unroll") for (int n = 0; n < 2; ++n) _Pragma("unroll") for (int k = 0; k < 2; ++k) \
        acc[ai][bj][m][n] = __builtin_bit_cast(f32x4, __builtin_amdgcn_mfma_i32_16x16x64_i8(__builtin_bit_cast(i32x4, Bt[n][k]), __builtin_bit_cast(i32x4, At[m][k]), __builtin_bit_cast(i32x4, acc[ai][bj][m][n]), 0, 0, 0)); \
        } else if constexpr (MODE == 1) { _Pragma("unroll") for (int m = 0; m < 4; ++m) _Pragma("unroll") for (int n = 0; n < 2; ++n) \
        asm volatile("v_mfma_f32_16x16x128_f8f6f4 %0, %1, %2, %0" : "+v"(acc[ai][bj][m][n]) : "v"(cat8(Bt[n][0], Bt[n][1])), "v"(cat8(At[m][0], At[m][1]))); } else { \
        _Pragma("unroll") for (int m = 0; m < 4; ++m) _Pragma("unroll") for (int n = 0; n < 2; ++n) _Pragma("unroll") for (int k = 0; k < 2; ++k) \
        acc[ai][bj][m][n] = __builtin_amdgcn_mfma_f32_16x16x32_bf16(Bt[n][k], At[m][k], acc[ai][bj][m][n], 0, 0, 0); } __builtin_amdgcn_s_setprio(0); } while (0)
#define PG8_WAIT_V(n) asm volatile("s_waitcnt vmcnt(" #n ")" ::: "memory")
#define PG8_WAIT_L(n) asm volatile("s_waitcnt lgkmcnt(" #n ")" ::: "memory")
#define PG8_BAR __builtin_amdgcn_s_barrier()
#define PG8_SCHED __builtin_amdgcn_sched_barrier(0)
    Unit cur, nxt; int ui = 0;
    if (!S.next(0, cur)) return;
    f32x4 acc[2][2][4][2];
#pragma unroll
    for (int a = 0; a < 2; ++a)
#pragma unroll
        for (int b = 0; b < 2; ++b)
#pragma unroll
            for (int m = 0; m < 4; ++m)
#pragma unroll
                for (int n = 0; n < 2; ++n) acc[a][b][m][n] = (f32x4){0.f, 0.f, 0.f, 0.f};
    bf16x8 At[4][2], B0[2][2], B1[2][2];
    unsigned vA[2][2], nvA[2][2];
    LAS unsigned char* side = lds + STAGE_BYTES;
    LAS int* lte = (LAS int*)(side + 5120);
#define PG8_TSRC(sl) ((LAS int*)(side + (sl) * 1024))
#define PG8_TBIAS(sl) ((LAS float*)(side + 2048 + (sl) * 1024))
#define PG8_TAUX(sl) ((LAS float*)(side + 8192 + (sl) * 1024))
    if constexpr (Src::SIDE) { X.load_map(lte, S.nM); __syncthreads(); }
    X.a_voff(cur, Rr, Cc, vA);
    E.side_issue(cur, PG8_TBIAS(0), PG8_TAUX(0), lte, wid, lane);
    const char* cA = X.a_base(cur); const char* cB = X.b_base(cur, lte);
    PG8_STAGE(PG8_SB(0, 0), cB, voffB); PG8_STAGE(PG8_SB(0, 1), cB + hstep, voffB); PG8_STAGE(PG8_SA(0, 0), cA, vA[0]); PG8_STAGE(PG8_SA(0, 1), cA, vA[1]);
    if (wr == 1) PG8_BAR;
    PG8_WAIT_V(2); PG8_BAR;
    PG8_STAGE(PG8_SB(1, 0), cB + kstep, voffB); PG8_STAGE(PG8_SA(1, 0), cA + kstep, vA[0]); PG8_STAGE(PG8_SB(1, 1), cB + hstep + kstep, voffB);
    PG8_WAIT_V(6); PG8_BAR;
    for (;;) {
        const bool has_next = S.next(ui + 1, nxt);
        const char* nA = cA; const char* nB = cB;
#pragma unroll
        for (int h = 0; h < 2; ++h)
#pragma unroll
            for (int i = 0; i < 2; ++i) nvA[h][i] = vA[h][i];
        const int tsl = (ui + 1) & 1, bsl = (ui + 1) % 3;
        if (has_next) { nA = X.a_base(nxt); nB = X.b_base(nxt, lte); X.side_issue(nxt, PG8_TSRC(tsl), wid, lane); E.side_issue(nxt, PG8_TBIAS(bsl), PG8_TAUX(bsl), lte, wid, lane); }
        for (int t = 0; t < nt; t += 2) {
            const bool last = (t == nt - 2);
            const char* a1 = cA + (size_t)(t + 1) * kstep;
            const char* a2 = last ? nA : cA + (size_t)(t + 2) * kstep; const char* b2 = last ? nB : cB + (size_t)(t + 2) * kstep;
            const char* a3 = a2 + kstep; const char* b3 = b2 + kstep;
            unsigned w0[2], w1[2];
            if (last && has_next) X.a_voff_side(nxt, PG8_TSRC(tsl), Rr, Cc, nvA);
            w0[0] = last ? nvA[0][0] : vA[0][0]; w0[1] = last ? nvA[0][1] : vA[0][1];
            w1[0] = last ? nvA[1][0] : vA[1][0]; w1[1] = last ? nvA[1][1] : vA[1][1];
            PG8_LDB(B0, 0, 0); PG8_LDB(B1, 0, 1); PG8_SCHED; PG8_LDA(At, 0, 0); PG8_STAGE(PG8_SA(1, 1), a1, vA[1]);
            PG8_WAIT_V(8); PG8_WAIT_L(0); PG8_BAR; PG8_MMA(0, 0, At, B0); PG8_MMA(0, 1, At, B1); PG8_BAR; PG8_SCHED;
            PG8_LDA(At, 0, 1); PG8_STAGE(PG8_SB(0, 0), b2, voffB); PG8_STAGE(PG8_SB(0, 1), b2 + hstep, voffB); PG8_STAGE(PG8_SA(0, 0), a2, w0);
            PG8_WAIT_V(8); PG8_WAIT_L(0); PG8_BAR; PG8_MMA(1, 0, At, B0); PG8_MMA(1, 1, At, B1); PG8_BAR; PG8_SCHED;
            PG8_LDB(B0, 1, 0); PG8_LDB(B1, 1, 1); PG8_SCHED; PG8_LDA(At, 1, 0); PG8_STAGE(PG8_SA(0, 1), a2, w1);
            PG8_WAIT_V(8); PG8_WAIT_L(0); PG8_BAR; PG8_MMA(0, 0, At, B0); PG8_MMA(0, 1, At, B1); PG8_BAR; PG8_SCHED;
            PG8_LDA(At, 1, 1); PG8_STAGE(PG8_SB(1, 0), b3, voffB); PG8_STAGE(PG8_SB(1, 1), b3 + hstep, voffB); PG8_STAGE(PG8_SA(1, 0), a3, w0);
            PG8_WAIT_V(8); PG8_WAIT_L(0); PG8_BAR; PG8_MMA(1, 0, At, B0); PG8_MMA(1, 1, At, B1); PG8_BAR; PG8_SCHED;
        }
        if (wr == 0) PG8_BAR;
        if constexpr (MODE == 1) asm volatile("s_nop 15\n\ts_nop 15\n\ts_nop 15" ::: "memory");
        E(acc, cur, wr, wc, fr, fq, PG8_TBIAS(ui % 3), PG8_TAUX(ui % 3), lte);
        if (!has_next) break;
#pragma unroll
        for (int a = 0; a < 2; ++a)
#pragma unroll
            for (int b = 0; b < 2; ++b)
#pragma unroll
                for (int m = 0; m < 4; ++m)
#pragma unroll
                    for (int n = 0; n < 2; ++n) acc[a][b][m][n] = (f32x4){0.f, 0.f, 0.f, 0.f};
        cur = nxt; cA = nA; cB = nB; ++ui;
#pragma unroll
        for (int h = 0; h < 2; ++h)
#pragma unroll
            for (int i = 0; i < 2; ++i) vA[h][i] = nvA[h][i];
        if (wr == 1) PG8_BAR;
    }
    PG8_WAIT_V(0);
    PG8_BAR;
#undef PG8_TSRC
#undef PG8_TBIAS
#undef PG8_TAUX
#undef PG8_SA
#undef PG8_SB
#undef PG8_STAGE
#undef PG8_LDA
#undef PG8_LDB
#undef PG8_MMA
#undef PG8_WAIT_V
#undef PG8_WAIT_L
#undef PG8_BAR
#undef PG8_SCHED
}

struct EpiProj {
    static constexpr bool PERM = true;
    bf16_t* O; int ldc; float sc;
    __device__ __forceinline__ void side_issue(const Unit&, LAS float*, LAS float*, const LAS int*, int, int) const {}
    __device__ __forceinline__ void operator()(const f32x4 (&acc)[2][2][4][2], const Unit& u, int wr, int wc, int fr, int fq, const LAS float*, const LAS float*, const LAS int*) const {
        const int row0 = u.pm * BM + wr * 64 + fr, col0 = u.pn * BM + wc * 32 + 8 * fq;
#pragma unroll
        for (int ai = 0; ai < 2; ++ai)
#pragma unroll
            for (int m = 0; m < 4; ++m) { bf16_t* rowp = O + (size_t)(row0 + ai * HALF + m * 16) * ldc + col0;
#pragma unroll
                for (int bj = 0; bj < 2; ++bj) { const f32x4 v0 = acc[ai][bj][m][0] * sc, v1 = acc[ai][bj][m][1] * sc;
                    u32x4 w; w.x = cvt_pk_bf16(v0[0], v0[1]); w.y = cvt_pk_bf16(v0[2], v0[3]); w.z = cvt_pk_bf16(v1[0], v1[1]); w.w = cvt_pk_bf16(v1[2], v1[3]);
                    *(u32x4*)(rowp + bj * HALF) = w; } }
    }
};
struct EpiProjI8 {
    static constexpr bool PERM = true;
    bf16_t* O; int ldc; const float* rs; const float* cmax;
    __device__ __forceinline__ void side_issue(const Unit& u, LAS float* bt, LAS float* aux, const LAS int*, int wid, int lane) const {
        if (wid < 4) __builtin_amdgcn_global_load_lds((const unsigned*)(rs + u.pm * BM + wid * 64 + lane), (LAS unsigned*)(aux + wid * 64), 4, 0, 0);
        else __builtin_amdgcn_global_load_lds((const unsigned*)(cmax + u.pn * BM + (wid - 4) * 64 + lane), (LAS unsigned*)(bt + (wid - 4) * 64), 4, 0, 0);
    }
    __device__ __forceinline__ void operator()(const f32x4 (&acc)[2][2][4][2], const Unit& u, int wr, int wc, int fr, int fq, const LAS float* bt, const LAS float* aux, const LAS int*) const {
        const int row0 = u.pm * BM + wr * 64 + fr, col0 = u.pn * BM + wc * 32 + 8 * fq;
        f32x4 cs[2][2];
#pragma unroll
        for (int bj = 0; bj < 2; ++bj)
#pragma unroll
            for (int n = 0; n < 2; ++n) cs[bj][n] = *(const LAS f32x4*)(bt + wc * 32 + 8 * fq + bj * HALF + n * 4) * (1.0f / 127.0f);
#pragma unroll
        for (int ai = 0; ai < 2; ++ai)
#pragma unroll
            for (int m = 0; m < 4; ++m) { const int row = row0 + ai * HALF + m * 16; bf16_t* rowp = O + (size_t)row * ldc + col0; const float r = aux[wr * 64 + fr + ai * HALF + m * 16];
#pragma unroll
                for (int bj = 0; bj < 2; ++bj) { const i32x4 a0 = __builtin_bit_cast(i32x4, acc[ai][bj][m][0]), a1 = __builtin_bit_cast(i32x4, acc[ai][bj][m][1]);
                    const f32x4 c0 = cs[bj][0] * r, c1 = cs[bj][1] * r;
                    u32x4 w; w.x = cvt_pk_bf16((float)a0[0] * c0[0], (float)a0[1] * c0[1]); w.y = cvt_pk_bf16((float)a0[2] * c0[2], (float)a0[3] * c0[3]);
                    w.z = cvt_pk_bf16((float)a1[0] * c1[0], (float)a1[1] * c1[1]); w.w = cvt_pk_bf16((float)a1[2] * c1[2], (float)a1[3] * c1[3]);
                    *(u32x4*)(rowp + bj * HALF) = w; } }
    }
};
struct EpiResid {
    static constexpr bool PERM = false;
    const float* x; bf16_t* x1; const float* gate; float sc;
    __device__ __forceinline__ void side_issue(const Unit&, LAS float*, LAS float*, const LAS int*, int, int) const {}
    __device__ __forceinline__ void operator()(const f32x4 (&acc)[2][2][4][2], const Unit& u, int wr, int wc, int fr, int fq, const LAS float*, const LAS float*, const LAS int*) const {
        const int row0 = u.pm * BM + wr * 64 + fr, col0 = u.pn * BM + wc * 32 + 4 * fq;
        const float* gp = gate + ((u.pm * BM) >> 13) * 12288 + col0;
        f32x4 gv[2][2];
#pragma unroll
        for (int bj = 0; bj < 2; ++bj)
#pragma unroll
            for (int n = 0; n < 2; ++n) gv[bj][n] = *(const f32x4*)(gp + bj * HALF + n * 16) * sc;
#pragma unroll
        for (int ai = 0; ai < 2; ++ai) {
            f32x4 xs[4][2][2];
#pragma unroll
            for (int m = 0; m < 4; ++m) { const size_t off = (size_t)(row0 + ai * HALF + m * 16) * 2048 + col0;
#pragma unroll
                for (int bj = 0; bj < 2; ++bj)
#pragma unroll
                    for (int n = 0; n < 2; ++n) xs[m][bj][n] = *(const f32x4*)(x + off + bj * HALF + n * 16); }
#pragma unroll
            for (int m = 0; m < 4; ++m) { const size_t off = (size_t)(row0 + ai * HALF + m * 16) * 2048 + col0;
#pragma unroll
                for (int bj = 0; bj < 2; ++bj)
#pragma unroll
                    for (int n = 0; n < 2; ++n) { const f32x4 r = xs[m][bj][n] + gv[bj][n] * acc[ai][bj][m][n];
                        u32x2 w; w.x = cvt_pk_bf16(r[0], r[1]); w.y = cvt_pk_bf16(r[2], r[3]); *(u32x2*)(x1 + off + bj * HALF + n * 16) = w; } }
            asm volatile("" ::: "memory"); }
    }
};
struct EpiResidI8 {
    static constexpr bool PERM = false;
    const float* x; bf16_t* x1; const float* gate; const float* rs; const float* cmax;
    __device__ __forceinline__ void side_issue(const Unit&, LAS float*, LAS float*, const LAS int*, int, int) const {}
    __device__ __forceinline__ void operator()(const f32x4 (&acc)[2][2][4][2], const Unit& u, int wr, int wc, int fr, int fq, const LAS float* bt, const LAS float* aux, const LAS int*) const {
        const int row0 = u.pm * BM + wr * 64 + fr, col0 = u.pn * BM + wc * 32 + 4 * fq;
        const float* gp = gate + ((u.pm * BM) >> 13) * 12288 + col0;
        f32x4 gv[2][2];
#pragma unroll
        for (int bj = 0; bj < 2; ++bj)
#pragma unroll
            for (int n = 0; n < 2; ++n) gv[bj][n] = *(const f32x4*)(gp + bj * HALF + n * 16) * *(const f32x4*)(cmax + col0 + bj * HALF + n * 16) * (1.0f / 127.0f);
#pragma unroll
        for (int ai = 0; ai < 2; ++ai) {
            f32x4 xs[4][2][2]; float rr[4];
#pragma unroll
            for (int m = 0; m < 4; ++m) { const size_t off = (size_t)(row0 + ai * HALF + m * 16) * 2048 + col0; rr[m] = rs[row0 + ai * HALF + m * 16];
#pragma unroll
                for (int bj = 0; bj < 2; ++bj)
#pragma unroll
                    for (int n = 0; n < 2; ++n) xs[m][bj][n] = *(const f32x4*)(x + off + bj * HALF + n * 16); }
#pragma unroll
            for (int m = 0; m < 4; ++m) { const size_t off = (size_t)(row0 + ai * HALF + m * 16) * 2048 + col0;
#pragma unroll
                for (int bj = 0; bj < 2; ++bj)
#pragma unroll
                    for (int n = 0; n < 2; ++n) { const i32x4 a = __builtin_bit_cast(i32x4, acc[ai][bj][m][n]); const f32x4 g = gv[bj][n] * rr[m];
                        const f32x4 r = xs[m][bj][n] + g * (f32x4){(float)a[0], (float)a[1], (float)a[2], (float)a[3]};
                        u32x2 w; w.x = cvt_pk_bf16(r[0], r[1]); w.y = cvt_pk_bf16(r[2], r[3]); *(u32x2*)(x1 + off + bj * HALF + n * 16) = w; } }
            asm volatile("" ::: "memory"); }
    }
};
struct EpiGlu {
    static constexpr bool PERM = true;
    unsigned char* O; const float* b_gu;
    __device__ __forceinline__ void side_issue(const Unit& u, LAS float* bt, LAS float*, const LAS int* lte, int wid, int lane) const {
        if (wid >= 4) { const int w4 = wid - 4, e = lte[u.pm];
            __builtin_amdgcn_global_load_lds((const unsigned*)(b_gu + (size_t)e * 4096 + (w4 >> 1) * 2048 + u.pn * HALF + (w4 & 1) * 64 + lane), (LAS unsigned*)(bt + w4 * 64), 4, 0, 0); }
    }
    __device__ __forceinline__ void operator()(const f32x4 (&acc)[2][2][4][2], const Unit& u, int wr, int wc, int fr, int fq, const LAS float* bt, const LAS float*, const LAS int*) const {
        const int row0 = u.pm * BM + wr * 64 + fr, col0 = u.pn * HALF + wc * 32 + 8 * fq;
        f32x2 bg4[2][2], bl1[2][2];
#pragma unroll
        for (int n = 0; n < 2; ++n) { const f32x4 g = *(const LAS f32x4*)(bt + wc * 32 + 8 * fq + 4 * n), l = *(const LAS f32x4*)(bt + HALF + wc * 32 + 8 * fq + 4 * n);
            bg4[n][0] = (f32x2){4.0f * g[0], 4.0f * g[1]}; bg4[n][1] = (f32x2){4.0f * g[2], 4.0f * g[3]}; bl1[n][0] = (f32x2){l[0] + 1.0f, l[1] + 1.0f}; bl1[n][1] = (f32x2){l[2] + 1.0f, l[3] + 1.0f}; }
#pragma unroll
        for (int ai = 0; ai < 2; ++ai)
#pragma unroll
            for (int m = 0; m < 4; ++m) { unsigned char* rowp = O + (size_t)(row0 + ai * HALF + m * 16) * 2048 + col0;
                f32x2 r[4];
#pragma unroll
                for (int n = 0; n < 2; ++n)
#pragma unroll
                    for (int hp = 0; hp < 2; ++hp) {
                        const f32x2 ga = (f32x2){acc[ai][0][m][n][2 * hp], acc[ai][0][m][n][2 * hp + 1]}, la = (f32x2){acc[ai][1][m][n][2 * hp], acc[ai][1][m][n][2 * hp + 1]};
                        f32x2 g4 = ga * (4.0f / 64.0f) + bg4[n][hp]; g4[0] = fminf(g4[0], 28.0f); g4[1] = fminf(g4[1], 28.0f);
                        f32x2 l1 = la * (1.0f / 64.0f) + bl1[n][hp]; l1[0] = __builtin_amdgcn_fmed3f(l1[0], -6.0f, 8.0f); l1[1] = __builtin_amdgcn_fmed3f(l1[1], -6.0f, 8.0f);
                        const f32x2 z = g4 * (-1.702f * LOG2E * 0.25f);
                        f32x2 d = (f32x2){__builtin_amdgcn_exp2f(z[0]), __builtin_amdgcn_exp2f(z[1])} + 1.0f;
                        const f32x2 sg = (f32x2){__builtin_amdgcn_rcpf(d[0]), __builtin_amdgcn_rcpf(d[1])};
                        r[n * 2 + hp] = (g4 * sg) * l1; }
                u32x2 w; w.x = pack4_fp8(r[0][0], r[0][1], r[1][0], r[1][1]); w.y = pack4_fp8(r[2][0], r[2][1], r[3][0], r[3][1]);
                *(u32x2*)rowp = w; }
    }
};
struct EpiDown {
    static constexpr bool PERM = true;
    unsigned char* O; const float* b_down;
    __device__ __forceinline__ void side_issue(const Unit& u, LAS float* bt, LAS float*, const LAS int* lte, int wid, int lane) const {
        if (wid >= 4) { const int w4 = wid - 4, e = lte[u.pm];
            __builtin_amdgcn_global_load_lds((const unsigned*)(b_down + (size_t)e * 2048 + u.pn * BM + w4 * 64 + lane), (LAS unsigned*)(bt + w4 * 64), 4, 0, 0); }
    }
    __device__ __forceinline__ void operator()(const f32x4 (&acc)[2][2][4][2], const Unit& u, int wr, int wc, int fr, int fq, const LAS float* bt, const LAS float*, const LAS int*) const {
        const int row0 = u.pm * BM + wr * 64 + fr, col0 = u.pn * BM + wc * 32 + 8 * fq;
        f32x4 bv[2][2];
#pragma unroll
        for (int bj = 0; bj < 2; ++bj)
#pragma unroll
            for (int n = 0; n < 2; ++n) bv[bj][n] = *(const LAS f32x4*)(bt + bj * HALF + wc * 32 + 8 * fq + 4 * n) * 16.0f;
#pragma unroll
        for (int ai = 0; ai < 2; ++ai)
#pragma unroll
            for (int m = 0; m < 4; ++m) { unsigned char* rowp = O + (size_t)(row0 + ai * HALF + m * 16) * 2048 + col0;
#pragma unroll
                for (int bj = 0; bj < 2; ++bj) { const f32x4 v0 = acc[ai][bj][m][0] * (16.0f / 256.0f) + bv[bj][0], v1 = acc[ai][bj][m][1] * (16.0f / 256.0f) + bv[bj][1];
                    u32x2 w; w.x = pack4_fp8(v0[0], v0[1], v0[2], v0[3]); w.y = pack4_fp8(v1[0], v1[1], v1[2], v1[3]);
                    *(u32x2*)(rowp + bj * HALF) = w; } }
    }
};
}

struct Frame {
    LAS unsigned char* lds; int tid, lane, wave, G, bid;
    unsigned char* ws;
};
#define WSP(T, off) ((T*)(F.ws + (off)))

struct TileInfo { const float* src; unsigned char* dst; int ld, colA, colB, f8, n0, pad_; };
__device__ __forceinline__ TileInfo conv_decode(const Params& p, const Frame& F, int i) {
    TileInfo t;
    if (i < 896) { const int kt = i / 28, nt = i % 28, r0 = nt * 256; t.colA = r0 < 3072 ? r0 : r0 + 8; t.colB = t.colA + 128; t.ld = 7176;
        t.src = p.w_in + (size_t)kt * 64 * 7176; t.f8 = IN_MODE; t.n0 = r0; t.pad_ = 0; t.dst = F.ws + WS_WIN + (IN_MODE ? (size_t)r0 * 2048 + kt * 64 : ((size_t)r0 * 2048 + kt * 64) * 2); }
    else { const int j = i - 896, kt = j / 8, nt = j % 8; t.colA = nt * 256; t.colB = t.colA + 128; t.ld = 2048;
        t.src = p.w_out + (size_t)kt * 64 * 2048; t.f8 = OUT_MODE; t.n0 = NPROJ + nt * 256; t.pad_ = 0; t.dst = F.ws + WS_WOUT + (OUT_MODE ? (size_t)nt * 256 * 2048 + kt * 64 : ((size_t)nt * 256 * 2048 + kt * 64) * 2); }
    return t;
}
constexpr int CONV_TILES = 1152;
constexpr int CONV8_TILES = 16384 + 8192;
struct Tile8 { const float* src; unsigned char* dst; int ld; };
__device__ __forceinline__ Tile8 conv8_decode(const Params& p, const Frame& F, int i) {
    Tile8 t;
    if (i < 16384) { const int e = i / 512, r = i % 512, kt = r / 32, nt = r % 32, pn = nt >> 1, half = nt & 1; t.ld = 4096;
        t.src = p.w_gu + (size_t)e * 2048 * 4096 + (size_t)kt * 128 * 4096 + half * 2048 + pn * 128; t.dst = F.ws + WS_WGU + ((size_t)e * 4096 + nt * 128) * 2048 + kt * 128; }
    else { const int j = i - 16384, e = j / 256, r = j % 256, kt = r / 16, nt = r % 16; t.ld = 2048;
        t.src = p.w_down + (size_t)e * 2048 * 2048 + (size_t)kt * 128 * 2048 + nt * 128; t.dst = F.ws + WS_WDN + ((size_t)e * 2048 + nt * 128) * 2048 + kt * 128; }
    return t;
}
__device__ __forceinline__ void conv8_load(const Tile8& t, int g, int kq, f32x4 (&L)[2][4]) {
#pragma unroll
    for (int i = 0; i < 2; ++i)
#pragma unroll
        for (int r = 0; r < 4; ++r) L[i][r] = __builtin_nontemporal_load((const f32x4*)(t.src + (size_t)(4 * (kq + 16 * i) + r) * t.ld + 4 * g));
}
__device__ __forceinline__ void conv_load(const TileInfo& t, int g, int kq, f32x4 (&L)[4][2]) {
    const int col = g < 32 ? t.colA + 4 * g : t.colB + 4 * (g - 32);
#pragma unroll
    for (int i = 0; i < 4; ++i) { const int k0 = t.f8 ? 4 * (kq + 8 * (i >> 1)) + 2 * (i & 1) : 2 * (kq + 8 * i);
        L[i][0] = *(const f32x4*)(t.src + (size_t)k0 * t.ld + col);
        L[i][1] = *(const f32x4*)(t.src + (size_t)(k0 + 1) * t.ld + col); }
}
template <int KIND>
__device__ __forceinline__ void wtile_pass(const Params& p, const Frame& F, int lo, int hi) {
    const int tid = F.tid;
    LAS unsigned* tt = (LAS unsigned*)F.lds;
    const int g = tid & 63, kq = tid >> 6;
    f32x4 cur[4][2], nxt[4][2];
    int i = lo + F.bid;
    TileInfo ti;
    if (i < hi) { ti = conv_decode(p, F, i); conv_load(ti, g, kq, cur); }
    while (i < hi) {
        const int inext = i + F.G;
        TileInfo tn = ti;
        if (inext < hi) { tn = conv_decode(p, F, inext); conv_load(tn, g, kq, nxt); }
        if constexpr (KIND == 1) {
            f32x4 m = __builtin_elementwise_max(__builtin_elementwise_abs(cur[0][0]), __builtin_elementwise_abs(cur[0][1]));
#pragma unroll
            for (int q = 1; q < 4; ++q) m = __builtin_elementwise_max(m, __builtin_elementwise_max(__builtin_elementwise_abs(cur[q][0]), __builtin_elementwise_abs(cur[q][1])));
            *(LAS f32x4*)((LAS float*)tt + kq * 256 + 4 * g) = m;
            __syncthreads();
            if (tid < 256) { float v = ((LAS float*)tt)[tid];
#pragma unroll
                for (int w = 1; w < 8; ++w) v = fmaxf(v, ((LAS float*)tt)[w * 256 + tid]);
                __hip_atomic_fetch_max((unsigned*)(F.ws + WS_CMAX) + ti.n0 + tid, __float_as_uint(v), __ATOMIC_RELAXED, __HIP_MEMORY_SCOPE_AGENT); }
        } else if (ti.f8 == 2) {
            const f32x4 cm = *(const f32x4*)((const float*)(F.ws + WS_CMAX) + ti.n0 + 4 * g);
            f32x4 inv;
#pragma unroll
            for (int j = 0; j < 4; ++j) inv[j] = cm[j] > 0.f ? 127.0f / cm[j] : 0.f;
#pragma unroll
            for (int q = 0; q < 2; ++q)
#pragma unroll
                for (int j = 0; j < 4; ++j) tt[(4 * g + j) * 17 + kq + 8 * q] = pack4_i8(inv[j] * cur[2 * q][0][j], inv[j] * cur[2 * q][1][j], inv[j] * cur[2 * q + 1][0][j], inv[j] * cur[2 * q + 1][1][j]);
            __syncthreads();
#pragma unroll
            for (int r = 0; r < 2; ++r) { const int q = tid + 512 * r, n = q >> 2, ch = q & 3;
                u32x4 v; v.x = tt[n * 17 + ch * 4 + 0]; v.y = tt[n * 17 + ch * 4 + 1]; v.z = tt[n * 17 + ch * 4 + 2]; v.w = tt[n * 17 + ch * 4 + 3];
                *(u32x4*)(ti.dst + (size_t)n * 2048 + ch * 16) = v; }
        } else if (ti.f8) {
#pragma unroll
            for (int q = 0; q < 2; ++q)
#pragma unroll
                for (int j = 0; j < 4; ++j) tt[(4 * g + j) * 17 + kq + 8 * q] = pack4_fp8(64.0f * cur[2 * q][0][j], 64.0f * cur[2 * q][1][j], 64.0f * cur[2 * q + 1][0][j], 64.0f * cur[2 * q + 1][1][j]);
            __syncthreads();
#pragma unroll
            for (int r = 0; r < 2; ++r) { const int q = tid + 512 * r, n = q >> 2, ch = q & 3;
                u32x4 v; v.x = tt[n * 17 + ch * 4 + 0]; v.y = tt[n * 17 + ch * 4 + 1]; v.z = tt[n * 17 + ch * 4 + 2]; v.w = tt[n * 17 + ch * 4 + 3];
                *(u32x4*)(ti.dst + (size_t)n * 2048 + ch * 16) = v; }
        } else {
#pragma unroll
            for (int q = 0; q < 4; ++q)
#pragma unroll
                for (int j = 0; j < 4; ++j) tt[(4 * g + j) * 33 + kq + 8 * q] = cvt_pk_bf16(cur[q][0][j], cur[q][1][j]);
            __syncthreads();
#pragma unroll
            for (int r = 0; r < 4; ++r) { const int q = tid + 512 * r, n = q >> 3, ch = q & 7;
                u32x4 v; v.x = tt[n * 33 + ch * 4 + 0]; v.y = tt[n * 33 + ch * 4 + 1]; v.z = tt[n * 33 + ch * 4 + 2]; v.w = tt[n * 33 + ch * 4 + 3];
                *(u32x4*)(ti.dst + (size_t)n * 4096 + ch * 16) = v; }
        }
        __syncthreads();
#pragma unroll
        for (int q = 0; q < 4; ++q) { cur[q][0] = nxt[q][0]; cur[q][1] = nxt[q][1]; }
        ti = tn; i = inext;
    }
}


__device__ __forceinline__ void phase0(const Params& p, const Frame& F) {
    const int tid = F.tid;
    LAS float* cs = (LAS float*)F.lds;
    LAS float* red = cs + 4096;
    for (int i = tid; i < 4096; i += 512) { const float v = p.c[i]; cs[i] = v / (1.0f + expf(-v)); }
    __syncthreads();
    float* modp = WSP(float, WS_MODP);
    for (int u = F.bid; u < 384; u += F.G) {
        const int cc = u % 48, dc = u / 48, w = F.wave, lane = F.lane;
        const int d0 = dc * 256 + w * 32;
        const float* wp = p.w_ada + (size_t)d0 * 12288 + cc * 256 + lane * 4;
        f32x4 a0 = {0.f, 0.f, 0.f, 0.f}, a1 = {0.f, 0.f, 0.f, 0.f};
#pragma unroll 8
        for (int i = 0; i < 32; ++i) { const f32x4 v = *(const f32x4*)(wp + (size_t)i * 12288); const float c0 = cs[d0 + i], c1 = cs[2048 + d0 + i]; a0 += v * c0; a1 += v * c1; }
        *(LAS f32x4*)(red + (w * 2 + 0) * 256 + lane * 4) = a0;
        *(LAS f32x4*)(red + (w * 2 + 1) * 256 + lane * 4) = a1;
        __syncthreads();
        { const int b = tid >> 8, col = tid & 255; float s = 0.f;
#pragma unroll
          for (int w8 = 0; w8 < 8; ++w8) s += red[(w8 * 2 + b) * 256 + col];
          modp[(dc * 2 + b) * 12288 + cc * 256 + col] = s; }
        __syncthreads();
    }
#if IN_MODE == 2 && OUT_MODE == 2
    wtile_pass<1>(p, F, 0, CONV_TILES);
#elif IN_MODE == 2
    wtile_pass<1>(p, F, 0, 896);
    wtile_pass<0>(p, F, 896, CONV_TILES);
#else
    wtile_pass<0>(p, F, 0, CONV_TILES);
#endif
}

__device__ __forceinline__ void conv8_range(const Params& p, const Frame& F, int first, int stride) {
    const int tid = F.tid;
    LAS unsigned* tt = (LAS unsigned*)F.lds;
    const int g8 = tid & 31, kq8 = tid >> 5;
    f32x4 r0[2][4], r1[2][4], r2[2][4], r3[2][4], r4[2][4]; Tile8 t0, t1, t2, t3, t4;
#define C8_PROCESS(R, T) do { \
        _Pragma("unroll") for (int q = 0; q < 2; ++q) _Pragma("unroll") for (int j = 0; j < 4; ++j) \
            tt[(4 * g8 + j) * 33 + kq8 + 16 * q] = pack4_fp8(64.0f * R[q][0][j], 64.0f * R[q][1][j], 64.0f * R[q][2][j], 64.0f * R[q][3][j]); \
        __syncthreads(); \
        _Pragma("unroll") for (int r = 0; r < 2; ++r) { const int q = tid + 512 * r, n = q >> 3, ch = q & 7; \
            u32x4 v; v.x = tt[n * 33 + ch * 4 + 0]; v.y = tt[n * 33 + ch * 4 + 1]; v.z = tt[n * 33 + ch * 4 + 2]; v.w = tt[n * 33 + ch * 4 + 3]; \
            __builtin_nontemporal_store(v, (u32x4*)(T.dst + (size_t)n * 2048 + ch * 16)); } \
        __syncthreads(); } while (0)
#define C8_FETCH(R, T, idx) do { if ((idx) < CONV8_TILES) { T = conv8_decode(p, F, (idx)); conv8_load(T, g8, kq8, R); } } while (0)
    int i = first;
    C8_FETCH(r0, t0, i); C8_FETCH(r1, t1, i + stride); C8_FETCH(r2, t2, i + 2 * stride); C8_FETCH(r3, t3, i + 3 * stride);
    for (;;) {
        if (i >= CONV8_TILES) break;
        C8_FETCH(r4, t4, i + 4 * stride); C8_PROCESS(r0, t0); i += stride;
        if (i >= CONV8_TILES) break;
        C8_FETCH(r0, t0, i + 4 * stride); C8_PROCESS(r1, t1); i += stride;
        if (i >= CONV8_TILES) break;
        C8_FETCH(r1, t1, i + 4 * stride); C8_PROCESS(r2, t2); i += stride;
        if (i >= CONV8_TILES) break;
        C8_FETCH(r2, t2, i + 4 * stride); C8_PROCESS(r3, t3); i += stride;
        if (i >= CONV8_TILES) break;
        C8_FETCH(r3, t3, i + 4 * stride); C8_PROCESS(r4, t4); i += stride;
    }
#undef C8_FETCH
#undef C8_PROCESS
}

__device__ __forceinline__ void phase1(const Params& p, const Frame& F) {
    const int tid = F.tid, lane = F.lane;
    LAS float* wfT = (LAS float*)F.lds;
    LAS float* a1 = wfT + 8 * 2048;
    LAS float* s1 = a1 + 4096;
    const float* modp = WSP(float, WS_MODP);
    for (int q = tid; q < 4096; q += 512) { const int d = q >> 1, hf = q & 1; const f32x4 v = *(const f32x4*)(p.w_in + (size_t)d * 7176 + 3072 + hf * 4);
#pragma unroll
        for (int j = 0; j < 4; ++j) wfT[(hf * 4 + j) * 2048 + d] = v[j]; }
    for (int q = tid; q < 8192; q += 512) { const int b = q >> 12, r = q & 4095; float s = p.b_ada[r];
#pragma unroll
        for (int dc = 0; dc < 8; ++dc) s += modp[(dc * 2 + b) * 12288 + r];
        if (r < 2048) s1[b * 2048 + r] = s; else a1[b * 2048 + (r - 2048)] = p.g1[r - 2048] * (1.0f + s); }
    float* mod = WSP(float, WS_MOD);
    for (int q = F.bid * 512 + tid; q < 24576; q += F.G * 512) { const int b = q / 12288, r = q % 12288; float s = p.b_ada[r];
#pragma unroll
        for (int dc = 0; dc < 8; ++dc) s += modp[(dc * 2 + b) * 12288 + r];
        mod[q] = s; }
    __syncthreads();
    bf16_t* H1 = WSP(bf16_t, WS_H1); float* LOGF = WSP(float, WS_LOGF);
    for (int t = F.bid * 8 + F.wave; t < T_; t += F.G * 8) {
        asm volatile("" ::: "memory");
        const int b = t >> 13;
        const float* xr = p.x + (size_t)t * 2048;
        f32x4 v[8]; float ss = 0.f;
#pragma unroll
        for (int i = 0; i < 8; ++i) { v[i] = *(const f32x4*)(xr + (i * 64 + lane) * 4); ss += v[i][0] * v[i][0] + v[i][1] * v[i][1] + v[i][2] * v[i][2] + v[i][3] * v[i][3]; }
        ss = wave_sum(ss);
        const float rstd = rsqrtf(ss * (1.0f / 2048.0f) + EPS);
        float acc[8];
#pragma unroll
        for (int j = 0; j < 8; ++j) acc[j] = 0.f;
#if IN_MODE == 2
        float amax = 0.f;
#pragma unroll
        for (int i = 0; i < 8; ++i) { const int d = (i * 64 + lane) * 4;
            const f32x4 a = *(const LAS f32x4*)(a1 + b * 2048 + d), s = *(const LAS f32x4*)(s1 + b * 2048 + d);
            const f32x4 h = v[i] * rstd * a + s;
            amax = fmaxf(fmaxf(amax, fmaxf(fabsf(h[0]), fabsf(h[1]))), fmaxf(fabsf(h[2]), fabsf(h[3]))); }
#pragma unroll
        for (int o = 32; o > 0; o >>= 1) amax = fmaxf(amax, __shfl_xor(amax, o));
        const float qinv = amax > 0.f ? 127.0f / amax : 0.f;
        if (lane == 0) WSP(float, WS_RS)[t] = amax * (1.0f / 127.0f);
        asm volatile("" ::: "memory");
#pragma unroll
        for (int i = 0; i < 8; ++i) { const int d = (i * 64 + lane) * 4;
            const f32x4 a = *(const LAS f32x4*)(a1 + b * 2048 + d), s = *(const LAS f32x4*)(s1 + b * 2048 + d);
            const f32x4 h = v[i] * rstd * a + s;
            *(unsigned*)((unsigned char*)H1 + (size_t)t * 2048 + d) = pack4_i8(qinv * h[0], qinv * h[1], qinv * h[2], qinv * h[3]);
#pragma unroll
            for (int j = 0; j < 8; ++j) { const f32x4 wv = *(const LAS f32x4*)(wfT + j * 2048 + d); acc[j] += h[0] * wv[0] + h[1] * wv[1] + h[2] * wv[2] + h[3] * wv[3]; } }
#else
#pragma unroll
        for (int i = 0; i < 8; ++i) { const int d = (i * 64 + lane) * 4;
            const f32x4 a = *(const LAS f32x4*)(a1 + b * 2048 + d), s = *(const LAS f32x4*)(s1 + b * 2048 + d);
            const f32x4 h = v[i] * rstd * a + s;
#if IN_MODE == 1
            *(unsigned*)((unsigned char*)H1 + (size_t)t * 2048 + d) = pack4_fp8(4.0f * h[0], 4.0f * h[1], 4.0f * h[2], 4.0f * h[3]);
#else
            u32x2 w; w.x = cvt_pk_bf16(h[0], h[1]); w.y = cvt_pk_bf16(h[2], h[3]);
            *(u32x2*)(H1 + (size_t)t * 2048 + d) = w;
#endif
#pragma unroll
            for (int j = 0; j < 8; ++j) { const f32x4 wv = *(const LAS f32x4*)(wfT + j * 2048 + d); acc[j] += h[0] * wv[0] + h[1] * wv[1] + h[2] * wv[2] + h[3] * wv[3]; } }
#endif
        float z = 0.f;
#pragma unroll
        for (int j = 0; j < 8; ++j) { const float r = wave_sum(acc[j]); if (lane == j) z = r; }
        if (lane < 8) { z += p.b_fgate[lane]; LOGF[(size_t)t * 8 + lane] = fminf(z, 0.f) - log1pf(expf(-fabsf(z))); }
    }
}

__device__ __forceinline__ void cum_scan(const Frame& F) {
    const int tid = F.tid;
    LAS float* sc = (LAS float*)F.lds;
    const float* LOGF = WSP(float, WS_LOGF); float* CUM = WSP(float, WS_CUM);
    for (int seq = F.bid; seq < 16; seq += F.G) { const int b = seq >> 3, h = seq & 7;
        float v[16]; float run = 0.f; const size_t base = (size_t)b * S_ + tid * 16;
#pragma unroll
        for (int i = 0; i < 16; ++i) { run += LOGF[(base + i) * 8 + h]; v[i] = run; }
        sc[tid] = run; __syncthreads();
        for (int off = 1; off < 512; off <<= 1) { const float tv = tid >= off ? sc[tid - off] : 0.f; __syncthreads(); sc[tid] += tv; __syncthreads(); }
        const float excl = tid ? sc[tid - 1] : 0.f;
#pragma unroll
        for (int i = 0; i < 16; ++i) CUM[(size_t)seq * S_ + tid * 16 + i] = excl + v[i];
        __syncthreads();
    }
}

constexpr int AT_KS = 288;
__device__ __forceinline__ void attn_unit(const Frame& F, int bh, int qb) {
    const int tid = F.tid, lane = F.lane, w = F.wave, fr = lane & 15, fq = lane >> 4;
    const int b = bh >> 3, h = bh & 7;
    const bf16_t* proj = WSP(bf16_t, WS_PROJ) + (size_t)b * S_ * NPROJ + h * 128;
    const bf16_t* Qp = proj + C_FQ; const bf16_t* Kp = proj + C_FK; const bf16_t* Vp = proj + C_FV;
    const float* cum = WSP(float, WS_CUM) + (size_t)bh * S_;
    LAS unsigned char* Kt = F.lds;
    LAS unsigned char* Vt = F.lds + 2 * 64 * AT_KS;
    LAS float* cs = (LAS float*)(F.lds + 4 * 64 * AT_KS);
    const int r0 = qb * 128 + w * 16;
    const int qpos = r0 + fr;
    bf16x8 qf[4];
#pragma unroll
    for (int ks = 0; ks < 4; ++ks) qf[ks] = *(const bf16x8*)(Qp + (size_t)qpos * NPROJ + ks * 32 + fq * 8);
    const float cq = cum[qpos] * LOG2E;
    const int ntiles = 2 * qb + 2;
    const float SC2 = 0.08838834764831845f * LOG2E;
    LAS float* wmax = cs + 128;
    LAS int* shi = (LAS int*)(cs + 136);
    float qn = 0.f, sdiag = 0.f;
    {
#pragma unroll
      for (int ks = 0; ks < 4; ++ks) { const u32x4 v = __builtin_bit_cast(u32x4, qf[ks]); const u32x4 kk = *(const u32x4*)(Kp + (size_t)qpos * NPROJ + ks * 32 + fq * 8);
          const float q0 = bflo(v.x), q1 = bfhi(v.x), q2 = bflo(v.y), q3 = bfhi(v.y), q4 = bflo(v.z), q5 = bfhi(v.z), q6 = bflo(v.w), q7 = bfhi(v.w);
          qn += q0 * q0 + q1 * q1 + q2 * q2 + q3 * q3 + q4 * q4 + q5 * q5 + q6 * q6 + q7 * q7;
          sdiag += q0 * bflo(kk.x) + q1 * bfhi(kk.x) + q2 * bflo(kk.y) + q3 * bfhi(kk.y) + q4 * bflo(kk.z) + q5 * bfhi(kk.z) + q6 * bflo(kk.w) + q7 * bfhi(kk.w); }
      qn += __shfl_xor(qn, 16); qn += __shfl_xor(qn, 32); sdiag += __shfl_xor(sdiag, 16); sdiag += __shfl_xor(sdiag, 32);
      if (tid < 2) shi[tid] = 0; }
    __syncthreads();
    float ce = 0.f;
    if (tid < ntiles) { const float kv = WSP(float, WS_KN)[bh * 128 + tid]; ce = cum[(tid + 1) * 64 - 1] * LOG2E; atomicMax((int*)(shi + 0), __float_as_int(kv)); }
    __syncthreads();
    { float rt = SC2 * sqrtf(qn) * sqrtf(__int_as_float(shi[0])) * 1.001f + cq - SC2 * sdiag;
#pragma unroll
      for (int o = 8; o >= 1; o >>= 1) rt = fmaxf(rt, __shfl_xor(rt, o));
      if (lane == 0) wmax[w] = rt; }
    __syncthreads();
    { float rmax = wmax[0];
#pragma unroll
      for (int i = 1; i < 8; ++i) rmax = fmaxf(rmax, wmax[i]);
      const float bound = rmax - ce + 0.02f;
      if (tid < 2 * qb && bound < -40.0f) atomicMax((int*)(shi + 1), tid + 1); }
    __syncthreads();
    const int j_lo = shi[1];
    float m = -1e30f, l = 0.f;
    f32x4 oT[8];
#pragma unroll
    for (int n = 0; n < 8; ++n) oT[n] = (f32x4){0.f, 0.f, 0.f, 0.f};
    const int skey = tid >> 3, sc16 = (tid & 7) * 16;
    u32x4 kA0, kA1, vA0, vA1, kB0, kB1, vB0, vB1; float cA = 0.f, cB = 0.f;
#define AT_LOAD(S_, j) do { const size_t ro = (size_t)((j) * 64 + skey) * NPROJ + sc16; \
        k##S_##0 = *(const u32x4*)(Kp + ro); k##S_##1 = *(const u32x4*)(Kp + ro + 8); v##S_##0 = *(const u32x4*)(Vp + ro); v##S_##1 = *(const u32x4*)(Vp + ro + 8); \
        if (tid < 64) c##S_ = cum[(j) * 64 + tid]; } while (0)
#define AT_WRITE(S_, buf) do { LAS unsigned char* kd = Kt + (buf) * 64 * AT_KS + skey * AT_KS + sc16 * 2; LAS unsigned char* vd = Vt + (buf) * 64 * AT_KS + skey * AT_KS + sc16 * 2; \
        *(LAS u32x4*)kd = k##S_##0; *(LAS u32x4*)(kd + 16) = k##S_##1; *(LAS u32x4*)vd = v##S_##0; *(LAS u32x4*)(vd + 16) = v##S_##1; if (tid < 64) cs[(buf) * 64 + tid] = c##S_ * LOG2E; } while (0)
#define AT_COMPUTE(j, buf) do { \
        const LAS unsigned char* kb = Kt + (buf) * 64 * AT_KS; \
        f32x4 st[4]; \
        _Pragma("unroll") for (int kt = 0; kt < 4; ++kt) { st[kt] = (f32x4){0.f, 0.f, 0.f, 0.f}; \
            _Pragma("unroll") for (int ks = 0; ks < 4; ++ks) { const bf16x8 a = *(const LAS bf16x8*)(kb + (kt * 16 + fr) * AT_KS + (ks * 32 + fq * 8) * 2); \
                st[kt] = __builtin_amdgcn_mfma_f32_16x16x32_bf16(a, qf[ks], st[kt], 0, 0, 0); } } \
        const int kbase = (j) * 64; \
        const bool diag = (kbase + 63 > r0); \
        float mx = -1e30f; \
        if (diag) {     \
            _Pragma("unroll") for (int kt = 0; kt < 4; ++kt) { const f32x4 ck = *(const LAS f32x4*)(cs + (buf) * 64 + kt * 16 + fq * 4); \
                _Pragma("unroll") for (int i = 0; i < 4; ++i) { float s2 = st[kt][i] * SC2 + (cq - ck[i]); \
                    if (kbase + kt * 16 + fq * 4 + i > qpos) s2 = -__builtin_inff(); \
                    st[kt][i] = s2; mx = fmaxf(mx, s2); } } \
        } else { \
            _Pragma("unroll") for (int kt = 0; kt < 4; ++kt) { const f32x4 ck = *(const LAS f32x4*)(cs + (buf) * 64 + kt * 16 + fq * 4); \
                _Pragma("unroll") for (int i = 0; i < 4; ++i) { const float s2 = st[kt][i] * SC2 + (cq - ck[i]); st[kt][i] = s2; mx = fmaxf(mx, s2); } } \
        } \
        mx = xmax16(mx); mx = xmax32(mx);     \
        const float mn = fmaxf(m, mx); \
        const float alpha = __builtin_amdgcn_exp2f(m - mn); \
        m = mn; \
        float ps = 0.f; \
        _Pragma("unroll") for (int kt = 0; kt < 4; ++kt) \
            _Pragma("unroll") for (int i = 0; i < 4; ++i) { const float pv = __builtin_amdgcn_exp2f(st[kt][i] - mn); st[kt][i] = pv; ps += pv; } \
        l = l * alpha + ps;     \
        _Pragma("unroll") for (int n = 0; n < 8; ++n) oT[n] *= alpha; \
        bf16x8 pf[2]; \
        _Pragma("unroll") for (int kk = 0; kk < 2; ++kk) { u32x4 pw; pw.x = cvt_pk_bf16(st[2 * kk][0], st[2 * kk][1]); pw.y = cvt_pk_bf16(st[2 * kk][2], st[2 * kk][3]); \
            pw.z = cvt_pk_bf16(st[2 * kk + 1][0], st[2 * kk + 1][1]); pw.w = cvt_pk_bf16(st[2 * kk + 1][2], st[2 * kk + 1][3]); pf[kk] = __builtin_bit_cast(bf16x8, pw); } \
        const unsigned vaddr = (unsigned)(uintptr_t)(Vt + (buf) * 64 * AT_KS) + (unsigned)((fq * 4 + (fr >> 2)) * AT_KS + (fr & 3) * 8); \
        s16x4 va[8][4]; \
          \
        _Pragma("unroll") for (int g2 = 0; g2 < 5; ++g2) { \
            if (g2 < 4) asm volatile("ds_read_b64_tr_b16 %0, %8 offset:%9\n\tds_read_b64_tr_b16 %1, %8 offset:%10\n\tds_read_b64_tr_b16 %2, %8 offset:%11\n\tds_read_b64_tr_b16 %3, %8 offset:%12\n\t" \
                         "ds_read_b64_tr_b16 %4, %8 offset:%13\n\tds_read_b64_tr_b16 %5, %8 offset:%14\n\tds_read_b64_tr_b16 %6, %8 offset:%15\n\tds_read_b64_tr_b16 %7, %8 offset:%16" \
                         : "=&v"(va[2 * (g2 & 3) + 0][0]), "=&v"(va[2 * (g2 & 3) + 0][1]), "=&v"(va[2 * (g2 & 3) + 0][2]), "=&v"(va[2 * (g2 & 3) + 0][3]), \
                           "=&v"(va[2 * (g2 & 3) + 1][0]), "=&v"(va[2 * (g2 & 3) + 1][1]), "=&v"(va[2 * (g2 & 3) + 1][2]), "=&v"(va[2 * (g2 & 3) + 1][3]) \
                         : "v"(vaddr), \
                           "i"((2 * (g2 & 3) + 0) * 32), "i"(16 * AT_KS + (2 * (g2 & 3) + 0) * 32), "i"(32 * AT_KS + (2 * (g2 & 3) + 0) * 32), "i"(48 * AT_KS + (2 * (g2 & 3) + 0) * 32), \
                           "i"((2 * (g2 & 3) + 1) * 32), "i"(16 * AT_KS + (2 * (g2 & 3) + 1) * 32), "i"(32 * AT_KS + (2 * (g2 & 3) + 1) * 32), "i"(48 * AT_KS + (2 * (g2 & 3) + 1) * 32) : "memory"); \
            if (g2 >= 1) { \
                if (g2 < 4) asm volatile("s_waitcnt lgkmcnt(8)" ::: "memory"); else asm volatile("s_waitcnt lgkmcnt(0)" ::: "memory"); \
                __builtin_amdgcn_sched_barrier(0);     \
                _Pragma("unroll") for (int nn = 0; nn < 2; ++nn) { const int n = 2 * (g2 - 1) + nn; \
                    const bf16x8 v0 = (bf16x8){va[n][0][0], va[n][0][1], va[n][0][2], va[n][0][3], va[n][1][0], va[n][1][1], va[n][1][2], va[n][1][3]}; \
                    const bf16x8 v1 = (bf16x8){va[n][2][0], va[n][2][1], va[n][2][2], va[n][2][3], va[n][3][0], va[n][3][1], va[n][3][2], va[n][3][3]}; \
                    oT[n] = __builtin_amdgcn_mfma_f32_16x16x32_bf16(v0, pf[0], oT[n], 0, 0, 0); \
                    oT[n] = __builtin_amdgcn_mfma_f32_16x16x32_bf16(v1, pf[1], oT[n], 0, 0, 0); } } } \
    } while (0)
    AT_LOAD(A, j_lo); AT_WRITE(A, 0);
    if (j_lo + 1 < ntiles) AT_LOAD(B, j_lo + 1);
    __syncthreads();
    for (int j = j_lo; j < ntiles; j += 2) {
        {
            if (j + 2 < ntiles) AT_LOAD(A, j + 2);
            AT_COMPUTE(j, 0);
            if (j + 1 < ntiles) AT_WRITE(B, 1);
            __syncthreads();
        }
        if (j + 1 < ntiles) {
            if (j + 3 < ntiles) AT_LOAD(B, j + 3);
            AT_COMPUTE(j + 1, 1);
            if (j + 2 < ntiles) AT_WRITE(A, 0);
            __syncthreads();
        }
    }
#undef AT_LOAD
#undef AT_WRITE
#undef AT_COMPUTE
    l += __shfl_xor(l, 16); l += __shfl_xor(l, 32);
    const float rl = 1.0f / l;
    float ssq = 0.f;
    bf16_t* orow = WSP(bf16_t, WS_MIXED) + ((size_t)b * S_ + qpos) * 2048 + h * 128 + fq * 4;
#pragma unroll
    for (int n = 0; n < 8; ++n) { const f32x4 o = oT[n] * rl; ssq += o[0] * o[0] + o[1] * o[1] + o[2] * o[2] + o[3] * o[3];
        u32x2 wv; wv.x = cvt_pk_bf16(o[0], o[1]); wv.y = cvt_pk_bf16(o[2], o[3]); *(u32x2*)(orow + n * 16) = wv; }
    ssq += __shfl_xor(ssq, 16); ssq += __shfl_xor(ssq, 32);
    if (fq == 0) WSP(float, WS_SSQ)[((size_t)b * S_ + qpos) * 8 + h] = ssq;
    __syncthreads();
}


__device__ __forceinline__ void knorm_pass(const Frame& F) {
    const int lane = F.lane, r = lane >> 4, c = lane & 15;
    float* KN = WSP(float, WS_KN);
    for (int u = F.bid * 8 + F.wave; u < 2048; u += F.G * 8) { const int bh = u >> 7, j = u & 127, b = bh >> 3, h = bh & 7;
        const bf16_t* kp = WSP(bf16_t, WS_PROJ) + ((size_t)b * S_ + j * 64 + r) * NPROJ + C_FK + h * 128 + c * 8;
        float mx = 0.f;
#pragma unroll
        for (int it = 0; it < 16; ++it) { const u32x4 v = *(const u32x4*)(kp + (size_t)it * 4 * NPROJ);
            float s = bflo(v.x) * bflo(v.x) + bfhi(v.x) * bfhi(v.x) + bflo(v.y) * bflo(v.y) + bfhi(v.y) * bfhi(v.y) + bflo(v.z) * bflo(v.z) + bfhi(v.z) * bfhi(v.z) + bflo(v.w) * bflo(v.w) + bfhi(v.w) * bfhi(v.w);
#pragma unroll
            for (int o = 8; o >= 1; o >>= 1) s += __shfl_xor(s, o);
            mx = fmaxf(mx, s); }
        mx = fmaxf(mx, __shfl_xor(mx, 16)); mx = fmaxf(mx, __shfl_xor(mx, 32));
        if (lane == 0) KN[u] = mx; }
}

__device__ __forceinline__ void hg_load_col(const Frame& F, int bh, int n, int colbase, unsigned short (&r)[16]) {
    const int tid = F.tid, dk = tid & 127, rq = tid >> 7, b = bh >> 3, h = bh & 7;
    const bf16_t* ptr = WSP(bf16_t, WS_PROJ) + ((size_t)b * S_ + n * 64 + rq * 16) * NPROJ + colbase + h * 128 + dk;
#pragma unroll
    for (int i = 0; i < 16; ++i) r[i] = ptr[(size_t)i * NPROJ];
}
__device__ __forceinline__ void hg_gates(const Params& p, const Frame& F, LAS float* qsum, int h, const unsigned short (&hf)[16], float (&fv)[16], float (&bc)[16], float& blast) {
    const int tid = F.tid, dk = tid & 127, rq = tid >> 7;
    const float l0 = p.lb_logits[h * 128 + dk], l1 = p.lb_logits[1024 + h * 128 + dk];
    const float lb = __builtin_amdgcn_rcpf(1.0f + __expf(l1 - l0));
    float run = 0.f;
#pragma unroll
    for (int i = 0; i < 16; ++i) { const float z = bf2f(hf[i]); const float f = lb + (1.0f - lb) * __builtin_amdgcn_rcpf(1.0f + __builtin_amdgcn_exp2f(z * -LOG2E)); fv[i] = f; run += __builtin_amdgcn_logf(f); bc[i] = run; }
    qsum[rq * 128 + dk] = run;
    __syncthreads();
    float off = 0.f, tot = 0.f;
#pragma unroll
    for (int q = 0; q < 4; ++q) { const float v = qsum[q * 128 + dk]; tot += v; if (q < rq) off += v; }
#pragma unroll
    for (int i = 0; i < 16; ++i) bc[i] += off;
    blast = tot;
}

__device__ __forceinline__ void hgu_unit(const Params& p, const Frame& F, int bh, int n, const unsigned short (&hf)[16], const unsigned short (&hi)[16]) {
    const int tid = F.tid, lane = F.lane, w = F.wave, fr = lane & 15, fq = lane >> 4;
    const int h = bh & 7, dk = tid & 127, rq = tid >> 7;
    LAS bf16_t* kT = (LAS bf16_t*)F.lds;
    LAS bf16_t* vT = kT + 128 * 72;
    LAS float* qsum = (LAS float*)(vT + 128 * 72);
    float fv[16], bc[16], blast;
    hg_gates(p, F, qsum, h, hf, fv, bc, blast);
#pragma unroll
    for (int i = 0; i < 16; i += 2) { const float k0 = (1.0f - fv[i]) * __builtin_amdgcn_exp2f(blast - bc[i]), k1 = (1.0f - fv[i + 1]) * __builtin_amdgcn_exp2f(blast - bc[i + 1]);
        *(LAS unsigned*)(kT + dk * 72 + rq * 16 + i) = cvt_pk_bf16(k0, k1); }
    if (rq == 0) WSP(float, WS_HGDEC)[((size_t)bh * 128 + n) * 128 + dk] = __builtin_amdgcn_exp2f(blast);
#pragma unroll
    for (int i = 0; i < 16; i += 2) *(LAS unsigned*)(vT + dk * 72 + rq * 16 + i) = (unsigned)hi[i] | ((unsigned)hi[i + 1] << 16);
    __syncthreads();
    f32x4 acc[8];
#pragma unroll
    for (int nt = 0; nt < 8; ++nt) acc[nt] = (f32x4){0.f, 0.f, 0.f, 0.f};
#pragma unroll
    for (int ks = 0; ks < 2; ++ks) { const bf16x8 a = *(const LAS bf16x8*)(kT + (w * 16 + fr) * 72 + ks * 32 + fq * 8);
#pragma unroll
        for (int nt = 0; nt < 8; ++nt) { const bf16x8 bv = *(const LAS bf16x8*)(vT + (nt * 16 + fr) * 72 + ks * 32 + fq * 8);
            acc[nt] = __builtin_amdgcn_mfma_f32_16x16x32_bf16(a, bv, acc[nt], 0, 0, 0); } }
    bf16_t* U = WSP(bf16_t, WS_HGU) + ((size_t)bh * 128 + n) * 16384;
#pragma unroll
    for (int nt = 0; nt < 8; ++nt) { u32x2 wv; wv.x = cvt_pk_bf16(acc[nt][0], acc[nt][1]); wv.y = cvt_pk_bf16(acc[nt][2], acc[nt][3]); *(u32x2*)(U + (size_t)(nt * 16 + fr) * 128 + w * 16 + fq * 4) = wv; }
    __syncthreads();
}

__device__ __forceinline__ void hg_scan(const Frame& F) {
    const bf16_t* U = WSP(bf16_t, WS_HGU); const float* DEC = WSP(float, WS_HGDEC); bf16_t* SP = WSP(bf16_t, WS_HGSP);
    for (int idx = F.bid * 512 + F.tid; idx < 16 * 8192; idx += F.G * 512) {
        const int bh = idx >> 13, rem = idx & 8191, dv = rem >> 6, dk2 = (rem & 63) * 2;
        const size_t e0 = (size_t)bh * 128 * 16384 + (size_t)dv * 128 + dk2;
        const size_t d0 = (size_t)bh * 128 * 128 + dk2;
        f32x2 s = {0.f, 0.f};
        unsigned ua[8], ub[8]; f32x2 da[8], db[8];
#define HS_LOAD(u_, d_, n0_) do { _Pragma("unroll") for (int k = 0; k < 8; ++k) { u_[k] = *(const unsigned*)(U + e0 + (size_t)((n0_) + k) * 16384); d_[k] = *(const f32x2*)(DEC + d0 + (size_t)((n0_) + k) * 128); } } while (0)
#define HS_STEP(u_, d_, n0_) do { _Pragma("unroll") for (int k = 0; k < 8; ++k) { *(unsigned*)(SP + e0 + (size_t)((n0_) + k) * 16384) = cvt_pk_bf16(s[0], s[1]); s = d_[k] * s + (f32x2){bflo(u_[k]), bfhi(u_[k])}; } } while (0)
        HS_LOAD(ua, da, 0);
        for (int n0 = 0; n0 < 128; n0 += 16) {
            HS_LOAD(ub, db, n0 + 8);
            HS_STEP(ua, da, n0);
            if (n0 + 16 < 128) HS_LOAD(ua, da, n0 + 16);
            HS_STEP(ub, db, n0 + 8);
        }
#undef HS_LOAD
#undef HS_STEP
    }
}
__device__ __forceinline__ void hgo_unit(const Params& p, const Frame& F, int bh, int n, const unsigned short (&hf)[16], const unsigned short (&hq)[16], const unsigned short (&hi)[16], const u32x4 (&spr)[4]) {
    const int tid = F.tid, lane = F.lane, w = F.wave, fr = lane & 15, fq = lane >> 4;
    const int b = bh >> 3, h = bh & 7, dk = tid & 127, rq = tid >> 7;
    LAS bf16_t* qd = (LAS bf16_t*)F.lds;
    LAS bf16_t* ki = qd + 64 * 136;
    LAS bf16_t* vT = ki + 64 * 136;
    LAS bf16_t* at = vT + 128 * 72;
    LAS bf16_t* sp = at + 64 * 72;
    LAS float* qsum = (LAS float*)(sp + 128 * 136);
    LAS float* rs = qsum + 512;
    const size_t trow = (size_t)b * S_ + n * 64;
    bf16_t* fxp = WSP(bf16_t, WS_MIXED) + (trow + (tid >> 3)) * 2048 + h * 128 + (tid & 7) * 16;
    const u32x4 fx0 = *(const u32x4*)fxp, fx1 = *(const u32x4*)(fxp + 8);
    const f32x4 sq0 = *(const f32x4*)(WSP(float, WS_SSQ) + (trow + (tid >> 3)) * 8), sq1 = *(const f32x4*)(WSP(float, WS_SSQ) + (trow + (tid >> 3)) * 8 + 4);
    u32x2 gwv[4];
    { const bf16_t* hg = WSP(bf16_t, WS_PROJ) + (trow + (w & 3) * 16 + fr) * NPROJ + C_HG + h * 128;
#pragma unroll
      for (int q = 0; q < 4; ++q) gwv[q] = *(const u32x2*)(hg + ((w >> 2) * 4 + q) * 16 + fq * 4); }
    float fv[16], bc[16], blast;
    hg_gates(p, F, qsum, h, hf, fv, bc, blast);
#pragma unroll
    for (int i = 0; i < 16; ++i) { const float q = bf2f(hq[i]); const float qq = q * __builtin_amdgcn_rcpf(1.0f + __builtin_amdgcn_exp2f(q * -LOG2E));
        const float qdv = qq * __builtin_amdgcn_exp2f(bc[i]), kiv = (1.0f - fv[i]) * __builtin_amdgcn_exp2f(-bc[i]);
        qd[(rq * 16 + i) * 136 + dk] = (bf16_t)(cvt_pk_bf16(qdv, 0.f) & 0xffffu);
        ki[(rq * 16 + i) * 136 + dk] = (bf16_t)(cvt_pk_bf16(kiv, 0.f) & 0xffffu); }
#pragma unroll
    for (int i = 0; i < 16; i += 2) *(LAS unsigned*)(vT + dk * 72 + rq * 16 + i) = (unsigned)hi[i] | ((unsigned)hi[i + 1] << 16);
#pragma unroll
    for (int r = 0; r < 4; ++r) { const int q = tid + 512 * r, dv = q >> 4, ch = q & 15; *(LAS u32x4*)(sp + dv * 136 + ch * 8) = spr[r]; }
    __syncthreads();
    { const int ct = w & 3;
#pragma unroll
      for (int q = 0; q < 2; ++q) { const int st = (w >> 2) * 2 + q;
          f32x4 a = {0.f, 0.f, 0.f, 0.f};
          if (st <= ct) {
#pragma unroll
              for (int ks = 0; ks < 4; ++ks) { const bf16x8 ka = *(const LAS bf16x8*)(ki + (st * 16 + fr) * 136 + ks * 32 + fq * 8); const bf16x8 qb = *(const LAS bf16x8*)(qd + (ct * 16 + fr) * 136 + ks * 32 + fq * 8);
                  a = __builtin_amdgcn_mfma_f32_16x16x32_bf16(ka, qb, a, 0, 0, 0); } }
          const int c = ct * 16 + fr;
#pragma unroll
          for (int i = 0; i < 4; ++i) if (st * 16 + fq * 4 + i > c) a[i] = 0.f;
          u32x2 wv; wv.x = cvt_pk_bf16(a[0], a[1]); wv.y = cvt_pk_bf16(a[2], a[3]);
          *(LAS u32x2*)(at + c * 72 + st * 16 + fq * 4) = wv; } }
    __syncthreads();
    const int ct = w & 3, dh = w >> 2;
    f32x4 acc[4];
#pragma unroll
    for (int q = 0; q < 4; ++q) acc[q] = (f32x4){0.f, 0.f, 0.f, 0.f};
#pragma unroll
    for (int ks = 0; ks < 2; ++ks) { const bf16x8 bb = *(const LAS bf16x8*)(at + (ct * 16 + fr) * 72 + ks * 32 + fq * 8);
#pragma unroll
        for (int q = 0; q < 4; ++q) { const bf16x8 aa = *(const LAS bf16x8*)(vT + ((dh * 4 + q) * 16 + fr) * 72 + ks * 32 + fq * 8);
            acc[q] = __builtin_amdgcn_mfma_f32_16x16x32_bf16(aa, bb, acc[q], 0, 0, 0); } }
#pragma unroll
    for (int ks = 0; ks < 4; ++ks) { const bf16x8 bb = *(const LAS bf16x8*)(qd + (ct * 16 + fr) * 136 + ks * 32 + fq * 8);
#pragma unroll
        for (int q = 0; q < 4; ++q) { const bf16x8 aa = *(const LAS bf16x8*)(sp + ((dh * 4 + q) * 16 + fr) * 136 + ks * 32 + fq * 8);
            acc[q] = __builtin_amdgcn_mfma_f32_16x16x32_bf16(aa, bb, acc[q], 0, 0, 0); } }
    float ss = 0.f;
#pragma unroll
    for (int q = 0; q < 4; ++q) ss += acc[q][0] * acc[q][0] + acc[q][1] * acc[q][1] + acc[q][2] * acc[q][2] + acc[q][3] * acc[q][3];
    ss += __shfl_xor(ss, 16); ss += __shfl_xor(ss, 32);
    const int c = ct * 16 + fr;
    if (fq == 0) rs[c * 2 + dh] = ss;
    __syncthreads();
    const float rstd = rsqrtf((rs[c * 2] + rs[c * 2 + 1]) * (1.0f / 128.0f) + EPS);
    bf16_t* orow = WSP(bf16_t, OUT_MODE == 2 ? WS_MIXN : WS_MIXED) + (trow + c) * 2048 + 1024 + h * 128;
#pragma unroll
    for (int q = 0; q < 4; ++q) { const int dv = (dh * 4 + q) * 16 + fq * 4;
        const u32x2 gw = gwv[q]; const f32x4 gn = *(const f32x4*)(p.g_hg + h * 128 + dv);
        const float g0 = bflo(gw.x), g1 = bfhi(gw.x), g2 = bflo(gw.y), g3 = bfhi(gw.y);
        const float o0 = acc[q][0] * rstd * gn[0] * (g0 * __builtin_amdgcn_rcpf(1.0f + __expf(-g0))), o1 = acc[q][1] * rstd * gn[1] * (g1 * __builtin_amdgcn_rcpf(1.0f + __expf(-g1)));
        const float o2 = acc[q][2] * rstd * gn[2] * (g2 * __builtin_amdgcn_rcpf(1.0f + __expf(-g2))), o3 = acc[q][3] * rstd * gn[3] * (g3 * __builtin_amdgcn_rcpf(1.0f + __expf(-g3)));
#if OUT_MODE == 1
        *(unsigned*)(F.ws + WS_MIX8 + (trow + c) * 2048 + 1024 + h * 128 + dv) = pack4_fp8(4.0f * o0, 4.0f * o1, 4.0f * o2, 4.0f * o3);
#else
        u32x2 wv; wv.x = cvt_pk_bf16(o0, o1); wv.y = cvt_pk_bf16(o2, o3); *(u32x2*)(orow + dv) = wv;
#endif
    }
    { const float rstdf = rsqrtf(((sq0[0] + sq0[1]) + (sq0[2] + sq0[3]) + (sq1[0] + sq1[1]) + (sq1[2] + sq1[3])) * (1.0f / 1024.0f) + EPS);
      const float* gf = p.g_fox + h * 128 + (tid & 7) * 16;
#if OUT_MODE == 1
      const float rs4 = 4.0f * rstdf;
      const f32x4 ga = *(const f32x4*)gf * rs4, gb = *(const f32x4*)(gf + 4) * rs4, gc = *(const f32x4*)(gf + 8) * rs4, gd = *(const f32x4*)(gf + 12) * rs4;
      u32x4 ov;
      ov.x = pack4_fp8(bflo(fx0.x) * ga[0], bfhi(fx0.x) * ga[1], bflo(fx0.y) * ga[2], bfhi(fx0.y) * ga[3]); ov.y = pack4_fp8(bflo(fx0.z) * gb[0], bfhi(fx0.z) * gb[1], bflo(fx0.w) * gb[2], bfhi(fx0.w) * gb[3]);
      ov.z = pack4_fp8(bflo(fx1.x) * gc[0], bfhi(fx1.x) * gc[1], bflo(fx1.y) * gc[2], bfhi(fx1.y) * gc[3]); ov.w = pack4_fp8(bflo(fx1.z) * gd[0], bfhi(fx1.z) * gd[1], bflo(fx1.w) * gd[2], bfhi(fx1.w) * gd[3]);
      *(u32x4*)(F.ws + WS_MIX8 + (trow + (tid >> 3)) * 2048 + h * 128 + (tid & 7) * 16) = ov; }
#else
      const f32x4 ga = *(const f32x4*)gf * rstdf, gb = *(const f32x4*)(gf + 4) * rstdf, gc = *(const f32x4*)(gf + 8) * rstdf, gd = *(const f32x4*)(gf + 12) * rstdf;
      u32x4 o0v, o1v;
      o0v.x = cvt_pk_bf16(bflo(fx0.x) * ga[0], bfhi(fx0.x) * ga[1]); o0v.y = cvt_pk_bf16(bflo(fx0.y) * ga[2], bfhi(fx0.y) * ga[3]); o0v.z = cvt_pk_bf16(bflo(fx0.z) * gb[0], bfhi(fx0.z) * gb[1]); o0v.w = cvt_pk_bf16(bflo(fx0.w) * gb[2], bfhi(fx0.w) * gb[3]);
      o1v.x = cvt_pk_bf16(bflo(fx1.x) * gc[0], bfhi(fx1.x) * gc[1]); o1v.y = cvt_pk_bf16(bflo(fx1.y) * gc[2], bfhi(fx1.y) * gc[3]); o1v.z = cvt_pk_bf16(bflo(fx1.z) * gd[0], bfhi(fx1.z) * gd[1]); o1v.w = cvt_pk_bf16(bflo(fx1.w) * gd[2], bfhi(fx1.w) * gd[3]);
      bf16_t* fxo = OUT_MODE == 2 ? WSP(bf16_t, WS_MIXN) + (trow + (tid >> 3)) * 2048 + h * 128 + (tid & 7) * 16 : fxp;
      *(u32x4*)fxo = o0v; *(u32x4*)(fxo + 8) = o1v; }
#endif
    __syncthreads();
}

__device__ __forceinline__ void mix_quant(const Frame& F, int b, int n) {
    const int lane = F.lane;
    const size_t trow = (size_t)b * S_ + n * 64 + F.wave * 8;
    const bf16_t* src = WSP(bf16_t, WS_MIXN); unsigned char* dst = F.ws + WS_MIX8; float* rs = WSP(float, WS_RS2);
#pragma unroll 1
    for (int r = 0; r < 8; r += 2) {
        u32x4 v[2][4];
#pragma unroll
        for (int q = 0; q < 2; ++q)
#pragma unroll
            for (int j = 0; j < 4; ++j) v[q][j] = *(const u32x4*)(src + (trow + r + q) * 2048 + j * 512 + lane * 8);
#pragma unroll
        for (int q = 0; q < 2; ++q) {
            float am = 0.f;
#pragma unroll
            for (int j = 0; j < 4; ++j)
#pragma unroll
                for (int e = 0; e < 4; ++e) am = fmaxf(am, fmaxf(fabsf(bflo(v[q][j][e])), fabsf(bfhi(v[q][j][e]))));
#pragma unroll
            for (int o = 32; o > 0; o >>= 1) am = fmaxf(am, __shfl_xor(am, o));
            const float inv = am > 0.f ? 127.0f / am : 0.f;
#pragma unroll
            for (int j = 0; j < 4; ++j) { u32x2 o;
                o.x = pack4_i8(inv * bflo(v[q][j].x), inv * bfhi(v[q][j].x), inv * bflo(v[q][j].y), inv * bfhi(v[q][j].y));
                o.y = pack4_i8(inv * bflo(v[q][j].z), inv * bfhi(v[q][j].z), inv * bflo(v[q][j].w), inv * bfhi(v[q][j].w));
                *(u32x2*)(dst + (trow + r + q) * 2048 + j * 512 + lane * 8) = o; }
            if (lane == 0) rs[trow + r + q] = am * (1.0f / 127.0f); }
    }
}

constexpr int HS_STRIDE = 2052;
__device__ __forceinline__ void phase7(const Params& p, const Frame& F) {
    const int tid = F.tid, lane = F.lane, w = F.wave;
    LAS float* hs = (LAS float*)F.lds;
    LAS float* part = hs + 16 * HS_STRIDE;
    LAS float* lg = part + 8 * 16 * 32;
    LAS int* hist = (LAS int*)(lg + 512);
    const float* mod = WSP(float, WS_MOD); const bf16_t* X1 = WSP(bf16_t, WS_X1);
    unsigned char* H2 = F.ws + WS_H2; int* TOPI = WSP(int, WS_TOPI); float* TOPG = WSP(float, WS_TOPG); int* CNT = WSP(int, WS_CNT);
    float wreg[16][4][2];
    { const int i16 = lane & 15, kq = lane >> 4;
#pragma unroll
      for (int kb = 0; kb < 16; ++kb)
#pragma unroll
          for (int sx = 0; sx < 4; ++sx) { const float* wp = p.w_router + (size_t)(256 * w + 16 * kb + 4 * kq + sx) * 32 + i16; wreg[kb][sx][0] = wp[0]; wreg[kb][sx][1] = wp[16]; } }
    for (int chunk = F.bid; chunk < 256; chunk += F.G) {
        if (tid < 32) hist[tid] = 0;
        __syncthreads();
        for (int gi = 0; gi < 4; ++gi) {
            const int t0 = chunk * 64 + gi * 16;
#pragma unroll
            for (int r = 0; r < 2; ++r) { const int tk = 2 * w + r, t = t0 + tk, b = t >> 13;
                const bf16_t* xr = X1 + (size_t)t * 2048;
                f32x4 v[8]; float ss = 0.f;
#pragma unroll
                for (int i = 0; i < 8; ++i) { const u32x2 xw = *(const u32x2*)(xr + (i * 64 + lane) * 4); v[i] = (f32x4){bflo(xw.x), bfhi(xw.x), bflo(xw.y), bfhi(xw.y)}; ss += v[i][0] * v[i][0] + v[i][1] * v[i][1] + v[i][2] * v[i][2] + v[i][3] * v[i][3]; }
                ss = wave_sum(ss);
                const float rstd = rsqrtf(ss * (1.0f / 2048.0f) + EPS);
#pragma unroll
                for (int i = 0; i < 8; ++i) { const int d = (i * 64 + lane) * 4;
                    const f32x4 sh = *(const f32x4*)(mod + b * 12288 + 6144 + d), sc = *(const f32x4*)(mod + b * 12288 + 8192 + d), g = *(const f32x4*)(p.g2 + d);
                    const f32x4 hv = v[i] * rstd * g * (sc + 1.0f) + sh;
                    *(unsigned*)(H2 + (size_t)t * 2048 + d) = pack4_fp8(hv[0], hv[1], hv[2], hv[3]);
                    *(LAS f32x4*)(hs + tk * HS_STRIDE + d) = hv; } }
            __syncthreads();
            { const int i16 = lane & 15, kq = lane >> 4;
              f32x4 c0 = {0.f, 0.f, 0.f, 0.f}, c1 = {0.f, 0.f, 0.f, 0.f};
#pragma unroll
              for (int kb = 0; kb < 16; ++kb) { const int kbase = 256 * w + 16 * kb + 4 * kq;
                  const f32x4 a4 = *(const LAS f32x4*)(hs + i16 * HS_STRIDE + kbase);
#pragma unroll
                  for (int sx = 0; sx < 4; ++sx) {
                      c0 = __builtin_amdgcn_mfma_f32_16x16x4f32(a4[sx], wreg[kb][sx][0], c0, 0, 0, 0); c1 = __builtin_amdgcn_mfma_f32_16x16x4f32(a4[sx], wreg[kb][sx][1], c1, 0, 0, 0); } }
#pragma unroll
              for (int r = 0; r < 4; ++r) { part[(w * 16 + 4 * kq + r) * 32 + i16] = c0[r]; part[(w * 16 + 4 * kq + r) * 32 + 16 + i16] = c1[r]; } }
            __syncthreads();
            {
                const int tk = tid >> 5, e = tid & 31; float cur = p.b_router[e];
#pragma unroll
                for (int w8 = 0; w8 < 8; ++w8) cur += part[(w8 * 16 + tk) * 32 + e];
                float vals[4]; int ids[4];
#pragma unroll
                for (int k = 0; k < 4; ++k) { float bv = cur; int bi = e;
#pragma unroll
                    for (int o = 16; o >= 1; o >>= 1) { const float ov = __shfl_xor(bv, o); const int oi = __shfl_xor(bi, o); if (ov > bv || (ov == bv && oi < bi)) { bv = ov; bi = oi; } }
                    vals[k] = bv; ids[k] = bi; if (e == bi) cur = -__builtin_inff(); }
                if (e == 0) { const int t = t0 + tk; float ex[4], se = 0.f;
#pragma unroll
                    for (int k = 0; k < 4; ++k) { ex[k] = __expf(vals[k] - vals[0]); se += ex[k]; }
                    const float inv = 1.0f / se;
#pragma unroll
                    for (int k = 0; k < 4; ++k) { TOPI[(size_t)t * 4 + k] = ids[k]; TOPG[(size_t)t * 4 + k] = ex[k] * inv; atomicAdd((int*)(hist + ids[k]), 1); } } }
            __syncthreads();
        }
        if (tid < 32) CNT[chunk * 32 + tid] = hist[tid];
        __syncthreads();
    }
}

__device__ __forceinline__ void phase8(const Frame& F) {
    const int tid = F.tid, lane = F.lane, w = F.wave;
    LAS int* cn = (LAS int*)F.lds;
    LAS int* part = cn + 8192;
    LAS int* tot = part + 512;
    LAS int* base = tot + 32;
    LAS int* pst = base + 32;
    LAS int* wcnt = pst + 40;
    const int* CNT = WSP(int, WS_CNT); const int* TOPI = WSP(int, WS_TOPI);
    int* POS = WSP(int, WS_POS); int* SRC = WSP(int, WS_SRC); int* TILEE = WSP(int, WS_TILEE);
    const int chunk0 = F.bid;
    int e_pre = 0;
    if (tid < 256 && chunk0 < 256) e_pre = TOPI[(size_t)chunk0 * 256 + tid];
    for (int q = tid; q < 8192; q += 512) cn[q] = CNT[q];
    __syncthreads();
    { const int e = tid & 31, g = tid >> 5; int sacc = 0;
#pragma unroll
      for (int c = 0; c < 16; ++c) sacc += cn[(g * 16 + c) * 32 + e];
      part[g * 32 + e] = sacc; }
    __syncthreads();
    if (tid < 32) { int run = 0;
#pragma unroll
        for (int g = 0; g < 16; ++g) run += part[g * 32 + tid];
        tot[tid] = run; }
    __syncthreads();
    if (tid < 32) {
        const int pad = (tot[tid] + 255) / 256 * 256; int incl = pad;
#pragma unroll
        for (int o = 1; o < 32; o <<= 1) { const int v = __shfl_up(incl, o); if (tid >= o) incl += v; }
        pst[tid] = incl - pad; if (tid == 31) pst[32] = incl; }
    __syncthreads();
    for (int chunk = chunk0; chunk < 256; chunk += F.G) {
        if (tid < 32) { const int g = chunk >> 4; int run = 0;
            for (int gg = 0; gg < g; ++gg) run += part[gg * 32 + tid];
            for (int c = g * 16; c < chunk; ++c) run += cn[c * 32 + tid];
            base[tid] = run; }
        int e = e_pre; if (chunk != chunk0 && tid < 256) e = TOPI[(size_t)chunk * 256 + tid];
        int rk = 0;
        if (tid < 256) {
#pragma unroll 8
            for (int k = 0; k < 32; ++k) { const unsigned long long mk = __ballot(e == k);
                if (e == k) rk = __popcll(mk & ((1ull << lane) - 1ull));
                if (lane == k) wcnt[w * 32 + k] = __popcll(mk); } }
        __syncthreads();
        if (tid < 256) { int before = 0;
            for (int ww = 0; ww < w; ++ww) before += wcnt[ww * 32 + e];
            const int pos = pst[e] + base[e] + before + rk; POS[(size_t)chunk * 256 + tid] = pos; SRC[pos] = chunk * 64 + (tid >> 2); }
        if (chunk < 32) { const int ee = chunk; for (int r = pst[ee] + tot[ee] + tid; r < pst[ee + 1]; r += 512) SRC[r] = 0; }
        if (chunk == 0) { const int ntl = pst[32] >> 8; for (int i = tid; i < ntl; i += 512) { int ee = 0;
#pragma unroll
                for (int k = 0; k < 32; ++k) if (pst[k] <= i * 256) ee = k;
                TILEE[i] = ee; }
            if (tid == 0) TILEE[MAXTILES] = ntl; }
        __syncthreads();
    }
}

__device__ __forceinline__ void phase11(const Params& p, const Frame& F) {
    const int lane = F.lane;
    const float* mod = WSP(float, WS_MOD); const bf16_t* X1 = WSP(bf16_t, WS_X1); const unsigned char* Y = F.ws + WS_YBUF;
    const int* POS = WSP(int, WS_POS); const float* TOPG = WSP(float, WS_TOPG);
    for (int t = F.bid * 8 + F.wave; t < T_; t += F.G * 8) {
        const int b = t >> 13;
        int ps[4]; float gk[4];
#pragma unroll
        for (int k = 0; k < 4; ++k) { ps[k] = POS[(size_t)t * 4 + k]; gk[k] = TOPG[(size_t)t * 4 + k] * (1.0f / 16.0f); }
        f32x4 v[8]; float ss = 0.f;
#pragma unroll
        for (int i = 0; i < 8; ++i) { const int d = (i * 64 + lane) * 4;
            f32x4 a = {0.f, 0.f, 0.f, 0.f};
#pragma unroll
            for (int k = 0; k < 4; ++k) { const int yw = *(const int*)(Y + (size_t)ps[k] * 2048 + d);
                const f32x2 ylo = __builtin_amdgcn_cvt_pk_f32_fp8(yw, false), yhi = __builtin_amdgcn_cvt_pk_f32_fp8(yw, true);
                a[0] += gk[k] * ylo[0]; a[1] += gk[k] * ylo[1]; a[2] += gk[k] * yhi[0]; a[3] += gk[k] * yhi[1]; }
            const f32x4 gt = *(const f32x4*)(mod + b * 12288 + 10240 + d);
            const u32x2 xw = *(const u32x2*)(X1 + (size_t)t * 2048 + d);
            v[i] = (f32x4){bflo(xw.x), bfhi(xw.x), bflo(xw.y), bfhi(xw.y)} + gt * a;
            ss += v[i][0] * v[i][0] + v[i][1] * v[i][1] + v[i][2] * v[i][2] + v[i][3] * v[i][3]; }
        ss = wave_sum(ss);
        const float rstd = rsqrtf(ss * (1.0f / 2048.0f) + EPS);
#pragma unroll
        for (int i = 0; i < 8; ++i) { const int d = (i * 64 + lane) * 4; const f32x4 g = *(const f32x4*)(p.g_final + d);
            *(f32x4*)(p.out + (size_t)t * 2048 + d) = v[i] * rstd * g; }
    }
}

__global__ void __launch_bounds__(512, 2) fwd(Params p) {
    extern __shared__ __attribute__((aligned(16))) unsigned char lds_raw[];
    Frame F;
    F.lds = (LAS unsigned char*)lds_raw;
    F.tid = threadIdx.x; F.lane = F.tid & 63; F.wave = __builtin_amdgcn_readfirstlane(F.tid >> 6);
    F.G = gridDim.x; F.bid = blockIdx.x; F.ws = p.ws;
    volatile LAS unsigned* xbw = (volatile LAS unsigned*)(F.lds + LDS_BYTES - 16);
    if (F.tid < 4) xbw[F.tid] = 0u;
    __syncthreads();
    const int lo = p.lo, hi = p.hi;
    const bool multi = (hi - lo) > 1;
    XcdBarrier bar; bar.bar = (unsigned*)(p.ws + WS_CTL); bar.x = 0; bar.st = xbw; bar.total = (unsigned)F.G;
    if (multi) bar = xcd_barrier_post((unsigned*)(p.ws + WS_CTL), xbw, (unsigned)F.G);
    const bool bgc = multi && (hi - lo) == NPHASE && F.G >= 2 * BG_CONV && (F.G & 7) == 0;
    const int ncv = bgc ? BG_CONV : 0;
    const bool is_conv = F.bid < ncv;
    Frame FW = F; FW.bid = F.bid - ncv; FW.G = F.G - ncv;
    XcdBarrier barW = bar;
    if (bgc && !is_conv) barW = xcd_barrier_post((unsigned*)(p.ws + WS_BARW), xbw + 2, (unsigned)FW.G);
#define SEAM_W(k) do { if (IN((k) + 1)) xcd_barrier(barW); } while (0)
#define IN(k) (lo <= (k) && (k) < hi)
#define SEAM(k) do { if (IN((k) + 1)) xcd_barrier(bar); } while (0)

    if (IN(0)) { phase0(p, F); SEAM(0); }
    if (IN(1)) { phase1(p, F);
#if IN_MODE == 2
        __syncthreads(); wtile_pass<0>(p, F, 0, OUT_MODE == 2 ? CONV_TILES : 896);
#endif
        SEAM(1); }
    if (IN(2)) {
        if (is_conv || !bgc) { conv8_range(p, F, F.bid, bgc ? ncv : F.G); __syncthreads(); }
      if (!is_conv) {
        cum_scan(FW);
        pg8::StaticOrder S; S.init(T_, NPROJ, FW.G, FW.bid, WGM_IN);
#if IN_MODE == 2
        pg8::SrcPlain X{WSP(bf16_t, WS_H1), WSP(bf16_t, WS_WIN), 1024};
        pg8::EpiProjI8 E{WSP(bf16_t, WS_PROJ), NPROJ, WSP(float, WS_RS), WSP(float, WS_CMAX)};
        pg8::gemm_phase<2>(F.lds, 1024, S, X, E);
#elif IN_MODE == 1
        pg8::SrcPlain X{WSP(bf16_t, WS_H1), WSP(bf16_t, WS_WIN), 1024};
        pg8::EpiProj E{WSP(bf16_t, WS_PROJ), NPROJ, 1.0f / 256.0f};
        pg8::gemm_phase<1>(F.lds, 1024, S, X, E);
#else
        pg8::SrcPlain X{WSP(bf16_t, WS_H1), WSP(bf16_t, WS_WIN), 2048};
        pg8::EpiProj E{WSP(bf16_t, WS_PROJ), NPROJ, 1.0f};
        pg8::gemm_phase<0>(F.lds, 2048, S, X, E);
#endif
        SEAM_W(2);
      }
    }
    if (IN(3) && !is_conv) {
        {   unsigned short fa[16], va[16], fb[16], vb[16];
            int u = FW.bid;
            if (u < 2048) { hg_load_col(FW, u >> 7, u & 127, C_HF, fa); hg_load_col(FW, u >> 7, u & 127, C_HI, va); }
            while (u < 2048) { const int un = u + FW.G;
                if (un < 2048) { hg_load_col(FW, un >> 7, un & 127, C_HF, fb); hg_load_col(FW, un >> 7, un & 127, C_HI, vb); }
                hgu_unit(p, FW, u >> 7, u & 127, fa, va);
#pragma unroll
                for (int i = 0; i < 16; ++i) { fa[i] = fb[i]; va[i] = vb[i]; }
                u = un; } }
        knorm_pass(FW);
        SEAM_W(3);
    }
    if (IN(4)) {
        if (!is_conv) {
        hg_scan(FW);
        {
            const int full = (512 / FW.G) * FW.G, left = 512 - full, rounds = full / FW.G;
            int nitem = 2 * rounds, la = -1, lh = 0;
            if (2 * left <= FW.G) { if (FW.bid < 2 * left) { la = full + (FW.bid >> 1); lh = FW.bid & 1; nitem += 1; } }
            else if (FW.bid < left) { la = full + FW.bid; lh = 0; nitem += 2; }
#pragma unroll 1
            for (int i = 0; i < nitem; ++i) {
                const bool lo_ = i >= 2 * rounds;
                const int a = lo_ ? la : FW.bid + (i >> 1) * FW.G, hsel = lo_ ? (lh + (i - 2 * rounds)) & 1 : (i & 1);
                const int bh = a >> 5, xq = a & 31;
                attn_unit(FW, bh, hsel ? 63 - xq : xq); }
        }
        }
        SEAM(4);
    }
    if (IN(5)) {
        {   unsigned short fa[16], qa[16], va[16], fb[16], qb[16], vb[16]; u32x4 sa[4], sb[4];
            const bf16_t* SPg = WSP(bf16_t, WS_HGSP);
#define HGO_LOAD(u_, f_, q_, v_, s_) do { hg_load_col(F, (u_) >> 7, (u_) & 127, C_HF, f_); hg_load_col(F, (u_) >> 7, (u_) & 127, C_HQ, q_); hg_load_col(F, (u_) >> 7, (u_) & 127, C_HI, v_); \
                _Pragma("unroll") for (int r = 0; r < 4; ++r) { const int q = F.tid + 512 * r; s_[r] = *(const u32x4*)(SPg + (size_t)(u_) * 16384 + (size_t)(q >> 4) * 128 + (q & 15) * 8); } } while (0)
#if OUT_MODE == 2
#define HGO_UOF(j_) ((F.bid + ((j_) >> 3) * F.G) < 256 ? ((((F.bid + ((j_) >> 3) * F.G) >> 7) * 8 + ((j_) & 7)) * 128 + ((F.bid + ((j_) >> 3) * F.G) & 127)) : 2048)
            int j = 0, u = HGO_UOF(0);
            if (u < 2048) HGO_LOAD(u, fa, qa, va, sa);
            while (u < 2048) { const int un = HGO_UOF(j + 1);
                if (un < 2048) HGO_LOAD(un, fb, qb, vb, sb);
                hgo_unit(p, F, u >> 7, u & 127, fa, qa, va, sa);
                if ((j & 7) == 7) mix_quant(F, u >> 10, u & 127);
#pragma unroll
                for (int i = 0; i < 16; ++i) { fa[i] = fb[i]; qa[i] = qb[i]; va[i] = vb[i]; }
#pragma unroll
                for (int r = 0; r < 4; ++r) sa[r] = sb[r];
                u = un; ++j; }
#undef HGO_UOF
#else
            int u = F.bid;
            if (u < 2048) HGO_LOAD(u, fa, qa, va, sa);
            while (u < 2048) { const int un = u + F.G;
                if (un < 2048) HGO_LOAD(un, fb, qb, vb, sb);
                hgo_unit(p, F, u >> 7, u & 127, fa, qa, va, sa);
#pragma unroll
                for (int i = 0; i < 16; ++i) { fa[i] = fb[i]; qa[i] = qb[i]; va[i] = vb[i]; }
#pragma unroll
                for (int r = 0; r < 4; ++r) sa[r] = sb[r];
                u = un; }
#endif
#undef HGO_LOAD
        }
        SEAM(5);
    }
    if (IN(6)) {
        pg8::StaticOrder S; S.init(T_, 2048, F.G, F.bid, WGM_OUT);
#if OUT_MODE == 2
        pg8::SrcPlain X{WSP(bf16_t, WS_MIX8), WSP(bf16_t, WS_WOUT), 1024};
        pg8::EpiResidI8 E{p.x, WSP(bf16_t, WS_X1), WSP(float, WS_MOD) + 4096, WSP(float, WS_RS2), WSP(float, WS_CMAX) + NPROJ};
        pg8::gemm_phase<2>(F.lds, 1024, S, X, E);
#elif OUT_MODE == 1
        pg8::SrcPlain X{WSP(bf16_t, WS_MIX8), WSP(bf16_t, WS_WOUT), 1024};
        pg8::EpiResid E{p.x, WSP(bf16_t, WS_X1), WSP(float, WS_MOD) + 4096, 1.0f / 256.0f};
        pg8::gemm_phase<1>(F.lds, 1024, S, X, E);
#else
        pg8::SrcPlain X{WSP(bf16_t, WS_MIXED), WSP(bf16_t, WS_WOUT), 2048};
        pg8::EpiResid E{p.x, WSP(bf16_t, WS_X1), WSP(float, WS_MOD) + 4096, 1.0f};
        pg8::gemm_phase<0>(F.lds, 2048, S, X, E);
#endif
        SEAM(6);
    }
    if (IN(7)) { phase7(p, F); SEAM(7); }
    if (IN(8)) { phase8(F); SEAM(8); }
    if (IN(9)) {
        const int ntl = WSP(int, WS_TILEE)[MAXTILES];
        pg8::StaticOrder S; S.init(ntl * 256, 4096, F.G, F.bid, WGM_GU);
        pg8::SrcMoE X{WSP(bf16_t, WS_H2), WSP(bf16_t, WS_WGU), WSP(int, WS_SRC), WSP(int, WS_TILEE), 1024, (size_t)4096 * 1024};
        pg8::EpiGlu E{F.ws + WS_ACT, p.b_gu};
        pg8::gemm_phase<1>(F.lds, 1024, S, X, E);
        SEAM(9);
    }
    if (IN(10)) {
        const int ntl = WSP(int, WS_TILEE)[MAXTILES];
        pg8::StaticOrder S; S.init(ntl * 256, 2048, F.G, F.bid, WGM_DN);
        pg8::SrcMoE X{WSP(bf16_t, WS_ACT), WSP(bf16_t, WS_WDN), nullptr, WSP(int, WS_TILEE), 1024, (size_t)2048 * 1024};
        pg8::EpiDown E{F.ws + WS_YBUF, p.b_down};
        pg8::gemm_phase<1>(F.lds, 1024, S, X, E);
        SEAM(10);
    }
    if (IN(11)) { phase11(p, F); }
#undef IN
#undef SEAM
}

#ifndef N_LAUNCH_MODE
#define N_LAUNCH_MODE 1
#endif
extern "C" void kernel_launch(void* const* d_in, const int* in_sizes, int n_in, void* d_out, int out_size, void* d_ws, size_t ws_size, hipStream_t stream) {
    static int grid = 0;
    if (grid == 0) {
        if (n_in != 19 || out_size != T_ * D_ || ws_size < WS_END) { fprintf(stderr, "kernel_launch: unexpected shapes (n_in %d out %d ws %zu need %zu)\n", n_in, out_size, ws_size, (size_t)WS_END); grid = -1; return; }
        int dev = 0, cus = 0, per_cu = 0;
        if (hipGetDevice(&dev) != hipSuccess || hipDeviceGetAttribute(&cus, hipDeviceAttributeMultiprocessorCount, dev) != hipSuccess) { grid = -1; return; }
        if (hipFuncSetAttribute((const void*)fwd, hipFuncAttributeMaxDynamicSharedMemorySize, LDS_BYTES) != hipSuccess) { fprintf(stderr, "kernel_launch: hipFuncSetAttribute failed\n"); grid = -1; return; }
        if (hipOccupancyMaxActiveBlocksPerMultiprocessor(&per_cu, (const void*)fwd, 512, LDS_BYTES) != hipSuccess || per_cu < 1) fprintf(stderr, "kernel_launch: occupancy query reports %d\n", per_cu);
        (void)hipGetLastError();
        grid = cus;
    }
    if (grid < 0) return;
    (void)in_sizes;
    hipMemsetAsync((char*)d_ws + WS_CTL, 0, 65536, stream);
    Params p{};
    p.x = (const float*)d_in[0]; p.c = (const float*)d_in[1]; p.w_ada = (const float*)d_in[2]; p.b_ada = (const float*)d_in[3];
    p.g1 = (const float*)d_in[4]; p.g2 = (const float*)d_in[5]; p.w_in = (const float*)d_in[6]; p.b_fgate = (const float*)d_in[7];
    p.g_fox = (const float*)d_in[8]; p.lb_logits = (const float*)d_in[9]; p.g_hg = (const float*)d_in[10]; p.w_out = (const float*)d_in[11];
    p.w_router = (const float*)d_in[12]; p.b_router = (const float*)d_in[13]; p.w_gu = (const float*)d_in[14]; p.b_gu = (const float*)d_in[15];
    p.w_down = (const float*)d_in[16]; p.b_down = (const float*)d_in[17]; p.g_final = (const float*)d_in[18];
    p.out = (float*)d_out; p.ws = (unsigned char*)d_ws;
#if N_LAUNCH_MODE == 1
    p.lo = 0; p.hi = NPHASE;
    hipLaunchKernelGGL(fwd, dim3(grid), dim3(512), LDS_BYTES, stream, p);
#else
    for (int k = 0; k < NPHASE; ++k) { p.lo = k; p.hi = k + 1; hipLaunchKernelGGL(fwd, dim3(grid), dim3(512), LDS_BYTES, stream, p); }
#endif
}
```
